# Optimizing an MI355X kernel written in HIP

```python
import math
import jax
import jax.numpy as jnp
from jax import lax
import numpy as np

D_MODEL = 1024
BATCH = 8
SEQ = 2048
DEPTH = 2

N_MIXERS = 2
N_HEADS = 16
HEAD_DIM = 64
ATTN_WIDTH = N_HEADS * HEAD_DIM
A_KV_HEADS = 2
A_WINDOW = 128
B_KV_HEADS = 2
CMP_BLOCK = 32
CMP_STRIDE = 16
CMP_HIDDEN = 256
SEL_BLOCK = 64
SEL_TOPK = 16
SEL_LOCAL = 2
B_WINDOW = 512
REL_BUCKETS = 32
REL_MAX_DIST = 1024
D_FF = -(-(8 * D_MODEL) // (3 * 256)) * 256
BLOCK_Q = 128
SEL_QCHUNK = 64
RMS_EPS = 1e-6
NEG_INF = -1e30
FORCE_SCORE = 1e6
N_A_LAYERS = (DEPTH + 1) // 2
N_B_LAYERS = DEPTH // 2
A_QKV_WIDTH = ATTN_WIDTH + 2 * A_KV_HEADS * HEAD_DIM
B_IN_WIDTH = ATTN_WIDTH + 6 * B_KV_HEADS * HEAD_DIM + 3 * N_HEADS

kernel_name = 'hybrid_swa_sink_nsa_trunk'


def rms_norm(x, g):
    x32 = x.astype(jnp.float32)
    y = x32 * lax.rsqrt(jnp.mean(x32 * x32, axis=-1, keepdims=True) + RMS_EPS)
    return (y * g.astype(jnp.float32)).astype(x.dtype)


def t5_bucket(dist):
    n = jnp.maximum(dist, 0)
    max_exact = REL_BUCKETS // 2
    nf = jnp.maximum(n, 1).astype(jnp.float32)
    log_b = max_exact + (jnp.log(nf / max_exact) / math.log(REL_MAX_DIST / max_exact)
                         * (REL_BUCKETS - max_exact)).astype(jnp.int32)
    return jnp.where(n < max_exact, n, jnp.minimum(log_b, REL_BUCKETS - 1))


def head_bias(rel_table, dist, n_kv):
    b = rel_table.astype(jnp.float32)[t5_bucket(dist)]
    b = b.reshape(dist.shape + (n_kv, N_HEADS // n_kv))
    return jnp.moveaxis(b, (-2, -1), (0, 1))


def banded_attention(q, k, v, window, rel_table, sinks):
    B, S, hkv, g_sz, dh = q.shape
    nb = S // BLOCK_Q
    n_prev = (window - 1) // BLOCK_Q + 1
    span = (n_prev + 1) * BLOCK_Q
    pad = ((0, 0), (n_prev * BLOCK_Q, 0), (0, 0), (0, 0))
    kp = jnp.pad(k, pad)
    vp = jnp.pad(v, pad)
    qi = jnp.arange(BLOCK_Q)[:, None]
    kj = jnp.arange(span)[None, :]
    dist = qi - kj + n_prev * BLOCK_Q
    in_win = (dist >= 0) & (dist < window)
    bias = head_bias(rel_table, dist, hkv)
    qb = jnp.moveaxis(q.reshape(B, nb, BLOCK_Q, hkv, g_sz, dh), 1, 0)

    def block(args):
        n, qn = args
        start = n * BLOCK_Q
        kn = lax.dynamic_slice_in_dim(kp, start, span, axis=1)
        vn = lax.dynamic_slice_in_dim(vp, start, span, axis=1)
        s = jnp.einsum('bqhgd,bshd->bhgqs', qn, kn).astype(jnp.float32) + bias
        mask = in_win & (start - n_prev * BLOCK_Q + kj >= 0)
        s = jnp.where(mask, s, NEG_INF)
        if sinks is None:
            p = jax.nn.softmax(s, axis=-1)
        else:
            sk = sinks.astype(jnp.float32).reshape(hkv, g_sz, 1, 1)
            m = jnp.maximum(jnp.max(s, axis=-1, keepdims=True), sk)
            e = jnp.exp(s - m)
            p = e / (jnp.sum(e, axis=-1, keepdims=True) + jnp.exp(sk - m))
        return jnp.einsum('bhgqs,bshd->bqhgd', p.astype(vn.dtype), vn)

    out = lax.map(block, (jnp.arange(nb), qb))
    return jnp.moveaxis(out, 0, 1).reshape(B, S, hkv, g_sz, dh)


def swa_sink_mixer(h, w_qkv, b_qkv, sinks, w_o, b_o, rel_table):
    B, S, _ = h.shape
    g_sz = N_HEADS // A_KV_HEADS
    kvw = A_KV_HEADS * HEAD_DIM
    qkv = h @ w_qkv + b_qkv
    q = qkv[..., :ATTN_WIDTH].reshape(B, S, A_KV_HEADS, g_sz, HEAD_DIM) * HEAD_DIM ** -0.5
    k = qkv[..., ATTN_WIDTH:ATTN_WIDTH + kvw].reshape(B, S, A_KV_HEADS, HEAD_DIM)
    v = qkv[..., ATTN_WIDTH + kvw:].reshape(B, S, A_KV_HEADS, HEAD_DIM)
    o = banded_attention(q, k, v, A_WINDOW, rel_table, sinks)
    return o.reshape(B, S, ATTN_WIDTH) @ w_o + b_o


def compress(x_tok, pos, w1, w2):
    B, S, hkv, dh = x_tok.shape
    nc = (S - CMP_BLOCK) // CMP_STRIDE + 1
    idx = jnp.arange(nc)[:, None] * CMP_STRIDE + jnp.arange(CMP_BLOCK)[None, :]
    blocks = x_tok[:, idx] + pos[:, None, :]
    flat = jnp.moveaxis(blocks, 3, 2).reshape(B, nc, hkv, CMP_BLOCK * dh)
    return jax.nn.gelu(flat @ w1) @ w2


def nsa_mixer(h, w_in, cmp_pos, cmp_w1, cmp_w2, w_o, rel_table):
    B, S, _ = h.shape
    hkv, g_sz, dh = B_KV_HEADS, N_HEADS // B_KV_HEADS, HEAD_DIM
    kvw = hkv * dh
    proj = h @ w_in
    q = proj[..., :ATTN_WIDTH].reshape(B, S, hkv, g_sz, dh) * dh ** -0.5
    kv = proj[..., ATTN_WIDTH:ATTN_WIDTH + 6 * kvw].reshape(B, S, 6, hkv, dh)
    k_cmp, v_cmp, k_slc, v_slc, k_win, v_win = [kv[:, :, i] for i in range(6)]
    gates = jax.nn.sigmoid(proj[..., ATTN_WIDTH + 6 * kvw:].astype(jnp.float32))
    gates = gates.reshape(B, S, hkv, g_sz, 3).astype(h.dtype)

    kc = compress(k_cmp, cmp_pos[0], cmp_w1[0], cmp_w2[0])
    vc = compress(v_cmp, cmp_pos[1], cmp_w1[1], cmp_w2[1])
    nc = kc.shape[1]
    t = jnp.arange(S)[:, None]
    c_start = jnp.arange(nc) * CMP_STRIDE
    c_end = c_start + CMP_BLOCK - 1
    c_valid = c_end[None, :] <= t
    s_c = jnp.einsum('bshgd,bchd->bhgsc', q, kc).astype(jnp.float32)
    s_c = s_c + head_bias(rel_table, t - c_end[None, :], hkv)
    s_c = jnp.where(c_valid, s_c, NEG_INF)
    p_c = jax.nn.softmax(s_c, axis=-1) * c_valid
    o_cmp = jnp.einsum('bhgsc,bchd->bshgd', p_c.astype(h.dtype), vc)

    n_sel = S // SEL_BLOCK
    top_k = min(SEL_TOPK, n_sel)
    s_start = jnp.arange(n_sel) * SEL_BLOCK
    overlap = ((c_start[:, None] < s_start[None, :] + SEL_BLOCK)
               & (c_start[:, None] + CMP_BLOCK > s_start[None, :])).astype(jnp.float32)
    imp = jnp.einsum('bhgsc,cj->bhsj', p_c, overlap)
    cur = t // SEL_BLOCK
    jb = jnp.arange(n_sel)[None, :]
    forced = (jb == 0) | ((cur - jb >= 0) & (cur - jb < SEL_LOCAL))
    score = jnp.where(forced, FORCE_SCORE, jnp.where(jb <= cur, imp, -1.0))
    _, sel_idx = lax.top_k(score, top_k)

    ksb = jnp.moveaxis(k_slc.reshape(B, n_sel, SEL_BLOCK, hkv, dh), 3, 1)
    vsb = jnp.moveaxis(v_slc.reshape(B, n_sel, SEL_BLOCK, hkv, dh), 3, 1)
    n_ch = S // SEL_QCHUNK
    q_ch = jnp.moveaxis(q.reshape(B, n_ch, SEL_QCHUNK, hkv, g_sz, dh), 1, 0)
    idx_ch = jnp.moveaxis(sel_idx.reshape(B, hkv, n_ch, SEL_QCHUNK, top_k), 2, 0)
    bi = jnp.arange(B)[:, None, None, None]
    hi = jnp.arange(hkv)[None, :, None, None]
    table_h = rel_table.astype(jnp.float32).reshape(REL_BUCKETS, hkv, g_sz).transpose(1, 0, 2)
    n_keys = top_k * SEL_BLOCK

    def sel_chunk(args):
        c, qc, ic = args
        kg = ksb[bi, hi, ic].reshape(B, hkv, SEL_QCHUNK, n_keys, dh)
        vg = vsb[bi, hi, ic].reshape(B, hkv, SEL_QCHUNK, n_keys, dh)
        key_pos = (ic[..., None] * SEL_BLOCK + jnp.arange(SEL_BLOCK)).reshape(B, hkv, SEL_QCHUNK, n_keys)
        q_pos = c * SEL_QCHUNK + jnp.arange(SEL_QCHUNK)
        dist = q_pos[:, None] - key_pos
        bias = jnp.moveaxis(table_h[hi, t5_bucket(dist)], -1, 2)
        s = jnp.einsum('bqhgd,bhqkd->bhgqk', qc, kg).astype(jnp.float32) + bias
        s = jnp.where((dist >= 0)[:, :, None], s, NEG_INF)
        p = jax.nn.softmax(s, axis=-1)
        return jnp.einsum('bhgqk,bhqkd->bqhgd', p.astype(vg.dtype), vg)

    o_slc = lax.map(sel_chunk, (jnp.arange(n_ch), q_ch, idx_ch))
    o_slc = jnp.moveaxis(o_slc, 0, 1).reshape(B, S, hkv, g_sz, dh)

    o_win = banded_attention(q, k_win, v_win, B_WINDOW, rel_table, None)

    o = gates[..., 0:1] * o_cmp + gates[..., 1:2] * o_slc + gates[..., 2:3] * o_win
    return o.reshape(B, S, ATTN_WIDTH) @ w_o


def swiglu(h, w_gu, w_down):
    gate, up = jnp.split(h @ w_gu, 2, axis=-1)
    return (jax.nn.silu(gate) * up) @ w_down


def setup_inputs(seed: int = 0) -> dict:
    key = jax.random.key(seed)
    ks = jax.random.split(key, 18)
    f32 = jnp.float32

    def nrm(k, shape, scale):
        return jax.random.normal(k, shape, f32) * scale

    res_scale = (2 * DEPTH) ** -0.5
    return {
        'x': nrm(ks[0], (BATCH, SEQ, D_MODEL), 1.0),
        'rel_table': nrm(ks[1], (REL_BUCKETS, N_HEADS), 0.5),
        'attn_norm': 1.0 + nrm(ks[2], (DEPTH, D_MODEL), 0.05),
        'ffn_norm': 1.0 + nrm(ks[3], (DEPTH, D_MODEL), 0.05),
        'final_norm': 1.0 + nrm(ks[4], (D_MODEL,), 0.05),
        'a_w_qkv': nrm(ks[5], (N_A_LAYERS, D_MODEL, A_QKV_WIDTH), D_MODEL ** -0.5),
        'a_b_qkv': nrm(ks[6], (N_A_LAYERS, A_QKV_WIDTH), 0.02),
        'a_sinks': nrm(ks[7], (N_A_LAYERS, N_HEADS), 1.0),
        'a_w_o': nrm(ks[8], (N_A_LAYERS, ATTN_WIDTH, D_MODEL), ATTN_WIDTH ** -0.5 * res_scale),
        'a_b_o': nrm(ks[9], (N_A_LAYERS, D_MODEL), 0.02),
        'b_w_in': nrm(ks[10], (N_B_LAYERS, D_MODEL, B_IN_WIDTH), D_MODEL ** -0.5),
        'b_cmp_pos': nrm(ks[11], (N_B_LAYERS, 2, CMP_BLOCK, HEAD_DIM), 0.1),
        'b_cmp_w1': nrm(ks[12], (N_B_LAYERS, 2, CMP_BLOCK * HEAD_DIM, CMP_HIDDEN), (CMP_BLOCK * HEAD_DIM) ** -0.5),
        'b_cmp_w2': nrm(ks[13], (N_B_LAYERS, 2, CMP_HIDDEN, HEAD_DIM), CMP_HIDDEN ** -0.5),
        'b_w_o': nrm(ks[14], (N_B_LAYERS, ATTN_WIDTH, D_MODEL), ATTN_WIDTH ** -0.5 * res_scale),
        'ffn_w_gu': nrm(ks[15], (DEPTH, D_MODEL, 2 * D_FF), D_MODEL ** -0.5),
        'ffn_w_down': nrm(ks[16], (DEPTH, D_FF, D_MODEL), D_FF ** -0.5 * res_scale),
    }


def reference(x, rel_table, attn_norm, ffn_norm, final_norm, a_w_qkv, a_b_qkv, a_sinks, a_w_o, a_b_o,
              b_w_in, b_cmp_pos, b_cmp_w1, b_cmp_w2, b_w_o, ffn_w_gu, ffn_w_down):
    h = x
    for layer in range(DEPTH):
        hn = rms_norm(h, attn_norm[layer])
        j = layer // N_MIXERS
        if layer % N_MIXERS == 0:
            h = h + swa_sink_mixer(hn, a_w_qkv[j], a_b_qkv[j], a_sinks[j], a_w_o[j], a_b_o[j], rel_table)
        else:
            h = h + nsa_mixer(hn, b_w_in[j], b_cmp_pos[j], b_cmp_w1[j], b_cmp_w2[j], b_w_o[j], rel_table)
        h = h + swiglu(rms_norm(h, ffn_norm[layer]), ffn_w_gu[layer], ffn_w_down[layer])
    return rms_norm(h, final_norm)
```

```cpp
#include <hip/hip_runtime.h>
#include <cstdio>
#include <cstdint>

#ifndef MK_ONE_LAUNCH
#define MK_ONE_LAUNCH 0
#endif

#define GAS __attribute__((address_space(1)))
#define LAS __attribute__((address_space(3)))
typedef unsigned short bf16_t;
typedef short bf16x8 __attribute__((ext_vector_type(8)));
typedef float f32x4 __attribute__((ext_vector_type(4)));
typedef float f32x16 __attribute__((ext_vector_type(16)));
typedef unsigned u32x4 __attribute__((ext_vector_type(4)));
typedef unsigned u32x2 __attribute__((ext_vector_type(2)));

constexpr int BATCH = 8, SEQ = 2048, DM = 1024, NH = 16, HD = 64, M = BATCH * SEQ;
constexpr int AQKV = 1280;
constexpr int BIN = 1840;
constexpr int BINP = 2048;
constexpr int PROJW = 1792;
constexpr int DFF = 2816;
constexpr int NC = 127;
constexpr int NSEL = 32;
constexpr int NWAVES = 8, NTHR = 512;
constexpr float RMS_EPS = 1e-6f;
constexpr float NEG_BIG = -1e30f;

constexpr size_t MiB = 1u << 20;
constexpr size_t WS_CTL = 0, CTL_ZERO_BYTES = 1 * MiB;
constexpr size_t WS_BIASD = 1 * MiB;
constexpr size_t WS_C1 = WS_BIASD + 128 * 1024;
constexpr size_t WS_KCVC = WS_C1 + 4096;
constexpr size_t WS_SELM = WS_KCVC + 512 * 1024;
constexpr size_t WS_GATES = 4 * MiB;
constexpr size_t WS_WQKVA = 8 * MiB;
constexpr size_t WS_WOA = WS_WQKVA + 3 * MiB;
constexpr size_t WS_WIN = WS_WOA + 2 * MiB;
constexpr size_t WS_WOB = WS_WIN + 4 * MiB;
constexpr size_t WS_WGU = WS_WOB + 2 * MiB;
constexpr size_t WS_WDN = WS_WGU + 22 * MiB;
constexpr size_t WS_CW1 = WS_WDN + 11 * MiB;
constexpr size_t WS_CW2 = WS_CW1 + 2 * MiB;
constexpr size_t WS_XA = 56 * MiB;
constexpr size_t WS_QKV = 88 * MiB;
constexpr size_t WS_O = 144 * MiB;
constexpr size_t WS_HID = WS_QKV;
constexpr size_t WS_OCOMB = 176 * MiB;
constexpr size_t WS_END = 240 * MiB;
static_assert(WS_CW2 + 64 * 1024 <= WS_XA, "weights fit");
static_assert(WS_SELM + 128 * 1024 <= WS_GATES, "small region");
constexpr int CW_BAR = 4096;

constexpr int LDS_MAIN = 147456;
constexpr int MISC_OFF = LDS_MAIN;
constexpr int LDS_BYTES = LDS_MAIN + 128;

#define RLX_AGENT __ATOMIC_RELAXED, __HIP_MEMORY_SCOPE_AGENT
__device__ __forceinline__ unsigned f2bf(float f) { unsigned u = __builtin_bit_cast(unsigned, f); return (u + 0x7fffu + ((u >> 16) & 1u)) >> 16; }
__device__ __forceinline__ unsigned pk2(float lo, float hi) { return f2bf(lo) | (f2bf(hi) << 16); }
__device__ __forceinline__ float bf2f(unsigned short b) { return __builtin_bit_cast(float, (unsigned)b << 16); }
__device__ __forceinline__ float bflo(unsigned w) { return __builtin_bit_cast(float, w << 16); }
__device__ __forceinline__ float bfhi(unsigned w) { return __builtin_bit_cast(float, w & 0xffff0000u); }
__device__ __forceinline__ float wave_sum(float v) {
#pragma unroll
    for (int o = 1; o < 64; o <<= 1) v += __shfl_xor(v, o);
    return v;
}
__device__ __forceinline__ float wave_max(float v) {
#pragma unroll
    for (int o = 1; o < 64; o <<= 1) v = fmaxf(v, __shfl_xor(v, o));
    return v;
}

#define XB_TMO      128
#define XB_XCNT(j)  (256  + 64 * (j))
#define XB_XSUB(j)  (1280 + 64 * (j))
#define XB_XGEN(j)  (2304 + 64 * (j))
#define XB_TOP      3328
#define XB_TOPGEN   3392
#define XCD_BAR_WORDS 3456
#define XB_SPIN_CAP (1u << 25)
__device__ __forceinline__ unsigned xb_ld(unsigned* p)              { return __hip_atomic_load(p, __ATOMIC_RELAXED, __HIP_MEMORY_SCOPE_AGENT); }
__device__ __forceinline__ unsigned xb_add(unsigned* p, unsigned v) { return __hip_atomic_fetch_add(p, v, __ATOMIC_RELAXED, __HIP_MEMORY_SCOPE_AGENT); }
__device__ __forceinline__ unsigned xb_xcc_id() { return (unsigned)__builtin_amdgcn_s_getreg((3 << 11) | 20) & 0xFu; }
#define XB_SPIN(cond, bar) do { unsigned _sp = 0; while (cond) { __builtin_amdgcn_s_sleep(1); \
    if ((++_sp & 255u) == 0u) { if (xb_ld(&(bar)[XB_TMO])) break; if (_sp > XB_SPIN_CAP) { atomicAdd(&(bar)[XB_TMO], 1u); break; } } } } while (0)
struct XcdBarrier { unsigned* bar; unsigned x; volatile LAS unsigned* st; };
__device__ __forceinline__ XcdBarrier xcd_barrier_post(unsigned* bar, volatile LAS unsigned* st) {
    XcdBarrier b; b.bar = bar; b.x = xb_xcc_id(); b.st = st;
    if (threadIdx.x == 0) (void)xb_add(&bar[XB_XCNT(b.x)], 1u);
    return b;
}
__device__ __forceinline__ void xcd_barrier_complete(unsigned* bar, unsigned x, unsigned& nloc, unsigned& nx) {
    const unsigned G = gridDim.x * gridDim.y * gridDim.z;
    unsigned sum, cnt, mine, sp = 0u;
    for (;;) {
        sum = 0u; cnt = 0u; mine = 0u;
#pragma unroll
        for (unsigned j = 0; j < 16; ++j) { const unsigned c = xb_ld(&bar[XB_XCNT(j)]); sum += c; cnt += (c > 0u) ? 1u : 0u; mine = (j == x) ? c : mine; }
        if (sum == G) break;
        __builtin_amdgcn_s_sleep(1);
        if ((++sp & 255u) == 0u) { if (xb_ld(&bar[XB_TMO])) break; if (sp > XB_SPIN_CAP) { atomicAdd(&bar[XB_TMO], 1u); break; } }
    }
    nloc = mine > 0u ? mine : 1u; nx = cnt > 0u ? cnt : 1u;
}
__device__ __forceinline__ void xcd_barrier(const XcdBarrier& b) {
    asm volatile("s_waitcnt vmcnt(0)" ::: "memory");
    __syncthreads();
    if (threadIdx.x == 0) {
        unsigned* bar = b.bar;
        __builtin_amdgcn_s_waitcnt(0);
        unsigned nloc = b.st[0], nx = b.st[1];
        if (nloc == 0u) { xcd_barrier_complete(bar, b.x, nloc, nx); b.st[0] = nloc; b.st[1] = nx; }
        const unsigned old = xb_add(&bar[XB_XSUB(b.x)], 1u);
        const unsigned gen = old / nloc;
        if (old + 1u == (gen + 1u) * nloc) {
            __builtin_amdgcn_fence(__ATOMIC_RELEASE, "agent");
            asm volatile("s_waitcnt vmcnt(0)" ::: "memory");
            const unsigned og = xb_add(&bar[XB_TOP], 1u);
            const unsigned tg = og / nx;
            if (og + 1u == (tg + 1u) * nx) xb_add(&bar[XB_TOPGEN], 1u);
            else XB_SPIN(xb_ld(&bar[XB_TOPGEN]) == tg, bar);
            __builtin_amdgcn_fence(__ATOMIC_ACQUIRE, "agent");
            xb_add(&bar[XB_XGEN(b.x)], 1u);
            asm volatile("s_waitcnt vmcnt(0)" ::: "memory");
        } else {
            XB_SPIN(xb_ld(&bar[XB_XGEN(b.x)]) == gen, bar);
            __builtin_amdgcn_fence(__ATOMIC_ACQUIRE, "agent");
            asm volatile("s_waitcnt vmcnt(0)" ::: "memory");
        }
    }
    __syncthreads();
}

struct Args { const float* in[17]; float* out; unsigned char* ws; int ph_lo, ph_hi, li, pad; };
struct Frame {
    LAS unsigned char* lds;
    int tid, lane, wave, G, bid;
    int gw, ngw;
    const float* in[17]; float* out; unsigned char* ws;
};

__device__ __forceinline__ int t5_bucket(int n) {
    if (n < 16) return n;
    const float nf = (float)n;
    const int lb = 16 + (int)(logf(nf / 16.0f) / 4.1588830833596715f * 16.0f);
    return lb < 31 ? lb : 31;
}

struct RmPlain { int off; float s; __device__ int row(int n) const { return n + off; } __device__ float scale(int) const { return s; } };
struct RmQScale { int nq; __device__ int row(int n) const { return n; } __device__ float scale(int n) const { return n < nq ? 0.125f : 1.0f; } };
struct RmGU { __device__ int row(int n) const { const int up = n >= DFF; const int f = up ? n - DFF : n; return (f >> 7) * 256 + (up ? 128 : 0) + (f & 127); } __device__ float scale(int) const { return 1.0f; } };

template <class RM>
__device__ __forceinline__ void transpose_item(const float* W, int K, int N, bf16_t* WT, LAS float* scr, int item, int lane, const RM rm) {
    const int nblk = (N + 31) / 32, kb = item / nblk, nb = item % nblk, k0 = 64 * kb, n0 = 32 * nb;
    const int nl = n0 + (lane & 31);
#pragma unroll 8
    for (int i = 0; i < 32; ++i) { const int kk = 2 * i + (lane >> 5); scr[kk * 33 + (lane & 31)] = (nl < N) ? W[(size_t)(k0 + kk) * N + nl] : 0.f; }
    asm volatile("s_waitcnt lgkmcnt(0)" ::: "memory");
    const int c = lane & 7;
#pragma unroll
    for (int j = 0; j < 4; ++j) { const int nn = (lane >> 3) + 8 * j; const int n = n0 + nn; const LAS float* s = scr + (8 * c) * 33 + nn;
        if (n < N) { const float sc = rm.scale(n);
            u32x4 o; o.x = pk2(s[0 * 33] * sc, s[1 * 33] * sc); o.y = pk2(s[2 * 33] * sc, s[3 * 33] * sc); o.z = pk2(s[4 * 33] * sc, s[5 * 33] * sc); o.w = pk2(s[6 * 33] * sc, s[7 * 33] * sc);
            *(u32x4*)(WT + (size_t)rm.row(n) * K + k0 + 8 * c) = o; } }
    asm volatile("s_waitcnt lgkmcnt(0)" ::: "memory");
}
template <class RM>
__device__ __forceinline__ void transpose_all(Frame& F, const float* W, int K, int N, bf16_t* WT, const RM rm) {
    LAS float* scr = (LAS float*)(F.lds + F.wave * 16384);
    const int nitems = (K / 64) * ((N + 31) / 32);
    for (int it = F.gw; it < nitems; it += F.ngw) transpose_item(W, K, N, WT, scr, it, F.lane, rm);
}
__device__ __forceinline__ void rms_row_to_bf16(const float* xrow, const float* g, bf16_t* orow, int lane) {
    const f32x4* xr = (const f32x4*)xrow + lane; const f32x4* gr = (const f32x4*)g + lane;
    f32x4 v[4]; float s = 0.f;
#pragma unroll
    for (int j = 0; j < 4; ++j) { v[j] = xr[64 * j]; s += (v[j].x * v[j].x + v[j].y * v[j].y) + (v[j].z * v[j].z + v[j].w * v[j].w); }
    const float rstd = 1.0f / sqrtf(wave_sum(s) * (1.0f / DM) + RMS_EPS);
    unsigned long long* o8 = (unsigned long long*)orow + lane;
#pragma unroll
    for (int j = 0; j < 4; ++j) { const f32x4 gg = gr[64 * j];
        o8[64 * j] = (unsigned long long)pk2(v[j].x * rstd * gg.x, v[j].y * rstd * gg.y) | ((unsigned long long)pk2(v[j].z * rstd * gg.z, v[j].w * rstd * gg.w) << 32); }
}
__device__ __forceinline__ void norm_phase(Frame& F, const float* H, const float* g, bf16_t* XA) {
    for (int m = F.gw; m < M; m += F.ngw) rms_row_to_bf16(H + (size_t)m * DM, g, XA + (size_t)m * DM, F.lane);
}
__device__ __forceinline__ void final_norm_phase(Frame& F, float* H, const float* g) {
    for (int m = F.gw; m < M; m += F.ngw) {
        f32x4* xr = (f32x4*)(H + (size_t)m * DM) + F.lane; const f32x4* gr = (const f32x4*)g + F.lane;
        f32x4 v[4]; float s = 0.f;
#pragma unroll
        for (int j = 0; j < 4; ++j) { v[j] = xr[64 * j]; s += (v[j].x * v[j].x + v[j].y * v[j].y) + (v[j].z * v[j].z + v[j].w * v[j].w); }
        const float rstd = 1.0f / sqrtf(wave_sum(s) * (1.0f / DM) + RMS_EPS);
#pragma unroll
        for (int j = 0; j < 4; ++j) { const f32x4 gg = gr[64 * j]; f32x4 o; o.x = v[j].x * rstd * gg.x; o.y = v[j].y * rstd * gg.y; o.z = v[j].z * rstd * gg.z; o.w = v[j].w * rstd * gg.w; xr[64 * j] = o; }
    }
}
__device__ __forceinline__ void p0_prologue(Frame& F) {
    unsigned char* ws = F.ws;
    transpose_all(F, F.in[5], DM, AQKV, (bf16_t*)(ws + WS_WQKVA), RmQScale{1024});
    transpose_all(F, F.in[8], DM, DM, (bf16_t*)(ws + WS_WOA), RmPlain{0, 1.f});
    transpose_all(F, F.in[10], DM, BIN, (bf16_t*)(ws + WS_WIN), RmQScale{1024});
    transpose_all(F, F.in[14], DM, DM, (bf16_t*)(ws + WS_WOB), RmPlain{0, 1.f});
    for (int l = 0; l < 2; ++l) {
        transpose_all(F, F.in[15] + (size_t)l * DM * 2 * DFF, DM, 2 * DFF, (bf16_t*)(ws + WS_WGU) + (size_t)l * 2 * DFF * DM, RmGU{});
        transpose_all(F, F.in[16] + (size_t)l * DFF * DM, DFF, DM, (bf16_t*)(ws + WS_WDN) + (size_t)l * DM * DFF, RmPlain{0, 1.f});
        transpose_all(F, F.in[12] + (size_t)l * 2048 * 256, 2048, 256, (bf16_t*)(ws + WS_CW1) + (size_t)l * 256 * 2048, RmPlain{0, 1.f});
        transpose_all(F, F.in[13] + (size_t)l * 256 * 64, 256, 64, (bf16_t*)(ws + WS_CW2) + (size_t)l * 64 * 256, RmPlain{0, 1.f});
    }
    { u32x4* z = (u32x4*)((bf16_t*)(ws + WS_WIN) + (size_t)BIN * DM); const int n16 = (BINP - BIN) * DM * 2 / 16;
      for (int i = F.bid * NTHR + F.tid; i < n16; i += F.G * NTHR) z[i] = (u32x4){0u, 0u, 0u, 0u}; }
    { float* bd = (float*)(ws + WS_BIASD); const float* rt = F.in[1];
      for (int i = F.bid * NTHR + F.tid; i < 2048 * 16; i += F.G * NTHR) { const int d = i >> 4, h = i & 15; bd[i] = rt[t5_bucket(d) * 16 + h]; } }
    { float* c1 = (float*)(ws + WS_C1);
      for (int o = F.gw; o < 512; o += F.ngw) { const int kv = o >> 8, n = o & 255; const float* pos = F.in[11] + kv * 2048; const float* w1 = F.in[12] + (size_t)kv * 2048 * 256;
          float s = 0.f; for (int k = F.lane; k < 2048; k += 64) s += pos[k] * w1[(size_t)k * 256 + n];
          s = wave_sum(s); if (F.lane == 0) c1[o] = s; } }
    norm_phase(F, F.in[0], F.in[2], (bf16_t*)(ws + WS_XA));
}

template <bool DUAL, class Epi>
__device__ __forceinline__ void gemm_simple(Frame& F, const bf16_t* A, int lda, const bf16_t* Bt, int K, int nfeat_tiles, const Epi& E) {
    const int lane = F.lane, r32 = lane & 31, hi = lane >> 5;
    const int ntiles = (M / 64) * nfeat_tiles;
    for (int t = F.gw; t < ntiles; t += F.ngw) {
        const int mt = t / nfeat_tiles, ft = t % nfeat_tiles;
        const int m0 = mt * 64;
        int brow0, brow1, f0;
        if (DUAL) { f0 = ft * 32; brow0 = (f0 >> 7) * 256 + (f0 & 127); brow1 = brow0 + 128; }
        else { f0 = ft * 64; brow0 = f0; brow1 = f0 + 32; }
        const bf16_t* a0 = A + (size_t)(m0 + r32) * lda + 8 * hi; const bf16_t* a1 = a0 + (size_t)32 * lda;
        const bf16_t* b0 = Bt + (size_t)(brow0 + r32) * K + 8 * hi; const bf16_t* b1 = Bt + (size_t)(brow1 + r32) * K + 8 * hi;
        f32x16 acc00 = {}, acc01 = {}, acc10 = {}, acc11 = {};
#pragma unroll 4
        for (int k = 0; k < K; k += 16) {
            const bf16x8 fa0 = *(const bf16x8*)(a0 + k), fa1 = *(const bf16x8*)(a1 + k), fb0 = *(const bf16x8*)(b0 + k), fb1 = *(const bf16x8*)(b1 + k);
            acc00 = __builtin_amdgcn_mfma_f32_32x32x16_bf16(fa0, fb0, acc00, 0, 0, 0);
            acc01 = __builtin_amdgcn_mfma_f32_32x32x16_bf16(fa0, fb1, acc01, 0, 0, 0);
            acc10 = __builtin_amdgcn_mfma_f32_32x32x16_bf16(fa1, fb0, acc10, 0, 0, 0);
            acc11 = __builtin_amdgcn_mfma_f32_32x32x16_bf16(fa1, fb1, acc11, 0, 0, 0);
        }
#pragma unroll
        for (int r = 0; r < 16; ++r) {
            const int row = m0 + (r & 3) + 8 * (r >> 2) + 4 * hi;
            if (DUAL) { E(row, f0 + r32, acc00[r], acc01[r]); E(row + 32, f0 + r32, acc10[r], acc11[r]); }
            else { E(row, f0 + r32, acc00[r], 0.f); E(row, f0 + 32 + r32, acc01[r], 0.f); E(row + 32, f0 + r32, acc10[r], 0.f); E(row + 32, f0 + 32 + r32, acc11[r], 0.f); }
        }
    }
}
struct EpiQkvA { bf16_t* O; const float* bias; __device__ void operator()(int m, int n, float v, float) const { const float b = bias[n] * (n < 1024 ? 0.125f : 1.0f); O[(size_t)m * AQKV + n] = (bf16_t)f2bf(v + b); } };
struct EpiResid { const float* base; float* out; const float* bias; __device__ void operator()(int m, int n, float v, float) const { const size_t i = (size_t)m * DM + n; out[i] = base[i] + v + (bias ? bias[n] : 0.f); } };
struct EpiSwiglu { bf16_t* O; __device__ void operator()(int m, int f, float g, float u) const { const float s = g / (1.0f + __expf(-g)); O[(size_t)m * DFF + f] = (bf16_t)f2bf(s * u); } };
struct EpiWin { bf16_t* P; float* gates; __device__ void operator()(int m, int n, float v, float) const {
    if (n < PROJW) P[(size_t)m * PROJW + n] = (bf16_t)f2bf(v);
    else if (n < BIN) gates[(size_t)m * 48 + (n - PROJW)] = 1.0f / (1.0f + __expf(-v)); } };

struct KVsrc { const bf16_t* base; int pitch; int koff, voff; };
template <int MODE  >
__device__ __forceinline__ void attn_simple(Frame& F, const bf16_t* Q, int qpitch, KVsrc kv, const float* biasD, const float* sinks, const float* gates, const unsigned* selm, float* Ocomb, bf16_t* O) {
    const int nitems = M * NH / NTHR;
    for (int it = F.bid; it < nitems; it += F.G) {
        const int idx = it * NTHR + F.tid; const int m = idx >> 4, h = idx & 15, g = h >> 3;
        const int b = m / SEQ, t = m % SEQ;
        float q[64];
        { const u32x4* qp = (const u32x4*)(Q + (size_t)m * qpitch + h * 64);
#pragma unroll
          for (int c = 0; c < 8; ++c) { const u32x4 w = qp[c]; q[8 * c + 0] = bflo(w.x); q[8 * c + 1] = bfhi(w.x); q[8 * c + 2] = bflo(w.y); q[8 * c + 3] = bfhi(w.y); q[8 * c + 4] = bflo(w.z); q[8 * c + 5] = bfhi(w.z); q[8 * c + 6] = bflo(w.w); q[8 * c + 7] = bfhi(w.w); } }
        float o[64];
#pragma unroll
        for (int d = 0; d < 64; ++d) o[d] = 0.f;
        float mx = -1e20f, l = 0.f;
        unsigned sm = 0xffffffffu; int s_lo = 0;
        if (MODE == 0) s_lo = t - 127 > 0 ? t - 127 : 0;
        if (MODE == 2) s_lo = t - 511 > 0 ? t - 511 : 0;
        if (MODE == 1) sm = selm[(size_t)(b * 2 + g) * SEQ + t];
        const bf16_t* kb = kv.base + (size_t)b * SEQ * kv.pitch + kv.koff + g * 64;
        const bf16_t* vb = kv.base + (size_t)b * SEQ * kv.pitch + kv.voff + g * 64;
        for (int s = s_lo; s <= t; ++s) {
            if (MODE == 1) { if (!((sm >> (s >> 6)) & 1u)) { s |= 63; continue; } }
            const u32x4* kp = (const u32x4*)(kb + (size_t)s * kv.pitch);
            float dot = 0.f;
#pragma unroll
            for (int c = 0; c < 8; ++c) { const u32x4 w = kp[c];
                dot += q[8 * c + 0] * bflo(w.x) + q[8 * c + 1] * bfhi(w.x) + q[8 * c + 2] * bflo(w.y) + q[8 * c + 3] * bfhi(w.y) + q[8 * c + 4] * bflo(w.z) + q[8 * c + 5] * bfhi(w.z) + q[8 * c + 6] * bflo(w.w) + q[8 * c + 7] * bfhi(w.w); }
            const float sc = dot + biasD[(t - s) * 16 + h];
            const float mn = fmaxf(mx, sc); const float al = __expf(mx - mn), p = __expf(sc - mn);
            l = l * al + p; mx = mn;
            const u32x4* vp = (const u32x4*)(vb + (size_t)s * kv.pitch);
#pragma unroll
            for (int c = 0; c < 8; ++c) { const u32x4 w = vp[c];
                o[8 * c + 0] = o[8 * c + 0] * al + p * bflo(w.x); o[8 * c + 1] = o[8 * c + 1] * al + p * bfhi(w.x); o[8 * c + 2] = o[8 * c + 2] * al + p * bflo(w.y); o[8 * c + 3] = o[8 * c + 3] * al + p * bfhi(w.y);
                o[8 * c + 4] = o[8 * c + 4] * al + p * bflo(w.z); o[8 * c + 5] = o[8 * c + 5] * al + p * bfhi(w.z); o[8 * c + 6] = o[8 * c + 6] * al + p * bflo(w.w); o[8 * c + 7] = o[8 * c + 7] * al + p * bfhi(w.w); }
        }
        float inv;
        if (MODE == 0) { const float sk = sinks[h]; const float mf = fmaxf(mx, sk); const float al = __expf(mx - mf); inv = al / (l * al + __expf(sk - mf)); }
        else inv = (l > 0.f ? 1.0f / l : 0.f) * gates[(size_t)m * 48 + h * 3 + MODE];
        const size_t ob = (size_t)m * DM + h * 64;
        if (MODE == 1) {
#pragma unroll
            for (int c = 0; c < 16; ++c) { f32x4 a = *(f32x4*)(Ocomb + ob + 4 * c); a.x += o[4 * c] * inv; a.y += o[4 * c + 1] * inv; a.z += o[4 * c + 2] * inv; a.w += o[4 * c + 3] * inv; *(f32x4*)(Ocomb + ob + 4 * c) = a; }
        } else {
#pragma unroll
            for (int c = 0; c < 8; ++c) { float e[8];
#pragma unroll
                for (int j = 0; j < 8; ++j) e[j] = o[8 * c + j] * inv;
                if (MODE == 2) { const f32x4 a0 = *(const f32x4*)(Ocomb + ob + 8 * c), a1 = *(const f32x4*)(Ocomb + ob + 8 * c + 4); e[0] += a0.x; e[1] += a0.y; e[2] += a0.z; e[3] += a0.w; e[4] += a1.x; e[5] += a1.y; e[6] += a1.z; e[7] += a1.w; }
                u32x4 w; w.x = pk2(e[0], e[1]); w.y = pk2(e[2], e[3]); w.z = pk2(e[4], e[5]); w.w = pk2(e[6], e[7]); *(u32x4*)(O + ob + 8 * c) = w; }
        }
    }
}

__device__ __forceinline__ float gelu_tanh(float x) { const float u = 0.7978845608028654f * (x + 0.044715f * x * x * x); const float e = __expf(2.0f * u); const float th = 1.0f - 2.0f / (e + 1.0f); return 0.5f * x * (1.0f + th); }
__device__ __forceinline__ void compress_simple(Frame& F) {
    unsigned char* ws = F.ws;
    const bf16_t* P = (const bf16_t*)(ws + WS_QKV);
    LAS float* xs = (LAS float*)F.lds;
    LAS float* hs = xs + 2048;
    LAS float* part = hs + 256;
    const int nitems = 2 * BATCH * 2 * NC;
    for (int it = F.bid; it < nitems; it += F.G) {
        const int c = it % NC, g = (it / NC) & 1, b = (it / (NC * 2)) % BATCH, kvi = it / (NC * 2 * BATCH);
        __syncthreads();
        { const int l = F.tid >> 4, d4 = (F.tid & 15) * 4; const bf16_t* src = P + (size_t)(b * SEQ + 16 * c + l) * PROJW + 1024 + kvi * 128 + g * 64 + d4;
          const u32x2 w = *(const u32x2*)src; xs[l * 64 + d4] = bflo(w.x); xs[l * 64 + d4 + 1] = bfhi(w.x); xs[l * 64 + d4 + 2] = bflo(w.y); xs[l * 64 + d4 + 3] = bfhi(w.y); }
        __syncthreads();
        { const int n = F.tid & 255, half = F.tid >> 8; const bf16_t* w1 = (const bf16_t*)(ws + WS_CW1) + (size_t)kvi * 256 * 2048 + (size_t)n * 2048 + half * 1024;
          float s = 0.f;
          for (int k = 0; k < 1024; k += 8) { const u32x4 w = *(const u32x4*)(w1 + k); const LAS float* x = xs + half * 1024 + k;
              s += x[0] * bflo(w.x) + x[1] * bfhi(w.x) + x[2] * bflo(w.y) + x[3] * bfhi(w.y) + x[4] * bflo(w.z) + x[5] * bfhi(w.z) + x[6] * bflo(w.w) + x[7] * bfhi(w.w); }
          part[F.tid] = s; }
        __syncthreads();
        if (F.tid < 256) hs[F.tid] = gelu_tanh(part[F.tid] + part[F.tid + 256] + ((const float*)(ws + WS_C1))[kvi * 256 + F.tid]);
        __syncthreads();
        if (F.tid < 64) { const bf16_t* w2 = (const bf16_t*)(ws + WS_CW2) + (size_t)kvi * 64 * 256 + (size_t)F.tid * 256; float s = 0.f;
            for (int n = 0; n < 256; n += 2) { const unsigned w = *(const unsigned*)(w2 + n); s += hs[n] * bflo(w) + hs[n + 1] * bfhi(w); }
            ((bf16_t*)(ws + WS_KCVC))[((size_t)((kvi * BATCH + b) * 2 + g) * 128 + c) * 64 + F.tid] = (bf16_t)f2bf(s); }
    }
}

__device__ __forceinline__ void cmp_simple(Frame& F) {
    unsigned char* ws = F.ws;
    const bf16_t* P = (const bf16_t*)(ws + WS_QKV);
    const float* biasD = (const float*)(ws + WS_BIASD);
    const float* gates = (const float*)(ws + WS_GATES);
    float* Ocomb = (float*)(ws + WS_OCOMB);
    unsigned* selm = (unsigned*)(ws + WS_SELM);
    LAS float* Pl = (LAS float*)F.lds;
    LAS float* sc = Pl + 1024;
    const int nitems = BATCH * 2 * SEQ;
    for (int it = F.bid; it < nitems; it += F.G) {
        const int t = it % SEQ, g = (it / SEQ) & 1, b = it / (SEQ * 2);
        const int m = b * SEQ + t, hh = F.wave, h = g * 8 + hh, lane = F.lane;
        const bf16_t* kc = (const bf16_t*)(ws + WS_KCVC) + (size_t)((0 * BATCH + b) * 2 + g) * 128 * 64;
        const bf16_t* vc = (const bf16_t*)(ws + WS_KCVC) + (size_t)((1 * BATCH + b) * 2 + g) * 128 * 64;
        const bf16_t* qp = P + (size_t)m * PROJW + h * 64;
        __syncthreads();
        float s2[2];
#pragma unroll
        for (int u = 0; u < 2; ++u) { const int c = lane + 64 * u; float dot = 0.f; const bool valid = (c < NC) && (16 * c + 31 <= t);
            if (valid) { const u32x4* kp = (const u32x4*)(kc + (size_t)c * 64); const u32x4* qq = (const u32x4*)qp;
#pragma unroll
                for (int j = 0; j < 8; ++j) { const u32x4 a = qq[j], w = kp[j];
                    dot += bflo(a.x) * bflo(w.x) + bfhi(a.x) * bfhi(w.x) + bflo(a.y) * bflo(w.y) + bfhi(a.y) * bfhi(w.y) + bflo(a.z) * bflo(w.z) + bfhi(a.z) * bfhi(w.z) + bflo(a.w) * bflo(w.w) + bfhi(a.w) * bfhi(w.w); }
                dot += biasD[(t - 16 * c - 31) * 16 + h]; }
            s2[u] = valid ? dot : NEG_BIG; }
        const float mx = wave_max(fmaxf(s2[0], s2[1]));
        const float e0 = s2[0] > -1e29f ? __expf(s2[0] - mx) : 0.f, e1 = s2[1] > -1e29f ? __expf(s2[1] - mx) : 0.f;
        const float l = wave_sum(e0 + e1); const float inv = l > 0.f ? 1.0f / l : 0.f;
        Pl[hh * 128 + lane] = e0 * inv; Pl[hh * 128 + 64 + lane] = e1 * inv;
        __syncthreads();
        { float o = 0.f; const int cmax = (t - 31) >= 0 ? (t - 31) / 16 : -1;
          for (int c = 0; c <= cmax && c < NC; ++c) o += Pl[hh * 128 + c] * bf2f(vc[(size_t)c * 64 + lane]);
          Ocomb[(size_t)m * DM + h * 64 + lane] = o * gates[(size_t)m * 48 + h * 3 + 0]; }
        if (F.tid < 32) { const int j = F.tid, cur = t >> 6; float imp = 0.f;
            for (int c = 4 * j - 1; c <= 4 * j + 3; ++c) if (c >= 0 && c < NC) { float a = 0.f;
#pragma unroll
                for (int q = 0; q < 8; ++q) a += Pl[q * 128 + c];
                imp += a; }
            const bool forced = (j == 0) || (cur - j >= 0 && cur - j < 2);
            sc[j] = forced ? 1e6f : (j <= cur ? imp : -1.0f); }
        __syncthreads();
        if (F.tid < 32) { const int j = F.tid; const float mine = sc[j]; int rank = 0;
            for (int k = 0; k < 32; ++k) { const float o = sc[k]; rank += (o > mine || (o == mine && k < j)) ? 1 : 0; }
            const unsigned long long bal = __ballot(rank < 16);
            if (j == 0) selm[(size_t)(b * 2 + g) * SEQ + t] = (unsigned)bal; }
    }
}

constexpr int NPHASES = 17;
__global__ void __launch_bounds__(NTHR, 2) trunk_fwd(Args args) {
    extern __shared__ __attribute__((aligned(16))) unsigned char lds[];
    Frame F;
    F.lds = (LAS unsigned char*)lds;
    F.tid = threadIdx.x; F.lane = F.tid & 63; F.wave = __builtin_amdgcn_readfirstlane(F.tid >> 6);
    F.G = gridDim.x; F.bid = blockIdx.x; F.gw = F.bid * NWAVES + F.wave; F.ngw = F.G * NWAVES;
#pragma unroll
    for (int i = 0; i < 17; ++i) F.in[i] = args.in[i];
    F.out = args.out; F.ws = args.ws;
    unsigned char* ws = args.ws;
    volatile LAS unsigned* MISC = (volatile LAS unsigned*)(F.lds + MISC_OFF);
    if (F.tid < 32) MISC[F.tid] = 0u;
    __syncthreads();
    unsigned* barw = (unsigned*)(ws + WS_CTL) + CW_BAR + args.li * XCD_BAR_WORDS;
    XcdBarrier bar; bar.bar = barw; bar.x = 0; bar.st = nullptr;
    const int lo = args.ph_lo, hi = args.ph_hi;
    if (hi - lo > 1) bar = xcd_barrier_post(barw, MISC + 8);
#define IN(k) (lo <= (k) && (k) < hi)
#define SEAM(k) do { if (IN(k) && IN((k) + 1)) xcd_barrier(bar); } while (0)

    bf16_t* XA = (bf16_t*)(ws + WS_XA); bf16_t* QKV = (bf16_t*)(ws + WS_QKV); bf16_t* Ob = (bf16_t*)(ws + WS_O); bf16_t* HID = (bf16_t*)(ws + WS_HID);
    float* Hres = F.out; float* Ocomb = (float*)(ws + WS_OCOMB); float* gates = (float*)(ws + WS_GATES);
    const float* biasD = (const float*)(ws + WS_BIASD);

    if (IN(0)) { p0_prologue(F); } SEAM(0);
    if (IN(1)) { gemm_simple<false>(F, XA, DM, (const bf16_t*)(ws + WS_WQKVA), DM, AQKV / 64, EpiQkvA{QKV, F.in[6]}); } SEAM(1);
    if (IN(2)) { attn_simple<0>(F, QKV, AQKV, KVsrc{QKV, AQKV, 1024, 1152}, biasD, F.in[7], nullptr, nullptr, nullptr, Ob); } SEAM(2);
    if (IN(3)) { gemm_simple<false>(F, Ob, DM, (const bf16_t*)(ws + WS_WOA), DM, DM / 64, EpiResid{F.in[0], Hres, F.in[9]}); } SEAM(3);
    if (IN(4)) { norm_phase(F, Hres, F.in[3], XA); } SEAM(4);
    if (IN(5)) { gemm_simple<true>(F, XA, DM, (const bf16_t*)(ws + WS_WGU), DM, DFF / 32, EpiSwiglu{HID}); } SEAM(5);
    if (IN(6)) { gemm_simple<false>(F, HID, DFF, (const bf16_t*)(ws + WS_WDN), DFF, DM / 64, EpiResid{Hres, Hres, nullptr}); } SEAM(6);
    if (IN(7)) { norm_phase(F, Hres, F.in[2] + DM, XA); } SEAM(7);
    if (IN(8)) { gemm_simple<false>(F, XA, DM, (const bf16_t*)(ws + WS_WIN), DM, (BIN + 63) / 64, EpiWin{QKV, gates}); } SEAM(8);
    if (IN(9)) { compress_simple(F); } SEAM(9);
    if (IN(10)) { cmp_simple(F); } SEAM(10);
    if (IN(11)) { attn_simple<1>(F, QKV, PROJW, KVsrc{QKV, PROJW, 1024 + 2 * 128, 1024 + 3 * 128}, biasD, nullptr, gates, (const unsigned*)(ws + WS_SELM), Ocomb, Ob);
                  attn_simple<2>(F, QKV, PROJW, KVsrc{QKV, PROJW, 1024 + 4 * 128, 1024 + 5 * 128}, biasD, nullptr, gates, nullptr, Ocomb, Ob); } SEAM(11);
    if (IN(12)) { gemm_simple<false>(F, Ob, DM, (const bf16_t*)(ws + WS_WOB), DM, DM / 64, EpiResid{Hres, Hres, nullptr}); } SEAM(12);
    if (IN(13)) { norm_phase(F, Hres, F.in[3] + DM, XA); } SEAM(13);
    if (IN(14)) { gemm_simple<true>(F, XA, DM, (const bf16_t*)(ws + WS_WGU) + (size_t)2 * DFF * DM, DM, DFF / 32, EpiSwiglu{HID}); } SEAM(14);
    if (IN(15)) { gemm_simple<false>(F, HID, DFF, (const bf16_t*)(ws + WS_WDN) + (size_t)DM * DFF, DFF, DM / 64, EpiResid{Hres, Hres, nullptr}); } SEAM(15);
    if (IN(16)) { final_norm_phase(F, Hres, F.in[4]); }
#undef IN
#undef SEAM
}

extern "C" void kernel_launch(void* const* d_in, const int* in_sizes, int n_in, void* d_out, int out_size, void* d_ws, size_t ws_size, hipStream_t stream) {
    static int grid = 0;
    if (grid == 0) {
        if (n_in != 17 || out_size != M * DM || ws_size < WS_END) { fprintf(stderr, "kernel_launch: unexpected shapes (n_in %d out %d ws %zu)\n", n_in, out_size, ws_size); grid = -1; return; }
        int dev = 0, cus = 0, per_cu = 0;
        hipGetDevice(&dev); hipDeviceGetAttribute(&cus, hipDeviceAttributeMultiprocessorCount, dev);
        hipFuncSetAttribute((const void*)trunk_fwd, hipFuncAttributeMaxDynamicSharedMemorySize, LDS_BYTES);
        hipOccupancyMaxActiveBlocksPerMultiprocessor(&per_cu, (const void*)trunk_fwd, NTHR, LDS_BYTES);
        (void)hipGetLastError();
        if (per_cu < 1) fprintf(stderr, "kernel_launch: occupancy query says %d blocks per CU\n", per_cu);
        grid = cus > 0 ? cus : 256;
    }
    if (grid < 0) return;
    hipMemsetAsync((char*)d_ws + WS_CTL, 0, CTL_ZERO_BYTES, stream);
    Args a{};
    for (int i = 0; i < 17; ++i) a.in[i] = (const float*)d_in[i];
    a.out = (float*)d_out; a.ws = (unsigned char*)d_ws;
#if MK_ONE_LAUNCH
    a.ph_lo = 0; a.ph_hi = NPHASES; a.li = 0;
    void* kargs[] = {&a};
    hipError_t e = hipLaunchCooperativeKernel((const void*)trunk_fwd, dim3(grid), dim3(NTHR), kargs, LDS_BYTES, stream);
    if (e != hipSuccess) fprintf(stderr, "cooperative launch failed: %s\n", hipGetErrorString(e));
#else
    for (int p = 0; p < NPHASES; ++p) { a.ph_lo = p; a.ph_hi = p + 1; a.li = 0;
        hipLaunchKernelGGL(trunk_fwd, dim3(grid), dim3(NTHR), LDS_BYTES, stream, a); }
#endif
}
```

```cpp
#include <hip/hip_runtime.h>
#include <cstdio>
#include <cstdint>

#ifndef MK_ONE_LAUNCH
#define MK_ONE_LAUNCH 1
#endif

#define GAS __attribute__((address_space(1)))
#define LAS __attribute__((address_space(3)))
typedef unsigned short bf16_t;
typedef short bf16x8 __attribute__((ext_vector_type(8)));
typedef float f32x4 __attribute__((ext_vector_type(4)));
typedef float f32x16 __attribute__((ext_vector_type(16)));
typedef unsigned u32x4 __attribute__((ext_vector_type(4)));
typedef unsigned u32x2 __attribute__((ext_vector_type(2)));

constexpr int BATCH = 8, SEQ = 2048, DM = 1024, NH = 16, HD = 64, M = BATCH * SEQ;
constexpr int AQKV = 1280;
constexpr int BIN = 1840;
constexpr int BINP = 2048;
constexpr int PROJW = 1792;
constexpr int DFF = 2816;
constexpr int NC = 127;
constexpr int NSEL = 32;
constexpr int NWAVES = 8, NTHR = 512;
constexpr float RMS_EPS = 1e-6f;
constexpr float NEG_BIG = -1e30f;

constexpr size_t MiB = 1u << 20;
constexpr size_t WS_CTL = 0, CTL_ZERO_BYTES = 1 * MiB;
constexpr size_t WS_BIASD = 1 * MiB;
constexpr size_t WS_C1 = WS_BIASD + 128 * 1024;
constexpr size_t WS_KCVC = WS_C1 + 4096;
constexpr size_t WS_SELM = WS_KCVC + 512 * 1024;
constexpr size_t WS_GATES = 4 * MiB;
constexpr size_t WS_WQKVA = 8 * MiB;
constexpr size_t WS_WOA = WS_WQKVA + 3 * MiB;
constexpr size_t WS_WIN = WS_WOA + 2 * MiB;
constexpr size_t WS_WOB = WS_WIN + 4 * MiB;
constexpr size_t WS_WGU = WS_WOB + 2 * MiB;
constexpr size_t WS_WDN = WS_WGU + 22 * MiB;
constexpr size_t WS_CW1 = WS_WDN + 11 * MiB;
constexpr size_t WS_CW2 = WS_CW1 + 2 * MiB;
constexpr size_t WS_XA = 56 * MiB;
constexpr size_t WS_QKV = 88 * MiB;
constexpr size_t WS_O = 144 * MiB;
constexpr size_t WS_HID = WS_QKV;
constexpr size_t WS_OCOMB = 176 * MiB;
constexpr size_t WS_END = 240 * MiB;
static_assert(WS_CW2 + 64 * 1024 <= WS_XA, "weights fit");
static_assert(WS_SELM + 128 * 1024 <= WS_GATES, "small region");
constexpr int CW_BAR = 4096;

constexpr int LDS_MAIN = 147456;
constexpr int MISC_OFF = LDS_MAIN;
constexpr int LDS_BYTES = LDS_MAIN + 128;

#define RLX_AGENT __ATOMIC_RELAXED, __HIP_MEMORY_SCOPE_AGENT
__device__ __forceinline__ unsigned f2bf(float f) { unsigned u = __builtin_bit_cast(unsigned, f); return (u + 0x7fffu + ((u >> 16) & 1u)) >> 16; }
__device__ __forceinline__ unsigned pk2(float lo, float hi) { return f2bf(lo) | (f2bf(hi) << 16); }
__device__ __forceinline__ float bf2f(unsigned short b) { return __builtin_bit_cast(float, (unsigned)b << 16); }
__device__ __forceinline__ float bflo(unsigned w) { return __builtin_bit_cast(float, w << 16); }
__device__ __forceinline__ float bfhi(unsigned w) { return __builtin_bit_cast(float, w & 0xffff0000u); }
__device__ __forceinline__ float wave_sum(float v) {
#pragma unroll
    for (int o = 1; o < 64; o <<= 1) v += __shfl_xor(v, o);
    return v;
}
__device__ __forceinline__ float wave_max(float v) {
#pragma unroll
    for (int o = 1; o < 64; o <<= 1) v = fmaxf(v, __shfl_xor(v, o));
    return v;
}

#define XB_TMO      128
#define XB_XCNT(j)  (256  + 64 * (j))
#define XB_XSUB(j)  (1280 + 64 * (j))
#define XB_XGEN(j)  (2304 + 64 * (j))
#define XB_TOP      3328
#define XB_TOPGEN   3392
#define XCD_BAR_WORDS 3456
#define XB_SPIN_CAP (1u << 25)
__device__ __forceinline__ unsigned xb_ld(unsigned* p)              { return __hip_atomic_load(p, __ATOMIC_RELAXED, __HIP_MEMORY_SCOPE_AGENT); }
__device__ __forceinline__ unsigned xb_add(unsigned* p, unsigned v) { return __hip_atomic_fetch_add(p, v, __ATOMIC_RELAXED, __HIP_MEMORY_SCOPE_AGENT); }
__device__ __forceinline__ unsigned xb_xcc_id() { return (unsigned)__builtin_amdgcn_s_getreg((3 << 11) | 20) & 0xFu; }
#define XB_SPIN(cond, bar) do { unsigned _sp = 0; while (cond) { __builtin_amdgcn_s_sleep(1); \
    if ((++_sp & 255u) == 0u) { if (xb_ld(&(bar)[XB_TMO])) break; if (_sp > XB_SPIN_CAP) { atomicAdd(&(bar)[XB_TMO], 1u); break; } } } } while (0)
struct XcdBarrier { unsigned* bar; unsigned x; volatile LAS unsigned* st; };
__device__ __forceinline__ XcdBarrier xcd_barrier_post(unsigned* bar, volatile LAS unsigned* st) {
    XcdBarrier b; b.bar = bar; b.x = xb_xcc_id(); b.st = st;
    if (threadIdx.x == 0) (void)xb_add(&bar[XB_XCNT(b.x)], 1u);
    return b;
}
__device__ __forceinline__ void xcd_barrier_complete(unsigned* bar, unsigned x, unsigned& nloc, unsigned& nx) {
    const unsigned G = gridDim.x * gridDim.y * gridDim.z;
    unsigned sum, cnt, mine, sp = 0u;
    for (;;) {
        sum = 0u; cnt = 0u; mine = 0u;
#pragma unroll
        for (unsigned j = 0; j < 16; ++j) { const unsigned c = xb_ld(&bar[XB_XCNT(j)]); sum += c; cnt += (c > 0u) ? 1u : 0u; mine = (j == x) ? c : mine; }
        if (sum == G) break;
        __builtin_amdgcn_s_sleep(1);
        if ((++sp & 255u) == 0u) { if (xb_ld(&bar[XB_TMO])) break; if (sp > XB_SPIN_CAP) { atomicAdd(&bar[XB_TMO], 1u); break; } }
    }
    nloc = mine > 0u ? mine : 1u; nx = cnt > 0u ? cnt : 1u;
}
__device__ __forceinline__ void xcd_barrier(const XcdBarrier& b) {
    asm volatile("s_waitcnt vmcnt(0)" ::: "memory");
    __syncthreads();
    if (threadIdx.x == 0) {
        unsigned* bar = b.bar;
        __builtin_amdgcn_s_waitcnt(0);
        unsigned nloc = b.st[0], nx = b.st[1];
        if (nloc == 0u) { xcd_barrier_complete(bar, b.x, nloc, nx); b.st[0] = nloc; b.st[1] = nx; }
        const unsigned old = xb_add(&bar[XB_XSUB(b.x)], 1u);
        const unsigned gen = old / nloc;
        if (old + 1u == (gen + 1u) * nloc) {
            __builtin_amdgcn_fence(__ATOMIC_RELEASE, "agent");
            asm volatile("s_waitcnt vmcnt(0)" ::: "memory");
            const unsigned og = xb_add(&bar[XB_TOP], 1u);
            const unsigned tg = og / nx;
            if (og + 1u == (tg + 1u) * nx) xb_add(&bar[XB_TOPGEN], 1u);
            else XB_SPIN(xb_ld(&bar[XB_TOPGEN]) == tg, bar);
            __builtin_amdgcn_fence(__ATOMIC_ACQUIRE, "agent");
            xb_add(&bar[XB_XGEN(b.x)], 1u);
            asm volatile("s_waitcnt vmcnt(0)" ::: "memory");
        } else {
            XB_SPIN(xb_ld(&bar[XB_XGEN(b.x)]) == gen, bar);
            __builtin_amdgcn_fence(__ATOMIC_ACQUIRE, "agent");
            asm volatile("s_waitcnt vmcnt(0)" ::: "memory");
        }
    }
    __syncthreads();
}

struct Args { const float* in[17]; float* out; unsigned char* ws; int ph_lo, ph_hi, li, pad; };
struct Frame {
    LAS unsigned char* lds;
    int tid, lane, wave, G, bid;
    int gw, ngw;
    const float* in[17]; float* out; unsigned char* ws;
};

__device__ __forceinline__ int t5_bucket(int n) {
    if (n < 16) return n;
    const float nf = (float)n;
    const int lb = 16 + (int)(logf(nf / 16.0f) / 4.1588830833596715f * 16.0f);
    return lb < 31 ? lb : 31;
}

struct RmPlain { int off; float s; __device__ int row(int n) const { return n + off; } __device__ float scale(int) const { return s; } };
struct RmQScale { int nq; __device__ int row(int n) const { return n; } __device__ float scale(int n) const { return n < nq ? 0.125f : 1.0f; } };
struct RmGU { __device__ int row(int n) const { const int up = n >= DFF; const int f = up ? n - DFF : n; return (f >> 7) * 256 + (up ? 128 : 0) + (f & 127); } __device__ float scale(int) const { return 1.0f; } };

template <class RM>
__device__ __forceinline__ void transpose_item(const float* W, int K, int N, bf16_t* WT, LAS float* scr, int item, int lane, const RM rm) {
    const int nblk = (N + 31) / 32, kb = item / nblk, nb = item % nblk, k0 = 64 * kb, n0 = 32 * nb;
    const int nl = n0 + (lane & 31);
#pragma unroll 8
    for (int i = 0; i < 32; ++i) { const int kk = 2 * i + (lane >> 5); scr[kk * 33 + (lane & 31)] = (nl < N) ? W[(size_t)(k0 + kk) * N + nl] : 0.f; }
    asm volatile("s_waitcnt lgkmcnt(0)" ::: "memory");
    const int c = lane & 7;
#pragma unroll
    for (int j = 0; j < 4; ++j) { const int nn = (lane >> 3) + 8 * j; const int n = n0 + nn; const LAS float* s = scr + (8 * c) * 33 + nn;
        if (n < N) { const float sc = rm.scale(n);
            u32x4 o; o.x = pk2(s[0 * 33] * sc, s[1 * 33] * sc); o.y = pk2(s[2 * 33] * sc, s[3 * 33] * sc); o.z = pk2(s[4 * 33] * sc, s[5 * 33] * sc); o.w = pk2(s[6 * 33] * sc, s[7 * 33] * sc);
            *(u32x4*)(WT + (size_t)rm.row(n) * K + k0 + 8 * c) = o; } }
    asm volatile("s_waitcnt lgkmcnt(0)" ::: "memory");
}
template <class RM>
__device__ __forceinline__ void transpose_all(Frame& F, const float* W, int K, int N, bf16_t* WT, const RM rm) {
    LAS float* scr = (LAS float*)(F.lds + F.wave * 16384);
    const int nitems = (K / 64) * ((N + 31) / 32);
    for (int it = F.gw; it < nitems; it += F.ngw) transpose_item(W, K, N, WT, scr, it, F.lane, rm);
}
__device__ __forceinline__ void rms_row_to_bf16(const float* xrow, const float* g, bf16_t* orow, int lane) {
    const f32x4* xr = (const f32x4*)xrow + lane; const f32x4* gr = (const f32x4*)g + lane;
    f32x4 v[4]; float s = 0.f;
#pragma unroll
    for (int j = 0; j < 4; ++j) { v[j] = xr[64 * j]; s += (v[j].x * v[j].x + v[j].y * v[j].y) + (v[j].z * v[j].z + v[j].w * v[j].w); }
    const float rstd = 1.0f / sqrtf(wave_sum(s) * (1.0f / DM) + RMS_EPS);
    unsigned long long* o8 = (unsigned long long*)orow + lane;
#pragma unroll
    for (int j = 0; j < 4; ++j) { const f32x4 gg = gr[64 * j];
        o8[64 * j] = (unsigned long long)pk2(v[j].x * rstd * gg.x, v[j].y * rstd * gg.y) | ((unsigned long long)pk2(v[j].z * rstd * gg.z, v[j].w * rstd * gg.w) << 32); }
}
__device__ __forceinline__ void norm_phase(Frame& F, const float* H, const float* g, bf16_t* XA) {
    for (int m = F.gw; m < M; m += F.ngw) rms_row_to_bf16(H + (size_t)m * DM, g, XA + (size_t)m * DM, F.lane);
}
__device__ __forceinline__ void final_norm_phase(Frame& F, float* H, const float* g) {
    for (int m = F.gw; m < M; m += F.ngw) {
        f32x4* xr = (f32x4*)(H + (size_t)m * DM) + F.lane; const f32x4* gr = (const f32x4*)g + F.lane;
        f32x4 v[4]; float s = 0.f;
#pragma unroll
        for (int j = 0; j < 4; ++j) { v[j] = xr[64 * j]; s += (v[j].x * v[j].x + v[j].y * v[j].y) + (v[j].z * v[j].z + v[j].w * v[j].w); }
        const float rstd = 1.0f / sqrtf(wave_sum(s) * (1.0f / DM) + RMS_EPS);
#pragma unroll
        for (int j = 0; j < 4; ++j) { const f32x4 gg = gr[64 * j]; f32x4 o; o.x = v[j].x * rstd * gg.x; o.y = v[j].y * rstd * gg.y; o.z = v[j].z * rstd * gg.z; o.w = v[j].w * rstd * gg.w; xr[64 * j] = o; }
    }
}
__device__ __forceinline__ void p0_prologue(Frame& F) {
    unsigned char* ws = F.ws;
    transpose_all(F, F.in[5], DM, AQKV, (bf16_t*)(ws + WS_WQKVA), RmQScale{1024});
    transpose_all(F, F.in[8], DM, DM, (bf16_t*)(ws + WS_WOA), RmPlain{0, 1.f});
    transpose_all(F, F.in[10], DM, BIN, (bf16_t*)(ws + WS_WIN), RmQScale{1024});
    transpose_all(F, F.in[14], DM, DM, (bf16_t*)(ws + WS_WOB), RmPlain{0, 1.f});
    for (int l = 0; l < 2; ++l) {
        transpose_all(F, F.in[15] + (size_t)l * DM * 2 * DFF, DM, 2 * DFF, (bf16_t*)(ws + WS_WGU) + (size_t)l * 2 * DFF * DM, RmGU{});
        transpose_all(F, F.in[16] + (size_t)l * DFF * DM, DFF, DM, (bf16_t*)(ws + WS_WDN) + (size_t)l * DM * DFF, RmPlain{0, 1.f});
        transpose_all(F, F.in[12] + (size_t)l * 2048 * 256, 2048, 256, (bf16_t*)(ws + WS_CW1) + (size_t)l * 256 * 2048, RmPlain{0, 1.f});
        transpose_all(F, F.in[13] + (size_t)l * 256 * 64, 256, 64, (bf16_t*)(ws + WS_CW2) + (size_t)l * 64 * 256, RmPlain{0, 1.f});
    }
    { u32x4* z = (u32x4*)((bf16_t*)(ws + WS_WIN) + (size_t)BIN * DM); const int n16 = (BINP - BIN) * DM * 2 / 16;
      for (int i = F.bid * NTHR + F.tid; i < n16; i += F.G * NTHR) z[i] = (u32x4){0u, 0u, 0u, 0u}; }
    { float* bd = (float*)(ws + WS_BIASD); const float* rt = F.in[1];
      for (int i = F.bid * NTHR + F.tid; i < 2048 * 16; i += F.G * NTHR) { const int d = i >> 4, h = i & 15; bd[i] = rt[t5_bucket(d) * 16 + h]; } }
    { float* c1 = (float*)(ws + WS_C1);
      for (int o = F.gw; o < 512; o += F.ngw) { const int kv = o >> 8, n = o & 255; const float* pos = F.in[11] + kv * 2048; const float* w1 = F.in[12] + (size_t)kv * 2048 * 256;
          float s = 0.f; for (int k = F.lane; k < 2048; k += 64) s += pos[k] * w1[(size_t)k * 256 + n];
          s = wave_sum(s); if (F.lane == 0) c1[o] = s; } }
    norm_phase(F, F.in[0], F.in[2], (bf16_t*)(ws + WS_XA));
}

template <bool DUAL, class Epi>
__device__ __forceinline__ void gemm_simple(Frame& F, const bf16_t* A, int lda, const bf16_t* Bt, int K, int nfeat_tiles, const Epi& E) {
    const int lane = F.lane, r32 = lane & 31, hi = lane >> 5;
    const int ntiles = (M / 64) * nfeat_tiles;
    for (int t = F.gw; t < ntiles; t += F.ngw) {
        const int mt = t / nfeat_tiles, ft = t % nfeat_tiles;
        const int m0 = mt * 64;
        int brow0, brow1, f0;
        if (DUAL) { f0 = ft * 32; brow0 = (f0 >> 7) * 256 + (f0 & 127); brow1 = brow0 + 128; }
        else { f0 = ft * 64; brow0 = f0; brow1 = f0 + 32; }
        const bf16_t* a0 = A + (size_t)(m0 + r32) * lda + 8 * hi; const bf16_t* a1 = a0 + (size_t)32 * lda;
        const bf16_t* b0 = Bt + (size_t)(brow0 + r32) * K + 8 * hi; const bf16_t* b1 = Bt + (size_t)(brow1 + r32) * K + 8 * hi;
        f32x16 acc00 = {}, acc01 = {}, acc10 = {}, acc11 = {};
#pragma unroll 4
        for (int k = 0; k < K; k += 16) {
            const bf16x8 fa0 = *(const bf16x8*)(a0 + k), fa1 = *(const bf16x8*)(a1 + k), fb0 = *(const bf16x8*)(b0 + k), fb1 = *(const bf16x8*)(b1 + k);
            acc00 = __builtin_amdgcn_mfma_f32_32x32x16_bf16(fa0, fb0, acc00, 0, 0, 0);
            acc01 = __builtin_amdgcn_mfma_f32_32x32x16_bf16(fa0, fb1, acc01, 0, 0, 0);
            acc10 = __builtin_amdgcn_mfma_f32_32x32x16_bf16(fa1, fb0, acc10, 0, 0, 0);
            acc11 = __builtin_amdgcn_mfma_f32_32x32x16_bf16(fa1, fb1, acc11, 0, 0, 0);
        }
#pragma unroll
        for (int r = 0; r < 16; ++r) {
            const int row = m0 + (r & 3) + 8 * (r >> 2) + 4 * hi;
            if (DUAL) { E(row, f0 + r32, acc00[r], acc01[r]); E(row + 32, f0 + r32, acc10[r], acc11[r]); }
            else { E(row, f0 + r32, acc00[r], 0.f); E(row, f0 + 32 + r32, acc01[r], 0.f); E(row + 32, f0 + r32, acc10[r], 0.f); E(row + 32, f0 + 32 + r32, acc11[r], 0.f); }
        }
    }
}
struct EpiQkvA { bf16_t* O; const float* bias; __device__ void operator()(int m, int n, float v, float) const { const float b = bias[n] * (n < 1024 ? 0.125f : 1.0f); O[(size_t)m * AQKV + n] = (bf16_t)f2bf(v + b); } };
struct EpiResid { const float* base; float* out; const float* bias; __device__ void operator()(int m, int n, float v, float) const { const size_t i = (size_t)m * DM + n; out[i] = base[i] + v + (bias ? bias[n] : 0.f); } };
struct EpiSwiglu { bf16_t* O; __device__ void operator()(int m, int f, float g, float u) const { const float s = g / (1.0f + __expf(-g)); O[(size_t)m * DFF + f] = (bf16_t)f2bf(s * u); } };
struct EpiWin { bf16_t* P; float* gates; __device__ void operator()(int m, int n, float v, float) const {
    if (n < PROJW) P[(size_t)m * PROJW + n] = (bf16_t)f2bf(v);
    else if (n < BIN) gates[(size_t)m * 48 + (n - PROJW)] = 1.0f / (1.0f + __expf(-v)); } };

struct KVsrc { const bf16_t* base; int pitch; int koff, voff; };
template <int MODE  >
__device__ __forceinline__ void attn_simple(Frame& F, const bf16_t* Q, int qpitch, KVsrc kv, const float* biasD, const float* sinks, const float* gates, const unsigned* selm, float* Ocomb, bf16_t* O) {
    const int nitems = M * NH / NTHR;
    for (int it = F.bid; it < nitems; it += F.G) {
        const int idx = it * NTHR + F.tid; const int m = idx >> 4, h = idx & 15, g = h >> 3;
        const int b = m / SEQ, t = m % SEQ;
        float q[64];
        { const u32x4* qp = (const u32x4*)(Q + (size_t)m * qpitch + h * 64);
#pragma unroll
          for (int c = 0; c < 8; ++c) { const u32x4 w = qp[c]; q[8 * c + 0] = bflo(w.x); q[8 * c + 1] = bfhi(w.x); q[8 * c + 2] = bflo(w.y); q[8 * c + 3] = bfhi(w.y); q[8 * c + 4] = bflo(w.z); q[8 * c + 5] = bfhi(w.z); q[8 * c + 6] = bflo(w.w); q[8 * c + 7] = bfhi(w.w); } }
        float o[64];
#pragma unroll
        for (int d = 0; d < 64; ++d) o[d] = 0.f;
        float mx = -1e20f, l = 0.f;
        unsigned sm = 0xffffffffu; int s_lo = 0;
        if (MODE == 0) s_lo = t - 127 > 0 ? t - 127 : 0;
        if (MODE == 2) s_lo = t - 511 > 0 ? t - 511 : 0;
        if (MODE == 1) sm = selm[(size_t)(b * 2 + g) * SEQ + t];
        const bf16_t* kb = kv.base + (size_t)b * SEQ * kv.pitch + kv.koff + g * 64;
        const bf16_t* vb = kv.base + (size_t)b * SEQ * kv.pitch + kv.voff + g * 64;
        for (int s = s_lo; s <= t; ++s) {
            if (MODE == 1) { if (!((sm >> (s >> 6)) & 1u)) { s |= 63; continue; } }
            const u32x4* kp = (const u32x4*)(kb + (size_t)s * kv.pitch);
            float dot = 0.f;
#pragma unroll
            for (int c = 0; c < 8; ++c) { const u32x4 w = kp[c];
                dot += q[8 * c + 0] * bflo(w.x) + q[8 * c + 1] * bfhi(w.x) + q[8 * c + 2] * bflo(w.y) + q[8 * c + 3] * bfhi(w.y) + q[8 * c + 4] * bflo(w.z) + q[8 * c + 5] * bfhi(w.z) + q[8 * c + 6] * bflo(w.w) + q[8 * c + 7] * bfhi(w.w); }
            const float sc = dot + biasD[(t - s) * 16 + h];
            const float mn = fmaxf(mx, sc); const float al = __expf(mx - mn), p = __expf(sc - mn);
            l = l * al + p; mx = mn;
            const u32x4* vp = (const u32x4*)(vb + (size_t)s * kv.pitch);
#pragma unroll
            for (int c = 0; c < 8; ++c) { const u32x4 w = vp[c];
                o[8 * c + 0] = o[8 * c + 0] * al + p * bflo(w.x); o[8 * c + 1] = o[8 * c + 1] * al + p * bfhi(w.x); o[8 * c + 2] = o[8 * c + 2] * al + p * bflo(w.y); o[8 * c + 3] = o[8 * c + 3] * al + p * bfhi(w.y);
                o[8 * c + 4] = o[8 * c + 4] * al + p * bflo(w.z); o[8 * c + 5] = o[8 * c + 5] * al + p * bfhi(w.z); o[8 * c + 6] = o[8 * c + 6] * al + p * bflo(w.w); o[8 * c + 7] = o[8 * c + 7] * al + p * bfhi(w.w); }
        }
        float inv;
        if (MODE == 0) { const float sk = sinks[h]; const float mf = fmaxf(mx, sk); const float al = __expf(mx - mf); inv = al / (l * al + __expf(sk - mf)); }
        else inv = (l > 0.f ? 1.0f / l : 0.f) * gates[(size_t)m * 48 + h * 3 + MODE];
        const size_t ob = (size_t)m * DM + h * 64;
        if (MODE == 1) {
#pragma unroll
            for (int c = 0; c < 16; ++c) { f32x4 a = *(f32x4*)(Ocomb + ob + 4 * c); a.x += o[4 * c] * inv; a.y += o[4 * c + 1] * inv; a.z += o[4 * c + 2] * inv; a.w += o[4 * c + 3] * inv; *(f32x4*)(Ocomb + ob + 4 * c) = a; }
        } else {
#pragma unroll
            for (int c = 0; c < 8; ++c) { float e[8];
#pragma unroll
                for (int j = 0; j < 8; ++j) e[j] = o[8 * c + j] * inv;
                if (MODE == 2) { const f32x4 a0 = *(const f32x4*)(Ocomb + ob + 8 * c), a1 = *(const f32x4*)(Ocomb + ob + 8 * c + 4); e[0] += a0.x; e[1] += a0.y; e[2] += a0.z; e[3] += a0.w; e[4] += a1.x; e[5] += a1.y; e[6] += a1.z; e[7] += a1.w; }
                u32x4 w; w.x = pk2(e[0], e[1]); w.y = pk2(e[2], e[3]); w.z = pk2(e[4], e[5]); w.w = pk2(e[6], e[7]); *(u32x4*)(O + ob + 8 * c) = w; }
        }
    }
}

__device__ __forceinline__ float gelu_tanh(float x) { const float u = 0.7978845608028654f * (x + 0.044715f * x * x * x); const float e = __expf(2.0f * u); const float th = 1.0f - 2.0f / (e + 1.0f); return 0.5f * x * (1.0f + th); }
__device__ __forceinline__ void compress_simple(Frame& F) {
    unsigned char* ws = F.ws;
    const bf16_t* P = (const bf16_t*)(ws + WS_QKV);
    LAS float* xs = (LAS float*)F.lds;
    LAS float* hs = xs + 2048;
    LAS float* part = hs + 256;
    const int nitems = 2 * BATCH * 2 * NC;
    for (int it = F.bid; it < nitems; it += F.G) {
        const int c = it % NC, g = (it / NC) & 1, b = (it / (NC * 2)) % BATCH, kvi = it / (NC * 2 * BATCH);
        __syncthreads();
        { const int l = F.tid >> 4, d4 = (F.tid & 15) * 4; const bf16_t* src = P + (size_t)(b * SEQ + 16 * c + l) * PROJW + 1024 + kvi * 128 + g * 64 + d4;
          const u32x2 w = *(const u32x2*)src; xs[l * 64 + d4] = bflo(w.x); xs[l * 64 + d4 + 1] = bfhi(w.x); xs[l * 64 + d4 + 2] = bflo(w.y); xs[l * 64 + d4 + 3] = bfhi(w.y); }
        __syncthreads();
        { const int n = F.tid & 255, half = F.tid >> 8; const bf16_t* w1 = (const bf16_t*)(ws + WS_CW1) + (size_t)kvi * 256 * 2048 + (size_t)n * 2048 + half * 1024;
          float s = 0.f;
          for (int k = 0; k < 1024; k += 8) { const u32x4 w = *(const u32x4*)(w1 + k); const LAS float* x = xs + half * 1024 + k;
              s += x[0] * bflo(w.x) + x[1] * bfhi(w.x) + x[2] * bflo(w.y) + x[3] * bfhi(w.y) + x[4] * bflo(w.z) + x[5] * bfhi(w.z) + x[6] * bflo(w.w) + x[7] * bfhi(w.w); }
          part[F.tid] = s; }
        __syncthreads();
        if (F.tid < 256) hs[F.tid] = gelu_tanh(part[F.tid] + part[F.tid + 256] + ((const float*)(ws + WS_C1))[kvi * 256 + F.tid]);
        __syncthreads();
        if (F.tid < 64) { const bf16_t* w2 = (const bf16_t*)(ws + WS_CW2) + (size_t)kvi * 64 * 256 + (size_t)F.tid * 256; float s = 0.f;
            for (int n = 0; n < 256; n += 2) { const unsigned w = *(const unsigned*)(w2 + n); s += hs[n] * bflo(w) + hs[n + 1] * bfhi(w); }
            ((bf16_t*)(ws + WS_KCVC))[((size_t)((kvi * BATCH + b) * 2 + g) * 128 + c) * 64 + F.tid] = (bf16_t)f2bf(s); }
    }
}

__device__ __forceinline__ void cmp_simple(Frame& F) {
    unsigned char* ws = F.ws;
    const bf16_t* P = (const bf16_t*)(ws + WS_QKV);
    const float* biasD = (const float*)(ws + WS_BIASD);
    const float* gates = (const float*)(ws + WS_GATES);
    float* Ocomb = (float*)(ws + WS_OCOMB);
    unsigned* selm = (unsigned*)(ws + WS_SELM);
    LAS float* Pl = (LAS float*)F.lds;
    LAS float* sc = Pl + 1024;
    const int nitems = BATCH * 2 * SEQ;
    for (int it = F.bid; it < nitems; it += F.G) {
        const int t = it % SEQ, g = (it / SEQ) & 1, b = it / (SEQ * 2);
        const int m = b * SEQ + t, hh = F.wave, h = g * 8 + hh, lane = F.lane;
        const bf16_t* kc = (const bf16_t*)(ws + WS_KCVC) + (size_t)((0 * BATCH + b) * 2 + g) * 128 * 64;
        const bf16_t* vc = (const bf16_t*)(ws + WS_KCVC) + (size_t)((1 * BATCH + b) * 2 + g) * 128 * 64;
        const bf16_t* qp = P + (size_t)m * PROJW + h * 64;
        __syncthreads();
        float s2[2];
#pragma unroll
        for (int u = 0; u < 2; ++u) { const int c = lane + 64 * u; float dot = 0.f; const bool valid = (c < NC) && (16 * c + 31 <= t);
            if (valid) { const u32x4* kp = (const u32x4*)(kc + (size_t)c * 64); const u32x4* qq = (const u32x4*)qp;
#pragma unroll
                for (int j = 0; j < 8; ++j) { const u32x4 a = qq[j], w = kp[j];
                    dot += bflo(a.x) * bflo(w.x) + bfhi(a.x) * bfhi(w.x) + bflo(a.y) * bflo(w.y) + bfhi(a.y) * bfhi(w.y) + bflo(a.z) * bflo(w.z) + bfhi(a.z) * bfhi(w.z) + bflo(a.w) * bflo(w.w) + bfhi(a.w) * bfhi(w.w); }
                dot += biasD[(t - 16 * c - 31) * 16 + h]; }
            s2[u] = valid ? dot : NEG_BIG; }
        const float mx = wave_max(fmaxf(s2[0], s2[1]));
        const float e0 = s2[0] > -1e29f ? __expf(s2[0] - mx) : 0.f, e1 = s2[1] > -1e29f ? __expf(s2[1] - mx) : 0.f;
        const float l = wave_sum(e0 + e1); const float inv = l > 0.f ? 1.0f / l : 0.f;
        Pl[hh * 128 + lane] = e0 * inv; Pl[hh * 128 + 64 + lane] = e1 * inv;
        __syncthreads();
        { float o = 0.f; const int cmax = (t - 31) >= 0 ? (t - 31) / 16 : -1;
          for (int c = 0; c <= cmax && c < NC; ++c) o += Pl[hh * 128 + c] * bf2f(vc[(size_t)c * 64 + lane]);
          Ocomb[(size_t)m * DM + h * 64 + lane] = o * gates[(size_t)m * 48 + h * 3 + 0]; }
        if (F.tid < 32) { const int j = F.tid, cur = t >> 6; float imp = 0.f;
            for (int c = 4 * j - 1; c <= 4 * j + 3; ++c) if (c >= 0 && c < NC) { float a = 0.f;
#pragma unroll
                for (int q = 0; q < 8; ++q) a += Pl[q * 128 + c];
                imp += a; }
            const bool forced = (j == 0) || (cur - j >= 0 && cur - j < 2);
            sc[j] = forced ? 1e6f : (j <= cur ? imp : -1.0f); }
        __syncthreads();
        if (F.tid < 32) { const int j = F.tid; const float mine = sc[j]; int rank = 0;
            for (int k = 0; k < 32; ++k) { const float o = sc[k]; rank += (o > mine || (o == mine && k < j)) ? 1 : 0; }
            const unsigned long long bal = __ballot(rank < 16);
            if (j == 0) selm[(size_t)(b * 2 + g) * SEQ + t] = (unsigned)bal; }
    }
}

constexpr int NPHASES = 17;
__global__ void __launch_bounds__(NTHR, 2) trunk_fwd(Args args) {
    extern __shared__ __attribute__((aligned(16))) unsigned char lds[];
    Frame F;
    F.lds = (LAS unsigned char*)lds;
    F.tid = threadIdx.x; F.lane = F.tid & 63; F.wave = __builtin_amdgcn_readfirstlane(F.tid >> 6);
    F.G = gridDim.x; F.bid = blockIdx.x; F.gw = F.bid * NWAVES + F.wave; F.ngw = F.G * NWAVES;
#pragma unroll
    for (int i = 0; i < 17; ++i) F.in[i] = args.in[i];
    F.out = args.out; F.ws = args.ws;
    unsigned char* ws = args.ws;
    volatile LAS unsigned* MISC = (volatile LAS unsigned*)(F.lds + MISC_OFF);
    if (F.tid < 32) MISC[F.tid] = 0u;
    __syncthreads();
    unsigned* barw = (unsigned*)(ws + WS_CTL) + CW_BAR + args.li * XCD_BAR_WORDS;
    XcdBarrier bar; bar.bar = barw; bar.x = 0; bar.st = nullptr;
    const int lo = args.ph_lo, hi = args.ph_hi;
    if (hi - lo > 1) bar = xcd_barrier_post(barw, MISC + 8);
#define IN(k) (lo <= (k) && (k) < hi)
#define SEAM(k) do { if (IN(k) && IN((k) + 1)) xcd_barrier(bar); } while (0)

    bf16_t* XA = (bf16_t*)(ws + WS_XA); bf16_t* QKV = (bf16_t*)(ws + WS_QKV); bf16_t* Ob = (bf16_t*)(ws + WS_O); bf16_t* HID = (bf16_t*)(ws + WS_HID);
    float* Hres = F.out; float* Ocomb = (float*)(ws + WS_OCOMB); float* gates = (float*)(ws + WS_GATES);
    const float* biasD = (const float*)(ws + WS_BIASD);

    if (IN(0)) { p0_prologue(F); } SEAM(0);
    if (IN(1)) { gemm_simple<false>(F, XA, DM, (const bf16_t*)(ws + WS_WQKVA), DM, AQKV / 64, EpiQkvA{QKV, F.in[6]}); } SEAM(1);
    if (IN(2)) { attn_simple<0>(F, QKV, AQKV, KVsrc{QKV, AQKV, 1024, 1152}, biasD, F.in[7], nullptr, nullptr, nullptr, Ob); } SEAM(2);
    if (IN(3)) { gemm_simple<false>(F, Ob, DM, (const bf16_t*)(ws + WS_WOA), DM, DM / 64, EpiResid{F.in[0], Hres, F.in[9]}); } SEAM(3);
    if (IN(4)) { norm_phase(F, Hres, F.in[3], XA); } SEAM(4);
    if (IN(5)) { gemm_simple<true>(F, XA, DM, (const bf16_t*)(ws + WS_WGU), DM, DFF / 32, EpiSwiglu{HID}); } SEAM(5);
    if (IN(6)) { gemm_simple<false>(F, HID, DFF, (const bf16_t*)(ws + WS_WDN), DFF, DM / 64, EpiResid{Hres, Hres, nullptr}); } SEAM(6);
    if (IN(7)) { norm_phase(F, Hres, F.in[2] + DM, XA); } SEAM(7);
    if (IN(8)) { gemm_simple<false>(F, XA, DM, (const bf16_t*)(ws + WS_WIN), DM, (BIN + 63) / 64, EpiWin{QKV, gates}); } SEAM(8);
    if (IN(9)) { compress_simple(F); } SEAM(9);
    if (IN(10)) { cmp_simple(F); } SEAM(10);
    if (IN(11)) { attn_simple<1>(F, QKV, PROJW, KVsrc{QKV, PROJW, 1024 + 2 * 128, 1024 + 3 * 128}, biasD, nullptr, gates, (const unsigned*)(ws + WS_SELM), Ocomb, Ob);
                  attn_simple<2>(F, QKV, PROJW, KVsrc{QKV, PROJW, 1024 + 4 * 128, 1024 + 5 * 128}, biasD, nullptr, gates, nullptr, Ocomb, Ob); } SEAM(11);
    if (IN(12)) { gemm_simple<false>(F, Ob, DM, (const bf16_t*)(ws + WS_WOB), DM, DM / 64, EpiResid{Hres, Hres, nullptr}); } SEAM(12);
    if (IN(13)) { norm_phase(F, Hres, F.in[3] + DM, XA); } SEAM(13);
    if (IN(14)) { gemm_simple<true>(F, XA, DM, (const bf16_t*)(ws + WS_WGU) + (size_t)2 * DFF * DM, DM, DFF / 32, EpiSwiglu{HID}); } SEAM(14);
    if (IN(15)) { gemm_simple<false>(F, HID, DFF, (const bf16_t*)(ws + WS_WDN) + (size_t)DM * DFF, DFF, DM / 64, EpiResid{Hres, Hres, nullptr}); } SEAM(15);
    if (IN(16)) { final_norm_phase(F, Hres, F.in[4]); }
#undef IN
#undef SEAM
}

extern "C" void kernel_launch(void* const* d_in, const int* in_sizes, int n_in, void* d_out, int out_size, void* d_ws, size_t ws_size, hipStream_t stream) {
    static int grid = 0;
    if (grid == 0) {
        if (n_in != 17 || out_size != M * DM || ws_size < WS_END) { fprintf(stderr, "kernel_launch: unexpected shapes (n_in %d out %d ws %zu)\n", n_in, out_size, ws_size); grid = -1; return; }
        int dev = 0, cus = 0, per_cu = 0;
        (void)hipGetDevice(&dev); (void)hipDeviceGetAttribute(&cus, hipDeviceAttributeMultiprocessorCount, dev);
        (void)hipFuncSetAttribute((const void*)trunk_fwd, hipFuncAttributeMaxDynamicSharedMemorySize, LDS_BYTES);
        (void)hipOccupancyMaxActiveBlocksPerMultiprocessor(&per_cu, (const void*)trunk_fwd, NTHR, LDS_BYTES);
        (void)hipGetLastError();
        if (per_cu < 1) fprintf(stderr, "kernel_launch: occupancy query says %d blocks per CU\n", per_cu);
        grid = cus > 0 ? cus : 256;
    }
    if (grid < 0) return;
    (void)hipMemsetAsync((char*)d_ws + WS_CTL, 0, CTL_ZERO_BYTES, stream);
    Args a{};
    for (int i = 0; i < 17; ++i) a.in[i] = (const float*)d_in[i];
    a.out = (float*)d_out; a.ws = (unsigned char*)d_ws;
#if MK_ONE_LAUNCH
    a.ph_lo = 0; a.ph_hi = NPHASES; a.li = 0;
    void* kargs[] = {&a};
    hipError_t e = hipLaunchCooperativeKernel((const void*)trunk_fwd, dim3(grid), dim3(NTHR), kargs, LDS_BYTES, stream);
    if (e != hipSuccess) fprintf(stderr, "cooperative launch failed: %s\n", hipGetErrorString(e));
#else
    for (int p = 0; p < NPHASES; ++p) { a.ph_lo = p; a.ph_hi = p + 1; a.li = 0;
        hipLaunchKernelGGL(trunk_fwd, dim3(grid), dim3(NTHR), LDS_BYTES, stream, a); }
#endif
}
```

```cpp
#include <hip/hip_runtime.h>
#include <cstdio>
#include <cstdint>

#ifndef FAST_GEMM
#define FAST_GEMM 1
#endif
#ifndef MK_ONE_LAUNCH
#define MK_ONE_LAUNCH 1
#endif

#define GAS __attribute__((address_space(1)))
#define LAS __attribute__((address_space(3)))
typedef unsigned short bf16_t;
typedef short bf16x8 __attribute__((ext_vector_type(8)));
typedef float f32x4 __attribute__((ext_vector_type(4)));
typedef float f32x16 __attribute__((ext_vector_type(16)));
typedef unsigned u32x4 __attribute__((ext_vector_type(4)));
typedef unsigned u32x2 __attribute__((ext_vector_type(2)));

constexpr int BATCH = 8, SEQ = 2048, DM = 1024, NH = 16, HD = 64, M = BATCH * SEQ;
constexpr int AQKV = 1280;
constexpr int BIN = 1840;
constexpr int BINP = 2048;
constexpr int PROJW = 1792;
constexpr int DFF = 2816;
constexpr int NC = 127;
constexpr int NSEL = 32;
constexpr int NWAVES = 8, NTHR = 512;
constexpr float RMS_EPS = 1e-6f;
constexpr float NEG_BIG = -1e30f;

constexpr size_t MiB = 1u << 20;
constexpr size_t WS_CTL = 0, CTL_ZERO_BYTES = 1 * MiB;
constexpr size_t WS_BIASD = 1 * MiB;
constexpr size_t WS_C1 = WS_BIASD + 128 * 1024;
constexpr size_t WS_KCVC = WS_C1 + 4096;
constexpr size_t WS_SELM = WS_KCVC + 512 * 1024;
constexpr size_t WS_GATES = 4 * MiB;
constexpr size_t WS_WQKVA = 8 * MiB;
constexpr size_t WS_WOA = WS_WQKVA + 3 * MiB;
constexpr size_t WS_WIN = WS_WOA + 2 * MiB;
constexpr size_t WS_WOB = WS_WIN + 4 * MiB;
constexpr size_t WS_WGU = WS_WOB + 2 * MiB;
constexpr size_t WS_WDN = WS_WGU + 22 * MiB;
constexpr size_t WS_CW1 = WS_WDN + 11 * MiB;
constexpr size_t WS_CW2 = WS_CW1 + 2 * MiB;
constexpr size_t WS_XA = 56 * MiB;
constexpr size_t WS_QKV = 88 * MiB;
constexpr size_t WS_O = 144 * MiB;
constexpr size_t WS_HID = WS_QKV;
constexpr size_t WS_OCOMB = 176 * MiB;
constexpr size_t WS_END = 240 * MiB;
static_assert(WS_CW2 + 64 * 1024 <= WS_XA, "weights fit");
static_assert(WS_SELM + 128 * 1024 <= WS_GATES, "small region");
constexpr int CW_BAR = 4096;

constexpr int LDS_MAIN = 147456;
constexpr int MISC_OFF = LDS_MAIN;
constexpr int LDS_BYTES = LDS_MAIN + 128;

#define RLX_AGENT __ATOMIC_RELAXED, __HIP_MEMORY_SCOPE_AGENT
__device__ __forceinline__ unsigned f2bf(float f) { unsigned u = __builtin_bit_cast(unsigned, f); return (u + 0x7fffu + ((u >> 16) & 1u)) >> 16; }
__device__ __forceinline__ unsigned pk2(float lo, float hi) { return f2bf(lo) | (f2bf(hi) << 16); }
__device__ __forceinline__ float bf2f(unsigned short b) { return __builtin_bit_cast(float, (unsigned)b << 16); }
__device__ __forceinline__ float bflo(unsigned w) { return __builtin_bit_cast(float, w << 16); }
__device__ __forceinline__ float bfhi(unsigned w) { return __builtin_bit_cast(float, w & 0xffff0000u); }
__device__ __forceinline__ float wave_sum(float v) {
#pragma unroll
    for (int o = 1; o < 64; o <<= 1) v += __shfl_xor(v, o);
    return v;
}
__device__ __forceinline__ float wave_max(float v) {
#pragma unroll
    for (int o = 1; o < 64; o <<= 1) v = fmaxf(v, __shfl_xor(v, o));
    return v;
}

#define XB_TMO      128
#define XB_XCNT(j)  (256  + 64 * (j))
#define XB_XSUB(j)  (1280 + 64 * (j))
#define XB_XGEN(j)  (2304 + 64 * (j))
#define XB_TOP      3328
#define XB_TOPGEN   3392
#define XCD_BAR_WORDS 3456
#define XB_SPIN_CAP (1u << 25)
__device__ __forceinline__ unsigned xb_ld(unsigned* p)              { return __hip_atomic_load(p, __ATOMIC_RELAXED, __HIP_MEMORY_SCOPE_AGENT); }
__device__ __forceinline__ unsigned xb_add(unsigned* p, unsigned v) { return __hip_atomic_fetch_add(p, v, __ATOMIC_RELAXED, __HIP_MEMORY_SCOPE_AGENT); }
__device__ __forceinline__ unsigned xb_xcc_id() { return (unsigned)__builtin_amdgcn_s_getreg((3 << 11) | 20) & 0xFu; }
#define XB_SPIN(cond, bar) do { unsigned _sp = 0; while (cond) { __builtin_amdgcn_s_sleep(1); \
    if ((++_sp & 255u) == 0u) { if (xb_ld(&(bar)[XB_TMO])) break; if (_sp > XB_SPIN_CAP) { atomicAdd(&(bar)[XB_TMO], 1u); break; } } } } while (0)
struct XcdBarrier { unsigned* bar; unsigned x; volatile LAS unsigned* st; };
__device__ __forceinline__ XcdBarrier xcd_barrier_post(unsigned* bar, volatile LAS unsigned* st) {
    XcdBarrier b; b.bar = bar; b.x = xb_xcc_id(); b.st = st;
    if (threadIdx.x == 0) (void)xb_add(&bar[XB_XCNT(b.x)], 1u);
    return b;
}
__device__ __forceinline__ void xcd_barrier_complete(unsigned* bar, unsigned x, unsigned& nloc, unsigned& nx) {
    const unsigned G = gridDim.x * gridDim.y * gridDim.z;
    unsigned sum, cnt, mine, sp = 0u;
    for (;;) {
        sum = 0u; cnt = 0u; mine = 0u;
#pragma unroll
        for (unsigned j = 0; j < 16; ++j) { const unsigned c = xb_ld(&bar[XB_XCNT(j)]); sum += c; cnt += (c > 0u) ? 1u : 0u; mine = (j == x) ? c : mine; }
        if (sum == G) break;
        __builtin_amdgcn_s_sleep(1);
        if ((++sp & 255u) == 0u) { if (xb_ld(&bar[XB_TMO])) break; if (sp > XB_SPIN_CAP) { atomicAdd(&bar[XB_TMO], 1u); break; } }
    }
    nloc = mine > 0u ? mine : 1u; nx = cnt > 0u ? cnt : 1u;
}
__device__ __forceinline__ void xcd_barrier(const XcdBarrier& b) {
    asm volatile("s_waitcnt vmcnt(0)" ::: "memory");
    __syncthreads();
    if (threadIdx.x == 0) {
        unsigned* bar = b.bar;
        __builtin_amdgcn_s_waitcnt(0);
        unsigned nloc = b.st[0], nx = b.st[1];
        if (nloc == 0u) { xcd_barrier_complete(bar, b.x, nloc, nx); b.st[0] = nloc; b.st[1] = nx; }
        const unsigned old = xb_add(&bar[XB_XSUB(b.x)], 1u);
        const unsigned gen = old / nloc;
        if (old + 1u == (gen + 1u) * nloc) {
            __builtin_amdgcn_fence(__ATOMIC_RELEASE, "agent");
            asm volatile("s_waitcnt vmcnt(0)" ::: "memory");
            const unsigned og = xb_add(&bar[XB_TOP], 1u);
            const unsigned tg = og / nx;
            if (og + 1u == (tg + 1u) * nx) xb_add(&bar[XB_TOPGEN], 1u);
            else XB_SPIN(xb_ld(&bar[XB_TOPGEN]) == tg, bar);
            __builtin_amdgcn_fence(__ATOMIC_ACQUIRE, "agent");
            xb_add(&bar[XB_XGEN(b.x)], 1u);
            asm volatile("s_waitcnt vmcnt(0)" ::: "memory");
        } else {
            XB_SPIN(xb_ld(&bar[XB_XGEN(b.x)]) == gen, bar);
            __builtin_amdgcn_fence(__ATOMIC_ACQUIRE, "agent");
            asm volatile("s_waitcnt vmcnt(0)" ::: "memory");
        }
    }
    __syncthreads();
}

namespace pg8 {
#define PG8_LAS __attribute__((address_space(3)))
typedef unsigned short bf16_t;
typedef short bf16x8 __attribute__((ext_vector_type(8)));
typedef float f32x4 __attribute__((ext_vector_type(4)));
typedef unsigned u32x4 __attribute__((ext_vector_type(4)));
constexpr int BM = 256, BK = 64, HALF = 128, HTB = HALF * BK * 2  , STAGE_BYTES = 8 * HTB, NXCD = 8, WGM = 8;

__host__ __device__ __forceinline__ int lds_byte(int r, int c) { const int st = (r >> 4) * 2 + (c >> 5), rr = r & 15, cc = c & 31, ob = rr * 64 + cc * 2; return st * 1024 + (ob ^ (((ob >> 9) & 1) << 5)); }
__host__ __device__ __forceinline__ void stage_rc(int b, int& R, int& C) { const int st = b / 1024, sb = b % 1024, swz = sb ^ (((sb >> 9) & 1) << 5); R = (st >> 1) * 16 + swz / 64; C = (st & 1) * 32 + (swz % 64) / 2; }
__host__ __device__ __forceinline__ int perm32(int rho) { const int n = rho >> 4, i = rho & 15; return 8 * (i >> 2) + 4 * n + (i & 3); }

struct Unit { int pm, pn; };
struct Gemm { const bf16_t* A; const bf16_t* Bt; int M, N, K; };

struct StaticOrder {
    int nM, nN, nwg, G, c;
    __host__ __device__ void init(int M, int N, int G_, int c_) { nM = M / BM; nN = N / BM; nwg = nM * nN; G = G_; c = c_; }
    __host__ __device__ bool next(int i, Unit& u) const {
        const long L = (long)i * G + c; if (L >= nwg) return false;
        int wgid = (int)L; { const int q = nwg / NXCD, r = nwg % NXCD, xcd = wgid % NXCD, off = wgid / NXCD; wgid = (xcd < r ? xcd * (q + 1) : r * (q + 1) + (xcd - r) * q) + off; }
        const int nig = WGM * nN, gid = wgid / nig, fm = gid * WGM, gsz = (nM - fm) < WGM ? (nM - fm) : WGM;
        u.pm = fm + ((wgid % nig) % gsz); u.pn = (wgid % nig) / gsz; return true;
    }
    __device__ __forceinline__ void a_ready(const Unit&) const {}
    __device__ __forceinline__ void done(const Unit&) const {}
};

__device__ __forceinline__ unsigned cvt_pk_bf16(float lo, float hi) { unsigned r; asm volatile("v_cvt_pk_bf16_f32 %0, %1, %2" : "=v"(r) : "v"(lo), "v"(hi)); return r; }
template <class Epi, class Sched, bool ALIGN_EPI = false, bool SP2 = false>
__device__ __forceinline__ void gemm_phase(PG8_LAS unsigned char* lds, const Gemm g, const Sched& S, const Epi& E) {
    const int tid = threadIdx.x, wid = __builtin_amdgcn_readfirstlane(tid >> 6), lane = tid & 63, wr = wid >> 2, wc = wid & 3, fr = lane & 15, fq = lane >> 4;
    const int K = g.K, nt = K / BK;
    unsigned voffA[2], voffB[2];
#pragma unroll
    for (int i = 0; i < 2; ++i) { int R, C; stage_rc(tid * 16 + i * 8192, R, C); const int Rb = Epi::PERM ? ((R & ~31) + perm32(R & 31)) : R;
        voffA[i] = (unsigned)(R * K + C) * 2u; voffB[i] = (unsigned)(Rb * K + C) * 2u; }
    const size_t kstep = (size_t)(BK * 2);
    const size_t hstep = (size_t)HALF * K * 2;
    const size_t tstep = 2 * hstep;
    const unsigned ldsw = (unsigned)wid * 1024u;
    const int aoff = lds_byte(wr * 64 + fr, fq * 8), boff = lds_byte(wc * 32 + fr, fq * 8);
#define PG8_SA(b, h) (((b) * 2 + (h)) * HTB)
#define PG8_SB(b, h) ((4 + (b) * 2 + (h)) * HTB)
#define PG8_STAGE(bufoff, gbase, voff) do { _Pragma("unroll") for (int _i = 0; _i < 2; ++_i) \
        __builtin_amdgcn_global_load_lds((const unsigned*)((const char*)(gbase) + (voff)[_i]), (PG8_LAS unsigned*)(lds + (bufoff) + ldsw + _i * 8192), 16, 0, 0); } while (0)
#define PG8_LDA(dst, b, h) do { _Pragma("unroll") for (int m = 0; m < 4; ++m) _Pragma("unroll") for (int k = 0; k < 2; ++k) dst[m][k] = *(const PG8_LAS bf16x8*)(lds + PG8_SA(b, h) + aoff + m * 2048 + k * 1024); } while (0)
#define PG8_LDB(dst, b, h) do { _Pragma("unroll") for (int n = 0; n < 2; ++n) _Pragma("unroll") for (int k = 0; k < 2; ++k) dst[n][k] = *(const PG8_LAS bf16x8*)(lds + PG8_SB(b, h) + boff + n * 2048 + k * 1024); } while (0)
#define PG8_MMA(ai, bj, At, Bt) do { __builtin_amdgcn_s_setprio(1); _Pragma("unroll") for (int m = 0; m < 4; ++m) _Pragma("unroll") for (int n = 0; n < 2; ++n) _Pragma("unroll") for (int k = 0; k < 2; ++k) \
        acc[ai][bj][m][n] = __builtin_amdgcn_mfma_f32_16x16x32_bf16(Bt[n][k], At[m][k], acc[ai][bj][m][n], 0, 0, 0); __builtin_amdgcn_s_setprio(0); } while (0)
#define PG8_WAIT_V(n) asm volatile("s_waitcnt vmcnt(" #n ")" ::: "memory")
#define PG8_WAIT_L(n) asm volatile("s_waitcnt lgkmcnt(" #n ")" ::: "memory")
#define PG8_BAR __builtin_amdgcn_s_barrier()
#define PG8_SCHED __builtin_amdgcn_sched_barrier(0)
    Unit cur, nxt; int ui = 0;
    if (!S.next(0, cur)) return;
    f32x4 acc[2][2][4][2];
#pragma unroll
    for (int a = 0; a < 2; ++a)
#pragma unroll
        for (int b = 0; b < 2; ++b)
#pragma unroll
            for (int m = 0; m < 4; ++m)
#pragma unroll
                for (int n = 0; n < 2; ++n) acc[a][b][m][n] = (f32x4){0.f, 0.f, 0.f, 0.f};
    bf16x8 At[4][2], B0[2][2], B1[2][2];
    const char* cA = (const char*)g.A + (size_t)cur.pm * tstep; const char* cB = (const char*)g.Bt + (size_t)cur.pn * tstep;
    S.a_ready(cur);
    if constexpr (SP2) {
        PG8_STAGE(PG8_SB(0, 0), cB, voffB); PG8_STAGE(PG8_SB(0, 1), cB + hstep, voffB); PG8_STAGE(PG8_SA(0, 0), cA, voffA); PG8_STAGE(PG8_SA(0, 1), cA + hstep, voffA);
        if (wr == 1) PG8_BAR;
        PG8_WAIT_V(2); PG8_BAR;
        PG8_STAGE(PG8_SB(1, 0), cB + kstep, voffB); PG8_STAGE(PG8_SA(1, 0), cA + kstep, voffA); PG8_STAGE(PG8_SB(1, 1), cB + hstep + kstep, voffB);
        PG8_WAIT_V(6); PG8_BAR;
    } else {
        PG8_STAGE(PG8_SB(0, 0), cB, voffB); PG8_STAGE(PG8_SA(0, 0), cA, voffA); PG8_STAGE(PG8_SB(0, 1), cB + hstep, voffB); PG8_STAGE(PG8_SA(0, 1), cA + hstep, voffA);
        if (wr == 1) PG8_BAR;
        PG8_WAIT_V(4); PG8_BAR;
        PG8_STAGE(PG8_SB(1, 0), cB + kstep, voffB); PG8_STAGE(PG8_SA(1, 0), cA + kstep, voffA); PG8_STAGE(PG8_SB(1, 1), cB + hstep + kstep, voffB);
        PG8_WAIT_V(6); PG8_BAR;
    }
    for (;;) {
        const bool has_next = S.next(ui + 1, nxt);
        const char* nA = has_next ? (const char*)g.A + (size_t)nxt.pm * tstep : cA; const char* nB = has_next ? (const char*)g.Bt + (size_t)nxt.pn * tstep : cB;
        for (int t = 0; t < nt; t += 2) {
            const bool last = (t == nt - 2);
            const char* a1 = cA + (size_t)(t + 1) * kstep;
            const char* a2 = last ? nA : cA + (size_t)(t + 2) * kstep; const char* b2 = last ? nB : cB + (size_t)(t + 2) * kstep;
            const char* a3 = a2 + kstep; const char* b3 = b2 + kstep;
            if (last && has_next) S.a_ready(nxt);
            if constexpr (SP2) {
            PG8_LDB(B0, 0, 0); PG8_LDB(B1, 0, 1); PG8_SCHED; PG8_LDA(At, 0, 0); PG8_STAGE(PG8_SA(1, 1), a1 + hstep, voffA);
            PG8_WAIT_V(8); PG8_WAIT_L(0); PG8_BAR; PG8_MMA(0, 0, At, B0); PG8_MMA(0, 1, At, B1); PG8_BAR; PG8_SCHED;
            PG8_LDA(At, 0, 1); PG8_STAGE(PG8_SB(0, 0), b2, voffB); PG8_STAGE(PG8_SB(0, 1), b2 + hstep, voffB); PG8_STAGE(PG8_SA(0, 0), a2, voffA);
            PG8_WAIT_V(8); PG8_WAIT_L(0); PG8_BAR; PG8_MMA(1, 0, At, B0); PG8_MMA(1, 1, At, B1); PG8_BAR; PG8_SCHED;
            PG8_LDB(B0, 1, 0); PG8_LDB(B1, 1, 1); PG8_SCHED; PG8_LDA(At, 1, 0); PG8_STAGE(PG8_SA(0, 1), a2 + hstep, voffA);
            PG8_WAIT_V(8); PG8_WAIT_L(0); PG8_BAR; PG8_MMA(0, 0, At, B0); PG8_MMA(0, 1, At, B1); PG8_BAR; PG8_SCHED;
            PG8_LDA(At, 1, 1); PG8_STAGE(PG8_SB(1, 0), b3, voffB); PG8_STAGE(PG8_SB(1, 1), b3 + hstep, voffB); PG8_STAGE(PG8_SA(1, 0), a3, voffA);
            PG8_WAIT_V(8); PG8_WAIT_L(0); PG8_BAR; PG8_MMA(1, 0, At, B0); PG8_MMA(1, 1, At, B1); PG8_BAR; PG8_SCHED;
            } else {
            PG8_LDB(B0, 0, 0); PG8_SCHED; PG8_LDA(At, 0, 0); PG8_STAGE(PG8_SA(1, 1), a1 + hstep, voffA);
            PG8_WAIT_L(8); PG8_BAR; PG8_WAIT_L(0); PG8_MMA(0, 0, At, B0); PG8_BAR; PG8_SCHED;
            PG8_LDB(B1, 0, 1); PG8_STAGE(PG8_SB(0, 0), b2, voffB);
            PG8_BAR; PG8_WAIT_L(0); PG8_MMA(0, 1, At, B1); PG8_BAR;
            PG8_LDA(At, 0, 1); PG8_STAGE(PG8_SA(0, 0), a2, voffA);
            PG8_BAR; PG8_WAIT_L(0); PG8_MMA(1, 0, At, B0); PG8_BAR; PG8_SCHED;
            PG8_STAGE(PG8_SB(0, 1), b2 + hstep, voffB);
            PG8_WAIT_V(6); PG8_BAR; PG8_MMA(1, 1, At, B1); PG8_BAR;
            PG8_LDB(B0, 1, 0); PG8_SCHED; PG8_LDA(At, 1, 0); PG8_STAGE(PG8_SA(0, 1), a2 + hstep, voffA);
            PG8_WAIT_L(8); PG8_BAR; PG8_WAIT_L(0); PG8_MMA(0, 0, At, B0); PG8_BAR; PG8_SCHED;
            PG8_LDB(B1, 1, 1); PG8_STAGE(PG8_SB(1, 0), b3, voffB);
            PG8_BAR; PG8_WAIT_L(0); PG8_MMA(0, 1, At, B1); PG8_BAR;
            PG8_LDA(At, 1, 1); PG8_STAGE(PG8_SA(1, 0), a3, voffA);
            PG8_BAR; PG8_WAIT_L(0); PG8_MMA(1, 0, At, B0); PG8_BAR; PG8_SCHED;
            PG8_STAGE(PG8_SB(1, 1), b3 + hstep, voffB);
            PG8_WAIT_V(6); PG8_BAR; PG8_MMA(1, 1, At, B1); PG8_BAR;
            }
        }
        if constexpr (ALIGN_EPI) { if (wr == 0) PG8_BAR; }
        if constexpr (!Epi::AFTER_DRAIN) { E(acc, cur, wr, wc, fr, fq); S.done(cur); }
        if (!has_next) break;
#pragma unroll
        for (int a = 0; a < 2; ++a)
#pragma unroll
            for (int b = 0; b < 2; ++b)
#pragma unroll
                for (int m = 0; m < 4; ++m)
#pragma unroll
                    for (int n = 0; n < 2; ++n) acc[a][b][m][n] = (f32x4){0.f, 0.f, 0.f, 0.f};
        cur = nxt; cA = nA; cB = nB; ++ui;
        if constexpr (ALIGN_EPI) { if (wr == 1) PG8_BAR; }
    }
    PG8_WAIT_V(0);
    if constexpr (!ALIGN_EPI) { if (wr == 0) PG8_BAR; }
    PG8_BAR;
    if constexpr (Epi::AFTER_DRAIN) { E.fused(acc, cur, wr, wc, fr, fq, lds, wid, lane); S.done(cur); }
#undef PG8_SA
#undef PG8_SB
#undef PG8_STAGE
#undef PG8_LDA
#undef PG8_LDB
#undef PG8_MMA
#undef PG8_WAIT_V
#undef PG8_WAIT_L
#undef PG8_BAR
#undef PG8_SCHED
}
}

namespace pg8 {
struct EpiQkvF { static constexpr bool PERM = true, AFTER_DRAIN = false; bf16_t* O; const float* bias;
    __device__ __forceinline__ void operator()(const f32x4 (&acc)[2][2][4][2], const Unit& u, int wr, int wc, int fr, int fq) const {
        const int row0 = u.pm * BM + wr * 64 + fr, col0 = u.pn * BM + wc * 32 + 8 * fq; const float sc = (u.pn < 4) ? 0.125f : 1.0f;
        f32x4 bv[2][2];
#pragma unroll
        for (int bj = 0; bj < 2; ++bj)
#pragma unroll
            for (int n = 0; n < 2; ++n) bv[bj][n] = *(const f32x4*)(bias + col0 + bj * HALF + 4 * n) * sc;
#pragma unroll
        for (int ai = 0; ai < 2; ++ai)
#pragma unroll
            for (int m = 0; m < 4; ++m) { bf16_t* rowp = O + (size_t)(row0 + ai * HALF + m * 16) * 1280 + col0;
#pragma unroll
                for (int bj = 0; bj < 2; ++bj) { const f32x4 v0 = acc[ai][bj][m][0] + bv[bj][0], v1 = acc[ai][bj][m][1] + bv[bj][1];
                    u32x4 w; w.x = cvt_pk_bf16(v0[0], v0[1]); w.y = cvt_pk_bf16(v0[2], v0[3]); w.z = cvt_pk_bf16(v1[0], v1[1]); w.w = cvt_pk_bf16(v1[2], v1[3]);
                    *(u32x4*)(rowp + bj * HALF) = w; } }
    }
};
struct EpiResidF { static constexpr bool PERM = false, AFTER_DRAIN = false; const float* base; float* out; const float* bias;
    __device__ __forceinline__ void operator()(const f32x4 (&acc)[2][2][4][2], const Unit& u, int wr, int wc, int fr, int fq) const {
        const int col0 = u.pn * BM + wc * 32 + 4 * fq;
        f32x4 bv[2][2];
#pragma unroll
        for (int bj = 0; bj < 2; ++bj)
#pragma unroll
            for (int n = 0; n < 2; ++n) bv[bj][n] = bias ? *(const f32x4*)(bias + col0 + bj * HALF + n * 16) : (f32x4){0.f, 0.f, 0.f, 0.f};
#pragma unroll
        for (int ai = 0; ai < 2; ++ai)
#pragma unroll
            for (int m = 0; m < 4; ++m) { const size_t off = (size_t)(u.pm * BM + ai * HALF + wr * 64 + m * 16 + fr) * 1024 + col0;
#pragma unroll
                for (int bj = 0; bj < 2; ++bj)
#pragma unroll
                    for (int n = 0; n < 2; ++n) { const f32x4 bs = *(const f32x4*)(base + off + bj * HALF + n * 16); *(f32x4*)(out + off + bj * HALF + n * 16) = bs + acc[ai][bj][m][n] + bv[bj][n]; }
                if (m & 1) asm volatile("" ::: "memory"); }
    }
};
struct EpiSwigluF { static constexpr bool PERM = true, AFTER_DRAIN = false; bf16_t* O;
    __device__ __forceinline__ float silu_mul(float g, float u) const { return g * __builtin_amdgcn_rcpf(1.0f + __expf(-g)) * u; }
    __device__ __forceinline__ void operator()(const f32x4 (&acc)[2][2][4][2], const Unit& u, int wr, int wc, int fr, int fq) const {
        const int row0 = u.pm * BM + wr * 64 + fr, f0 = u.pn * HALF + wc * 32 + 8 * fq;
#pragma unroll
        for (int ai = 0; ai < 2; ++ai)
#pragma unroll
            for (int m = 0; m < 4; ++m) { const f32x4 g0 = acc[ai][0][m][0], g1 = acc[ai][0][m][1], u0 = acc[ai][1][m][0], u1 = acc[ai][1][m][1];
                u32x4 w; w.x = cvt_pk_bf16(silu_mul(g0[0], u0[0]), silu_mul(g0[1], u0[1])); w.y = cvt_pk_bf16(silu_mul(g0[2], u0[2]), silu_mul(g0[3], u0[3]));
                w.z = cvt_pk_bf16(silu_mul(g1[0], u1[0]), silu_mul(g1[1], u1[1])); w.w = cvt_pk_bf16(silu_mul(g1[2], u1[2]), silu_mul(g1[3], u1[3]));
                *(u32x4*)(O + (size_t)(row0 + ai * HALF + m * 16) * 2816 + f0) = w; }
    }
};
struct EpiWinF { static constexpr bool PERM = true, AFTER_DRAIN = false; bf16_t* P; float* gates;
    __device__ __forceinline__ void operator()(const f32x4 (&acc)[2][2][4][2], const Unit& u, int wr, int wc, int fr, int fq) const {
        const int row0 = u.pm * BM + wr * 64 + fr, col0 = u.pn * BM + wc * 32 + 8 * fq;
        if (u.pn < 7) {
#pragma unroll
            for (int ai = 0; ai < 2; ++ai)
#pragma unroll
                for (int m = 0; m < 4; ++m) { bf16_t* rowp = P + (size_t)(row0 + ai * HALF + m * 16) * 1792 + col0;
#pragma unroll
                    for (int bj = 0; bj < 2; ++bj) { const f32x4 v0 = acc[ai][bj][m][0], v1 = acc[ai][bj][m][1];
                        u32x4 w; w.x = cvt_pk_bf16(v0[0], v0[1]); w.y = cvt_pk_bf16(v0[2], v0[3]); w.z = cvt_pk_bf16(v1[0], v1[1]); w.w = cvt_pk_bf16(v1[2], v1[3]);
                        *(u32x4*)(rowp + bj * HALF) = w; } }
        } else {
            const int gc = wc * 32 + 8 * fq;
            if (gc < 48) {
#pragma unroll
                for (int ai = 0; ai < 2; ++ai)
#pragma unroll
                    for (int m = 0; m < 4; ++m) { float* gp = gates + (size_t)(row0 + ai * HALF + m * 16) * 48 + gc;
#pragma unroll
                        for (int n = 0; n < 2; ++n) { const f32x4 v = acc[ai][0][m][n]; f32x4 s;
#pragma unroll
                            for (int j = 0; j < 4; ++j) s[j] = __builtin_amdgcn_rcpf(1.0f + __expf(-v[j]));
                            *(f32x4*)(gp + 4 * n) = s; } }
            }
        }
    }
};
}

struct Args { const float* in[17]; float* out; unsigned char* ws; int ph_lo, ph_hi, li, pad; };
struct Frame {
    LAS unsigned char* lds;
    int tid, lane, wave, G, bid;
    int gw, ngw;
    const float* in[17]; float* out; unsigned char* ws;
};

__device__ __forceinline__ int t5_bucket(int n) {
    if (n < 16) return n;
    const float nf = (float)n;
    const int lb = 16 + (int)(logf(nf / 16.0f) / 4.1588830833596715f * 16.0f);
    return lb < 31 ? lb : 31;
}

struct RmPlain { int off; float s; __device__ int row(int n) const { return n + off; } __device__ float scale(int) const { return s; } };
struct RmQScale { int nq; __device__ int row(int n) const { return n; } __device__ float scale(int n) const { return n < nq ? 0.125f : 1.0f; } };
struct RmGU { __device__ int row(int n) const { const int up = n >= DFF; const int f = up ? n - DFF : n; return (f >> 7) * 256 + (up ? 128 : 0) + (f & 127); } __device__ float scale(int) const { return 1.0f; } };

template <class RM>
__device__ __forceinline__ void transpose_item(const float* W, int K, int N, bf16_t* WT, LAS float* scr, int item, int lane, const RM rm) {
    const int nblk = (N + 31) / 32, kb = item / nblk, nb = item % nblk, k0 = 64 * kb, n0 = 32 * nb;
    const int nl = n0 + (lane & 31);
#pragma unroll 8
    for (int i = 0; i < 32; ++i) { const int kk = 2 * i + (lane >> 5); scr[kk * 33 + (lane & 31)] = (nl < N) ? W[(size_t)(k0 + kk) * N + nl] : 0.f; }
    asm volatile("s_waitcnt lgkmcnt(0)" ::: "memory");
    const int c = lane & 7;
#pragma unroll
    for (int j = 0; j < 4; ++j) { const int nn = (lane >> 3) + 8 * j; const int n = n0 + nn; const LAS float* s = scr + (8 * c) * 33 + nn;
        if (n < N) { const float sc = rm.scale(n);
            u32x4 o; o.x = pk2(s[0 * 33] * sc, s[1 * 33] * sc); o.y = pk2(s[2 * 33] * sc, s[3 * 33] * sc); o.z = pk2(s[4 * 33] * sc, s[5 * 33] * sc); o.w = pk2(s[6 * 33] * sc, s[7 * 33] * sc);
            *(u32x4*)(WT + (size_t)rm.row(n) * K + k0 + 8 * c) = o; } }
    asm volatile("s_waitcnt lgkmcnt(0)" ::: "memory");
}
template <class RM>
__device__ __forceinline__ void transpose_all(Frame& F, const float* W, int K, int N, bf16_t* WT, const RM rm) {
    LAS float* scr = (LAS float*)(F.lds + F.wave * 16384);
    const int nitems = (K / 64) * ((N + 31) / 32);
    for (int it = F.gw; it < nitems; it += F.ngw) transpose_item(W, K, N, WT, scr, it, F.lane, rm);
}
__device__ __forceinline__ void rms_row_to_bf16(const float* xrow, const float* g, bf16_t* orow, int lane) {
    const f32x4* xr = (const f32x4*)xrow + lane; const f32x4* gr = (const f32x4*)g + lane;
    f32x4 v[4]; float s = 0.f;
#pragma unroll
    for (int j = 0; j < 4; ++j) { v[j] = xr[64 * j]; s += (v[j].x * v[j].x + v[j].y * v[j].y) + (v[j].z * v[j].z + v[j].w * v[j].w); }
    const float rstd = 1.0f / sqrtf(wave_sum(s) * (1.0f / DM) + RMS_EPS);
    unsigned long long* o8 = (unsigned long long*)orow + lane;
#pragma unroll
    for (int j = 0; j < 4; ++j) { const f32x4 gg = gr[64 * j];
        o8[64 * j] = (unsigned long long)pk2(v[j].x * rstd * gg.x, v[j].y * rstd * gg.y) | ((unsigned long long)pk2(v[j].z * rstd * gg.z, v[j].w * rstd * gg.w) << 32); }
}
__device__ __forceinline__ void norm_phase(Frame& F, const float* H, const float* g, bf16_t* XA) {
    for (int m = F.gw; m < M; m += F.ngw) rms_row_to_bf16(H + (size_t)m * DM, g, XA + (size_t)m * DM, F.lane);
}
__device__ __forceinline__ void final_norm_phase(Frame& F, float* H, const float* g) {
    for (int m = F.gw; m < M; m += F.ngw) {
        f32x4* xr = (f32x4*)(H + (size_t)m * DM) + F.lane; const f32x4* gr = (const f32x4*)g + F.lane;
        f32x4 v[4]; float s = 0.f;
#pragma unroll
        for (int j = 0; j < 4; ++j) { v[j] = xr[64 * j]; s += (v[j].x * v[j].x + v[j].y * v[j].y) + (v[j].z * v[j].z + v[j].w * v[j].w); }
        const float rstd = 1.0f / sqrtf(wave_sum(s) * (1.0f / DM) + RMS_EPS);
#pragma unroll
        for (int j = 0; j < 4; ++j) { const f32x4 gg = gr[64 * j]; f32x4 o; o.x = v[j].x * rstd * gg.x; o.y = v[j].y * rstd * gg.y; o.z = v[j].z * rstd * gg.z; o.w = v[j].w * rstd * gg.w; xr[64 * j] = o; }
    }
}
__device__ __forceinline__ void p0_prologue(Frame& F) {
    unsigned char* ws = F.ws;
    transpose_all(F, F.in[5], DM, AQKV, (bf16_t*)(ws + WS_WQKVA), RmQScale{1024});
    transpose_all(F, F.in[8], DM, DM, (bf16_t*)(ws + WS_WOA), RmPlain{0, 1.f});
    transpose_all(F, F.in[10], DM, BIN, (bf16_t*)(ws + WS_WIN), RmQScale{1024});
    transpose_all(F, F.in[14], DM, DM, (bf16_t*)(ws + WS_WOB), RmPlain{0, 1.f});
    for (int l = 0; l < 2; ++l) {
        transpose_all(F, F.in[15] + (size_t)l * DM * 2 * DFF, DM, 2 * DFF, (bf16_t*)(ws + WS_WGU) + (size_t)l * 2 * DFF * DM, RmGU{});
        transpose_all(F, F.in[16] + (size_t)l * DFF * DM, DFF, DM, (bf16_t*)(ws + WS_WDN) + (size_t)l * DM * DFF, RmPlain{0, 1.f});
        transpose_all(F, F.in[12] + (size_t)l * 2048 * 256, 2048, 256, (bf16_t*)(ws + WS_CW1) + (size_t)l * 256 * 2048, RmPlain{0, 1.f});
        transpose_all(F, F.in[13] + (size_t)l * 256 * 64, 256, 64, (bf16_t*)(ws + WS_CW2) + (size_t)l * 64 * 256, RmPlain{0, 1.f});
    }
    { u32x4* z = (u32x4*)((bf16_t*)(ws + WS_WIN) + (size_t)BIN * DM); const int n16 = (BINP - BIN) * DM * 2 / 16;
      for (int i = F.bid * NTHR + F.tid; i < n16; i += F.G * NTHR) z[i] = (u32x4){0u, 0u, 0u, 0u}; }
    { float* bd = (float*)(ws + WS_BIASD); const float* rt = F.in[1];
      for (int i = F.bid * NTHR + F.tid; i < 2048 * 16; i += F.G * NTHR) { const int d = i >> 4, h = i & 15; bd[i] = rt[t5_bucket(d) * 16 + h]; } }
    { float* c1 = (float*)(ws + WS_C1);
      for (int o = F.gw; o < 512; o += F.ngw) { const int kv = o >> 8, n = o & 255; const float* pos = F.in[11] + kv * 2048; const float* w1 = F.in[12] + (size_t)kv * 2048 * 256;
          float s = 0.f; for (int k = F.lane; k < 2048; k += 64) s += pos[k] * w1[(size_t)k * 256 + n];
          s = wave_sum(s); if (F.lane == 0) c1[o] = s; } }
    norm_phase(F, F.in[0], F.in[2], (bf16_t*)(ws + WS_XA));
}

template <bool DUAL, class Epi>
__device__ __forceinline__ void gemm_simple(Frame& F, const bf16_t* A, int lda, const bf16_t* Bt, int K, int nfeat_tiles, const Epi& E) {
    const int lane = F.lane, r32 = lane & 31, hi = lane >> 5;
    const int ntiles = (M / 64) * nfeat_tiles;
    for (int t = F.gw; t < ntiles; t += F.ngw) {
        const int mt = t / nfeat_tiles, ft = t % nfeat_tiles;
        const int m0 = mt * 64;
        int brow0, brow1, f0;
        if (DUAL) { f0 = ft * 32; brow0 = (f0 >> 7) * 256 + (f0 & 127); brow1 = brow0 + 128; }
        else { f0 = ft * 64; brow0 = f0; brow1 = f0 + 32; }
        const bf16_t* a0 = A + (size_t)(m0 + r32) * lda + 8 * hi; const bf16_t* a1 = a0 + (size_t)32 * lda;
        const bf16_t* b0 = Bt + (size_t)(brow0 + r32) * K + 8 * hi; const bf16_t* b1 = Bt + (size_t)(brow1 + r32) * K + 8 * hi;
        f32x16 acc00 = {}, acc01 = {}, acc10 = {}, acc11 = {};
#pragma unroll 4
        for (int k = 0; k < K; k += 16) {
            const bf16x8 fa0 = *(const bf16x8*)(a0 + k), fa1 = *(const bf16x8*)(a1 + k), fb0 = *(const bf16x8*)(b0 + k), fb1 = *(const bf16x8*)(b1 + k);
            acc00 = __builtin_amdgcn_mfma_f32_32x32x16_bf16(fa0, fb0, acc00, 0, 0, 0);
            acc01 = __builtin_amdgcn_mfma_f32_32x32x16_bf16(fa0, fb1, acc01, 0, 0, 0);
            acc10 = __builtin_amdgcn_mfma_f32_32x32x16_bf16(fa1, fb0, acc10, 0, 0, 0);
            acc11 = __builtin_amdgcn_mfma_f32_32x32x16_bf16(fa1, fb1, acc11, 0, 0, 0);
        }
#pragma unroll
        for (int r = 0; r < 16; ++r) {
            const int row = m0 + (r & 3) + 8 * (r >> 2) + 4 * hi;
            if (DUAL) { E(row, f0 + r32, acc00[r], acc01[r]); E(row + 32, f0 + r32, acc10[r], acc11[r]); }
            else { E(row, f0 + r32, acc00[r], 0.f); E(row, f0 + 32 + r32, acc01[r], 0.f); E(row + 32, f0 + r32, acc10[r], 0.f); E(row + 32, f0 + 32 + r32, acc11[r], 0.f); }
        }
    }
}
struct EpiQkvA { bf16_t* O; const float* bias; __device__ void operator()(int m, int n, float v, float) const { const float b = bias[n] * (n < 1024 ? 0.125f : 1.0f); O[(size_t)m * AQKV + n] = (bf16_t)f2bf(v + b); } };
struct EpiResid { const float* base; float* out; const float* bias; __device__ void operator()(int m, int n, float v, float) const { const size_t i = (size_t)m * DM + n; out[i] = base[i] + v + (bias ? bias[n] : 0.f); } };
struct EpiSwiglu { bf16_t* O; __device__ void operator()(int m, int f, float g, float u) const { const float s = g / (1.0f + __expf(-g)); O[(size_t)m * DFF + f] = (bf16_t)f2bf(s * u); } };
struct EpiWin { bf16_t* P; float* gates; __device__ void operator()(int m, int n, float v, float) const {
    if (n < PROJW) P[(size_t)m * PROJW + n] = (bf16_t)f2bf(v);
    else if (n < BIN) gates[(size_t)m * 48 + (n - PROJW)] = 1.0f / (1.0f + __expf(-v)); } };

struct KVsrc { const bf16_t* base; int pitch; int koff, voff; };
template <int MODE  >
__device__ __forceinline__ void attn_simple(Frame& F, const bf16_t* Q, int qpitch, KVsrc kv, const float* biasD, const float* sinks, const float* gates, const unsigned* selm, float* Ocomb, bf16_t* O) {
    const int nitems = M * NH / NTHR;
    for (int it = F.bid; it < nitems; it += F.G) {
        const int idx = it * NTHR + F.tid; const int m = idx >> 4, h = idx & 15, g = h >> 3;
        const int b = m / SEQ, t = m % SEQ;
        float q[64];
        { const u32x4* qp = (const u32x4*)(Q + (size_t)m * qpitch + h * 64);
#pragma unroll
          for (int c = 0; c < 8; ++c) { const u32x4 w = qp[c]; q[8 * c + 0] = bflo(w.x); q[8 * c + 1] = bfhi(w.x); q[8 * c + 2] = bflo(w.y); q[8 * c + 3] = bfhi(w.y); q[8 * c + 4] = bflo(w.z); q[8 * c + 5] = bfhi(w.z); q[8 * c + 6] = bflo(w.w); q[8 * c + 7] = bfhi(w.w); } }
        float o[64];
#pragma unroll
        for (int d = 0; d < 64; ++d) o[d] = 0.f;
        float mx = -1e20f, l = 0.f;
        unsigned sm = 0xffffffffu; int s_lo = 0;
        if (MODE == 0) s_lo = t - 127 > 0 ? t - 127 : 0;
        if (MODE == 2) s_lo = t - 511 > 0 ? t - 511 : 0;
        if (MODE == 1) sm = selm[(size_t)(b * 2 + g) * SEQ + t];
        const bf16_t* kb = kv.base + (size_t)b * SEQ * kv.pitch + kv.koff + g * 64;
        const bf16_t* vb = kv.base + (size_t)b * SEQ * kv.pitch + kv.voff + g * 64;
        for (int s = s_lo; s <= t; ++s) {
            if (MODE == 1) { if (!((sm >> (s >> 6)) & 1u)) { s |= 63; continue; } }
            const u32x4* kp = (const u32x4*)(kb + (size_t)s * kv.pitch);
            float dot = 0.f;
#pragma unroll
            for (int c = 0; c < 8; ++c) { const u32x4 w = kp[c];
                dot += q[8 * c + 0] * bflo(w.x) + q[8 * c + 1] * bfhi(w.x) + q[8 * c + 2] * bflo(w.y) + q[8 * c + 3] * bfhi(w.y) + q[8 * c + 4] * bflo(w.z) + q[8 * c + 5] * bfhi(w.z) + q[8 * c + 6] * bflo(w.w) + q[8 * c + 7] * bfhi(w.w); }
            const float sc = dot + biasD[(t - s) * 16 + h];
            const float mn = fmaxf(mx, sc); const float al = __expf(mx - mn), p = __expf(sc - mn);
            l = l * al + p; mx = mn;
            const u32x4* vp = (const u32x4*)(vb + (size_t)s * kv.pitch);
#pragma unroll
            for (int c = 0; c < 8; ++c) { const u32x4 w = vp[c];
                o[8 * c + 0] = o[8 * c + 0] * al + p * bflo(w.x); o[8 * c + 1] = o[8 * c + 1] * al + p * bfhi(w.x); o[8 * c + 2] = o[8 * c + 2] * al + p * bflo(w.y); o[8 * c + 3] = o[8 * c + 3] * al + p * bfhi(w.y);
                o[8 * c + 4] = o[8 * c + 4] * al + p * bflo(w.z); o[8 * c + 5] = o[8 * c + 5] * al + p * bfhi(w.z); o[8 * c + 6] = o[8 * c + 6] * al + p * bflo(w.w); o[8 * c + 7] = o[8 * c + 7] * al + p * bfhi(w.w); }
        }
        float inv;
        if (MODE == 0) { const float sk = sinks[h]; const float mf = fmaxf(mx, sk); const float al = __expf(mx - mf); inv = al / (l * al + __expf(sk - mf)); }
        else inv = (l > 0.f ? 1.0f / l : 0.f) * gates[(size_t)m * 48 + h * 3 + MODE];
        const size_t ob = (size_t)m * DM + h * 64;
        if (MODE == 1) {
#pragma unroll
            for (int c = 0; c < 16; ++c) { f32x4 a = *(f32x4*)(Ocomb + ob + 4 * c); a.x += o[4 * c] * inv; a.y += o[4 * c + 1] * inv; a.z += o[4 * c + 2] * inv; a.w += o[4 * c + 3] * inv; *(f32x4*)(Ocomb + ob + 4 * c) = a; }
        } else {
#pragma unroll
            for (int c = 0; c < 8; ++c) { float e[8];
#pragma unroll
                for (int j = 0; j < 8; ++j) e[j] = o[8 * c + j] * inv;
                if (MODE == 2) { const f32x4 a0 = *(const f32x4*)(Ocomb + ob + 8 * c), a1 = *(const f32x4*)(Ocomb + ob + 8 * c + 4); e[0] += a0.x; e[1] += a0.y; e[2] += a0.z; e[3] += a0.w; e[4] += a1.x; e[5] += a1.y; e[6] += a1.z; e[7] += a1.w; }
                u32x4 w; w.x = pk2(e[0], e[1]); w.y = pk2(e[2], e[3]); w.z = pk2(e[4], e[5]); w.w = pk2(e[6], e[7]); *(u32x4*)(O + ob + 8 * c) = w; }
        }
    }
}

__device__ __forceinline__ float gelu_tanh(float x) { const float u = 0.7978845608028654f * (x + 0.044715f * x * x * x); const float e = __expf(2.0f * u); const float th = 1.0f - 2.0f / (e + 1.0f); return 0.5f * x * (1.0f + th); }
__device__ __forceinline__ void compress_simple(Frame& F) {
    unsigned char* ws = F.ws;
    const bf16_t* P = (const bf16_t*)(ws + WS_QKV);
    LAS float* xs = (LAS float*)F.lds;
    LAS float* hs = xs + 2048;
    LAS float* part = hs + 256;
    const int nitems = 2 * BATCH * 2 * NC;
    for (int it = F.bid; it < nitems; it += F.G) {
        const int c = it % NC, g = (it / NC) & 1, b = (it / (NC * 2)) % BATCH, kvi = it / (NC * 2 * BATCH);
        __syncthreads();
        { const int l = F.tid >> 4, d4 = (F.tid & 15) * 4; const bf16_t* src = P + (size_t)(b * SEQ + 16 * c + l) * PROJW + 1024 + kvi * 128 + g * 64 + d4;
          const u32x2 w = *(const u32x2*)src; xs[l * 64 + d4] = bflo(w.x); xs[l * 64 + d4 + 1] = bfhi(w.x); xs[l * 64 + d4 + 2] = bflo(w.y); xs[l * 64 + d4 + 3] = bfhi(w.y); }
        __syncthreads();
        { const int n = F.tid & 255, half = F.tid >> 8; const bf16_t* w1 = (const bf16_t*)(ws + WS_CW1) + (size_t)kvi * 256 * 2048 + (size_t)n * 2048 + half * 1024;
          float s = 0.f;
          for (int k = 0; k < 1024; k += 8) { const u32x4 w = *(const u32x4*)(w1 + k); const LAS float* x = xs + half * 1024 + k;
              s += x[0] * bflo(w.x) + x[1] * bfhi(w.x) + x[2] * bflo(w.y) + x[3] * bfhi(w.y) + x[4] * bflo(w.z) + x[5] * bfhi(w.z) + x[6] * bflo(w.w) + x[7] * bfhi(w.w); }
          part[F.tid] = s; }
        __syncthreads();
        if (F.tid < 256) hs[F.tid] = gelu_tanh(part[F.tid] + part[F.tid + 256] + ((const float*)(ws + WS_C1))[kvi * 256 + F.tid]);
        __syncthreads();
        if (F.tid < 64) { const bf16_t* w2 = (const bf16_t*)(ws + WS_CW2) + (size_t)kvi * 64 * 256 + (size_t)F.tid * 256; float s = 0.f;
            for (int n = 0; n < 256; n += 2) { const unsigned w = *(const unsigned*)(w2 + n); s += hs[n] * bflo(w) + hs[n + 1] * bfhi(w); }
            ((bf16_t*)(ws + WS_KCVC))[((size_t)((kvi * BATCH + b) * 2 + g) * 128 + c) * 64 + F.tid] = (bf16_t)f2bf(s); }
    }
}

__device__ __forceinline__ void cmp_simple(Frame& F) {
    unsigned char* ws = F.ws;
    const bf16_t* P = (const bf16_t*)(ws + WS_QKV);
    const float* biasD = (const float*)(ws + WS_BIASD);
    const float* gates = (const float*)(ws + WS_GATES);
    float* Ocomb = (float*)(ws + WS_OCOMB);
    unsigned* selm = (unsigned*)(ws + WS_SELM);
    LAS float* Pl = (LAS float*)F.lds;
    LAS float* sc = Pl + 1024;
    const int nitems = BATCH * 2 * SEQ;
    for (int it = F.bid; it < nitems; it += F.G) {
        const int t = it % SEQ, g = (it / SEQ) & 1, b = it / (SEQ * 2);
        const int m = b * SEQ + t, hh = F.wave, h = g * 8 + hh, lane = F.lane;
        const bf16_t* kc = (const bf16_t*)(ws + WS_KCVC) + (size_t)((0 * BATCH + b) * 2 + g) * 128 * 64;
        const bf16_t* vc = (const bf16_t*)(ws + WS_KCVC) + (size_t)((1 * BATCH + b) * 2 + g) * 128 * 64;
        const bf16_t* qp = P + (size_t)m * PROJW + h * 64;
        __syncthreads();
        float s2[2];
#pragma unroll
        for (int u = 0; u < 2; ++u) { const int c = lane + 64 * u; float dot = 0.f; const bool valid = (c < NC) && (16 * c + 31 <= t);
            if (valid) { const u32x4* kp = (const u32x4*)(kc + (size_t)c * 64); const u32x4* qq = (const u32x4*)qp;
#pragma unroll
                for (int j = 0; j < 8; ++j) { const u32x4 a = qq[j], w = kp[j];
                    dot += bflo(a.x) * bflo(w.x) + bfhi(a.x) * bfhi(w.x) + bflo(a.y) * bflo(w.y) + bfhi(a.y) * bfhi(w.y) + bflo(a.z) * bflo(w.z) + bfhi(a.z) * bfhi(w.z) + bflo(a.w) * bflo(w.w) + bfhi(a.w) * bfhi(w.w); }
                dot += biasD[(t - 16 * c - 31) * 16 + h]; }
            s2[u] = valid ? dot : NEG_BIG; }
        const float mx = wave_max(fmaxf(s2[0], s2[1]));
        const float e0 = s2[0] > -1e29f ? __expf(s2[0] - mx) : 0.f, e1 = s2[1] > -1e29f ? __expf(s2[1] - mx) : 0.f;
        const float l = wave_sum(e0 + e1); const float inv = l > 0.f ? 1.0f / l : 0.f;
        Pl[hh * 128 + lane] = e0 * inv; Pl[hh * 128 + 64 + lane] = e1 * inv;
        __syncthreads();
        { float o = 0.f; const int cmax = (t - 31) >= 0 ? (t - 31) / 16 : -1;
          for (int c = 0; c <= cmax && c < NC; ++c) o += Pl[hh * 128 + c] * bf2f(vc[(size_t)c * 64 + lane]);
          Ocomb[(size_t)m * DM + h * 64 + lane] = o * gates[(size_t)m * 48 + h * 3 + 0]; }
        if (F.tid < 32) { const int j = F.tid, cur = t >> 6; float imp = 0.f;
            for (int c = 4 * j - 1; c <= 4 * j + 3; ++c) if (c >= 0 && c < NC) { float a = 0.f;
#pragma unroll
                for (int q = 0; q < 8; ++q) a += Pl[q * 128 + c];
                imp += a; }
            const bool forced = (j == 0) || (cur - j >= 0 && cur - j < 2);
            sc[j] = forced ? 1e6f : (j <= cur ? imp : -1.0f); }
        __syncthreads();
        if (F.tid < 32) { const int j = F.tid; const float mine = sc[j]; int rank = 0;
            for (int k = 0; k < 32; ++k) { const float o = sc[k]; rank += (o > mine || (o == mine && k < j)) ? 1 : 0; }
            const unsigned long long bal = __ballot(rank < 16);
            if (j == 0) selm[(size_t)(b * 2 + g) * SEQ + t] = (unsigned)bal; }
    }
}


template <class Epi> __device__ __forceinline__ void gemm_fast(Frame& F, const bf16_t* A, const bf16_t* Bt, int N, int K, const Epi& E) {
    pg8::Gemm g{A, Bt, M, N, K}; pg8::StaticOrder S; S.init(M, N, F.G, F.bid);
    pg8::gemm_phase<Epi, pg8::StaticOrder, true, true>(F.lds, g, S, E);
}
constexpr int NPHASES = 17;
__global__ void __launch_bounds__(NTHR, 2) trunk_fwd(Args args) {
    extern __shared__ __attribute__((aligned(16))) unsigned char lds[];
    Frame F;
    F.lds = (LAS unsigned char*)lds;
    F.tid = threadIdx.x; F.lane = F.tid & 63; F.wave = __builtin_amdgcn_readfirstlane(F.tid >> 6);
    F.G = gridDim.x; F.bid = blockIdx.x; F.gw = F.bid * NWAVES + F.wave; F.ngw = F.G * NWAVES;
#pragma unroll
    for (int i = 0; i < 17; ++i) F.in[i] = args.in[i];
    F.out = args.out; F.ws = args.ws;
    unsigned char* ws = args.ws;
    volatile LAS unsigned* MISC = (volatile LAS unsigned*)(F.lds + MISC_OFF);
    if (F.tid < 32) MISC[F.tid] = 0u;
    __syncthreads();
    unsigned* barw = (unsigned*)(ws + WS_CTL) + CW_BAR + args.li * XCD_BAR_WORDS;
    XcdBarrier bar; bar.bar = barw; bar.x = 0; bar.st = nullptr;
    const int lo = args.ph_lo, hi = args.ph_hi;
    if (hi - lo > 1) bar = xcd_barrier_post(barw, MISC + 8);
#define IN(k) (lo <= (k) && (k) < hi)
#define SEAM(k) do { if (IN(k) && IN((k) + 1)) xcd_barrier(bar); } while (0)

    bf16_t* XA = (bf16_t*)(ws + WS_XA); bf16_t* QKV = (bf16_t*)(ws + WS_QKV); bf16_t* Ob = (bf16_t*)(ws + WS_O); bf16_t* HID = (bf16_t*)(ws + WS_HID);
    float* Hres = F.out; float* Ocomb = (float*)(ws + WS_OCOMB); float* gates = (float*)(ws + WS_GATES);
    const float* biasD = (const float*)(ws + WS_BIASD);

    if (IN(0)) { p0_prologue(F); } SEAM(0);
    if (IN(1)) { if (FAST_GEMM) gemm_fast(F, XA, (const bf16_t*)(ws + WS_WQKVA), AQKV, DM, pg8::EpiQkvF{QKV, F.in[6]}); else gemm_simple<false>(F, XA, DM, (const bf16_t*)(ws + WS_WQKVA), DM, AQKV / 64, EpiQkvA{QKV, F.in[6]}); } SEAM(1);
    if (IN(2)) { attn_simple<0>(F, QKV, AQKV, KVsrc{QKV, AQKV, 1024, 1152}, biasD, F.in[7], nullptr, nullptr, nullptr, Ob); } SEAM(2);
    if (IN(3)) { if (FAST_GEMM) gemm_fast(F, Ob, (const bf16_t*)(ws + WS_WOA), DM, DM, pg8::EpiResidF{F.in[0], Hres, F.in[9]}); else gemm_simple<false>(F, Ob, DM, (const bf16_t*)(ws + WS_WOA), DM, DM / 64, EpiResid{F.in[0], Hres, F.in[9]}); } SEAM(3);
    if (IN(4)) { norm_phase(F, Hres, F.in[3], XA); } SEAM(4);
    if (IN(5)) { if (FAST_GEMM) gemm_fast(F, XA, (const bf16_t*)(ws + WS_WGU), 2 * DFF, DM, pg8::EpiSwigluF{HID}); else gemm_simple<true>(F, XA, DM, (const bf16_t*)(ws + WS_WGU), DM, DFF / 32, EpiSwiglu{HID}); } SEAM(5);
    if (IN(6)) { if (FAST_GEMM) gemm_fast(F, HID, (const bf16_t*)(ws + WS_WDN), DM, DFF, pg8::EpiResidF{Hres, Hres, nullptr}); else gemm_simple<false>(F, HID, DFF, (const bf16_t*)(ws + WS_WDN), DFF, DM / 64, EpiResid{Hres, Hres, nullptr}); } SEAM(6);
    if (IN(7)) { norm_phase(F, Hres, F.in[2] + DM, XA); } SEAM(7);
    if (IN(8)) { if (FAST_GEMM) gemm_fast(F, XA, (const bf16_t*)(ws + WS_WIN), BINP, DM, pg8::EpiWinF{QKV, gates}); else gemm_simple<false>(F, XA, DM, (const bf16_t*)(ws + WS_WIN), DM, (BIN + 63) / 64, EpiWin{QKV, gates}); } SEAM(8);
    if (IN(9)) { compress_simple(F); } SEAM(9);
    if (IN(10)) { cmp_simple(F); } SEAM(10);
    if (IN(11)) { attn_simple<1>(F, QKV, PROJW, KVsrc{QKV, PROJW, 1024 + 2 * 128, 1024 + 3 * 128}, biasD, nullptr, gates, (const unsigned*)(ws + WS_SELM), Ocomb, Ob);
                  attn_simple<2>(F, QKV, PROJW, KVsrc{QKV, PROJW, 1024 + 4 * 128, 1024 + 5 * 128}, biasD, nullptr, gates, nullptr, Ocomb, Ob); } SEAM(11);
    if (IN(12)) { if (FAST_GEMM) gemm_fast(F, Ob, (const bf16_t*)(ws + WS_WOB), DM, DM, pg8::EpiResidF{Hres, Hres, nullptr}); else gemm_simple<false>(F, Ob, DM, (const bf16_t*)(ws + WS_WOB), DM, DM / 64, EpiResid{Hres, Hres, nullptr}); } SEAM(12);
    if (IN(13)) { norm_phase(F, Hres, F.in[3] + DM, XA); } SEAM(13);
    if (IN(14)) { if (FAST_GEMM) gemm_fast(F, XA, (const bf16_t*)(ws + WS_WGU) + (size_t)2 * DFF * DM, 2 * DFF, DM, pg8::EpiSwigluF{HID}); else gemm_simple<true>(F, XA, DM, (const bf16_t*)(ws + WS_WGU) + (size_t)2 * DFF * DM, DM, DFF / 32, EpiSwiglu{HID}); } SEAM(14);
    if (IN(15)) { if (FAST_GEMM) gemm_fast(F, HID, (const bf16_t*)(ws + WS_WDN) + (size_t)DM * DFF, DM, DFF, pg8::EpiResidF{Hres, Hres, nullptr}); else gemm_simple<false>(F, HID, DFF, (const bf16_t*)(ws + WS_WDN) + (size_t)DM * DFF, DFF, DM / 64, EpiResid{Hres, Hres, nullptr}); } SEAM(15);
    if (IN(16)) { final_norm_phase(F, Hres, F.in[4]); }
#undef IN
#undef SEAM
}

extern "C" void kernel_launch(void* const* d_in, const int* in_sizes, int n_in, void* d_out, int out_size, void* d_ws, size_t ws_size, hipStream_t stream) {
    static int grid = 0;
    if (grid == 0) {
        if (n_in != 17 || out_size != M * DM || ws_size < WS_END) { fprintf(stderr, "kernel_launch: unexpected shapes (n_in %d out %d ws %zu)\n", n_in, out_size, ws_size); grid = -1; return; }
        int dev = 0, cus = 0, per_cu = 0;
        (void)hipGetDevice(&dev); (void)hipDeviceGetAttribute(&cus, hipDeviceAttributeMultiprocessorCount, dev);
        (void)hipFuncSetAttribute((const void*)trunk_fwd, hipFuncAttributeMaxDynamicSharedMemorySize, LDS_BYTES);
        (void)hipOccupancyMaxActiveBlocksPerMultiprocessor(&per_cu, (const void*)trunk_fwd, NTHR, LDS_BYTES);
        (void)hipGetLastError();
        if (per_cu < 1) fprintf(stderr, "kernel_launch: occupancy query says %d blocks per CU\n", per_cu);
        grid = cus > 0 ? cus : 256;
    }
    if (grid < 0) return;
    (void)hipMemsetAsync((char*)d_ws + WS_CTL, 0, CTL_ZERO_BYTES, stream);
    Args a{};
    for (int i = 0; i < 17; ++i) a.in[i] = (const float*)d_in[i];
    a.out = (float*)d_out; a.ws = (unsigned char*)d_ws;
#if MK_ONE_LAUNCH
    a.ph_lo = 0; a.ph_hi = NPHASES; a.li = 0;
    void* kargs[] = {&a};
    hipError_t e = hipLaunchCooperativeKernel((const void*)trunk_fwd, dim3(grid), dim3(NTHR), kargs, LDS_BYTES, stream);
    if (e != hipSuccess) fprintf(stderr, "cooperative launch failed: %s\n", hipGetErrorString(e));
#else
    for (int p = 0; p < NPHASES; ++p) { a.ph_lo = p; a.ph_hi = p + 1; a.li = 0;
        hipLaunchKernelGGL(trunk_fwd, dim3(grid), dim3(NTHR), LDS_BYTES, stream, a); }
#endif
}
```

```cpp
#include <hip/hip_runtime.h>
#include <cstdio>
#include <cstdint>

#ifndef FAST_ATTN
#define FAST_ATTN 3
#endif
#ifndef FAST_GEMM
#define FAST_GEMM 1
#endif
#ifndef MK_ONE_LAUNCH
#define MK_ONE_LAUNCH 1
#endif

#define GAS __attribute__((address_space(1)))
#define LAS __attribute__((address_space(3)))
typedef unsigned short bf16_t;
typedef short bf16x8 __attribute__((ext_vector_type(8)));
typedef float f32x4 __attribute__((ext_vector_type(4)));
typedef float f32x16 __attribute__((ext_vector_type(16)));
typedef unsigned u32x4 __attribute__((ext_vector_type(4)));
typedef unsigned u32x2 __attribute__((ext_vector_type(2)));

constexpr int BATCH = 8, SEQ = 2048, DM = 1024, NH = 16, HD = 64, M = BATCH * SEQ;
constexpr int AQKV = 1280;
constexpr int BIN = 1840;
constexpr int BINP = 2048;
constexpr int PROJW = 1792;
constexpr int DFF = 2816;
constexpr int NC = 127;
constexpr int NSEL = 32;
constexpr int NWAVES = 8, NTHR = 512;
constexpr float RMS_EPS = 1e-6f;
constexpr float NEG_BIG = -1e30f;

constexpr size_t MiB = 1u << 20;
constexpr size_t WS_CTL = 0, CTL_ZERO_BYTES = 1 * MiB;
constexpr size_t WS_BIASD = 1 * MiB;
constexpr size_t WS_C1 = WS_BIASD + 128 * 1024;
constexpr size_t WS_KCVC = WS_C1 + 4096;
constexpr size_t WS_SELM = WS_KCVC + 512 * 1024;
constexpr size_t WS_GATES = 4 * MiB;
constexpr size_t WS_WQKVA = 8 * MiB;
constexpr size_t WS_WOA = WS_WQKVA + 3 * MiB;
constexpr size_t WS_WIN = WS_WOA + 2 * MiB;
constexpr size_t WS_WOB = WS_WIN + 4 * MiB;
constexpr size_t WS_WGU = WS_WOB + 2 * MiB;
constexpr size_t WS_WDN = WS_WGU + 22 * MiB;
constexpr size_t WS_CW1 = WS_WDN + 11 * MiB;
constexpr size_t WS_CW2 = WS_CW1 + 2 * MiB;
constexpr size_t WS_XA = 56 * MiB;
constexpr size_t WS_QKV = 88 * MiB;
constexpr size_t WS_O = 144 * MiB;
constexpr size_t WS_HID = WS_QKV;
constexpr size_t WS_OCOMB = 176 * MiB;
constexpr size_t WS_END = 240 * MiB;
static_assert(WS_CW2 + 64 * 1024 <= WS_XA, "weights fit");
static_assert(WS_SELM + 128 * 1024 <= WS_GATES, "small region");
constexpr int CW_BAR = 4096;

constexpr int LDS_MAIN = 147456;
constexpr int MISC_OFF = LDS_MAIN;
constexpr int LDS_BYTES = LDS_MAIN + 128;

#define RLX_AGENT __ATOMIC_RELAXED, __HIP_MEMORY_SCOPE_AGENT
__device__ __forceinline__ unsigned f2bf(float f) { unsigned u = __builtin_bit_cast(unsigned, f); return (u + 0x7fffu + ((u >> 16) & 1u)) >> 16; }
__device__ __forceinline__ unsigned pk2(float lo, float hi) { return f2bf(lo) | (f2bf(hi) << 16); }
__device__ __forceinline__ float bf2f(unsigned short b) { return __builtin_bit_cast(float, (unsigned)b << 16); }
__device__ __forceinline__ float bflo(unsigned w) { return __builtin_bit_cast(float, w << 16); }
__device__ __forceinline__ float bfhi(unsigned w) { return __builtin_bit_cast(float, w & 0xffff0000u); }
__device__ __forceinline__ float wave_sum(float v) {
#pragma unroll
    for (int o = 1; o < 64; o <<= 1) v += __shfl_xor(v, o);
    return v;
}
__device__ __forceinline__ float wave_max(float v) {
#pragma unroll
    for (int o = 1; o < 64; o <<= 1) v = fmaxf(v, __shfl_xor(v, o));
    return v;
}

#define XB_TMO      128
#define XB_XCNT(j)  (256  + 64 * (j))
#define XB_XSUB(j)  (1280 + 64 * (j))
#define XB_XGEN(j)  (2304 + 64 * (j))
#define XB_TOP      3328
#define XB_TOPGEN   3392
#define XCD_BAR_WORDS 3456
#define XB_SPIN_CAP (1u << 25)
__device__ __forceinline__ unsigned xb_ld(unsigned* p)              { return __hip_atomic_load(p, __ATOMIC_RELAXED, __HIP_MEMORY_SCOPE_AGENT); }
__device__ __forceinline__ unsigned xb_add(unsigned* p, unsigned v) { return __hip_atomic_fetch_add(p, v, __ATOMIC_RELAXED, __HIP_MEMORY_SCOPE_AGENT); }
__device__ __forceinline__ unsigned xb_xcc_id() { return (unsigned)__builtin_amdgcn_s_getreg((3 << 11) | 20) & 0xFu; }
#define XB_SPIN(cond, bar) do { unsigned _sp = 0; while (cond) { __builtin_amdgcn_s_sleep(1); \
    if ((++_sp & 255u) == 0u) { if (xb_ld(&(bar)[XB_TMO])) break; if (_sp > XB_SPIN_CAP) { atomicAdd(&(bar)[XB_TMO], 1u); break; } } } } while (0)
struct XcdBarrier { unsigned* bar; unsigned x; volatile LAS unsigned* st; };
__device__ __forceinline__ XcdBarrier xcd_barrier_post(unsigned* bar, volatile LAS unsigned* st) {
    XcdBarrier b; b.bar = bar; b.x = xb_xcc_id(); b.st = st;
    if (threadIdx.x == 0) (void)xb_add(&bar[XB_XCNT(b.x)], 1u);
    return b;
}
__device__ __forceinline__ void xcd_barrier_complete(unsigned* bar, unsigned x, unsigned& nloc, unsigned& nx) {
    const unsigned G = gridDim.x * gridDim.y * gridDim.z;
    unsigned sum, cnt, mine, sp = 0u;
    for (;;) {
        sum = 0u; cnt = 0u; mine = 0u;
#pragma unroll
        for (unsigned j = 0; j < 16; ++j) { const unsigned c = xb_ld(&bar[XB_XCNT(j)]); sum += c; cnt += (c > 0u) ? 1u : 0u; mine = (j == x) ? c : mine; }
        if (sum == G) break;
        __builtin_amdgcn_s_sleep(1);
        if ((++sp & 255u) == 0u) { if (xb_ld(&bar[XB_TMO])) break; if (sp > XB_SPIN_CAP) { atomicAdd(&bar[XB_TMO], 1u); break; } }
    }
    nloc = mine > 0u ? mine : 1u; nx = cnt > 0u ? cnt : 1u;
}
__device__ __forceinline__ void xcd_barrier(const XcdBarrier& b) {
    asm volatile("s_waitcnt vmcnt(0)" ::: "memory");
    __syncthreads();
    if (threadIdx.x == 0) {
        unsigned* bar = b.bar;
        __builtin_amdgcn_s_waitcnt(0);
        unsigned nloc = b.st[0], nx = b.st[1];
        if (nloc == 0u) { xcd_barrier_complete(bar, b.x, nloc, nx); b.st[0] = nloc; b.st[1] = nx; }
        const unsigned old = xb_add(&bar[XB_XSUB(b.x)], 1u);
        const unsigned gen = old / nloc;
        if (old + 1u == (gen + 1u) * nloc) {
            __builtin_amdgcn_fence(__ATOMIC_RELEASE, "agent");
            asm volatile("s_waitcnt vmcnt(0)" ::: "memory");
            const unsigned og = xb_add(&bar[XB_TOP], 1u);
            const unsigned tg = og / nx;
            if (og + 1u == (tg + 1u) * nx) xb_add(&bar[XB_TOPGEN], 1u);
            else XB_SPIN(xb_ld(&bar[XB_TOPGEN]) == tg, bar);
            __builtin_amdgcn_fence(__ATOMIC_ACQUIRE, "agent");
            xb_add(&bar[XB_XGEN(b.x)], 1u);
            asm volatile("s_waitcnt vmcnt(0)" ::: "memory");
        } else {
            XB_SPIN(xb_ld(&bar[XB_XGEN(b.x)]) == gen, bar);
            __builtin_amdgcn_fence(__ATOMIC_ACQUIRE, "agent");
            asm volatile("s_waitcnt vmcnt(0)" ::: "memory");
        }
    }
    __syncthreads();
}

namespace pg8 {
#define PG8_LAS __attribute__((address_space(3)))
typedef unsigned short bf16_t;
typedef short bf16x8 __attribute__((ext_vector_type(8)));
typedef float f32x4 __attribute__((ext_vector_type(4)));
typedef unsigned u32x4 __attribute__((ext_vector_type(4)));
constexpr int BM = 256, BK = 64, HALF = 128, HTB = HALF * BK * 2  , STAGE_BYTES = 8 * HTB, NXCD = 8, WGM = 8;

__host__ __device__ __forceinline__ int lds_byte(int r, int c) { const int st = (r >> 4) * 2 + (c >> 5), rr = r & 15, cc = c & 31, ob = rr * 64 + cc * 2; return st * 1024 + (ob ^ (((ob >> 9) & 1) << 5)); }
__host__ __device__ __forceinline__ void stage_rc(int b, int& R, int& C) { const int st = b / 1024, sb = b % 1024, swz = sb ^ (((sb >> 9) & 1) << 5); R = (st >> 1) * 16 + swz / 64; C = (st & 1) * 32 + (swz % 64) / 2; }
__host__ __device__ __forceinline__ int perm32(int rho) { const int n = rho >> 4, i = rho & 15; return 8 * (i >> 2) + 4 * n + (i & 3); }

struct Unit { int pm, pn; };
struct Gemm { const bf16_t* A; const bf16_t* Bt; int M, N, K; };

struct StaticOrder {
    int nM, nN, nwg, G, c;
    __host__ __device__ void init(int M, int N, int G_, int c_) { nM = M / BM; nN = N / BM; nwg = nM * nN; G = G_; c = c_; }
    __host__ __device__ bool next(int i, Unit& u) const {
        const long L = (long)i * G + c; if (L >= nwg) return false;
        int wgid = (int)L; { const int q = nwg / NXCD, r = nwg % NXCD, xcd = wgid % NXCD, off = wgid / NXCD; wgid = (xcd < r ? xcd * (q + 1) : r * (q + 1) + (xcd - r) * q) + off; }
        const int nig = WGM * nN, gid = wgid / nig, fm = gid * WGM, gsz = (nM - fm) < WGM ? (nM - fm) : WGM;
        u.pm = fm + ((wgid % nig) % gsz); u.pn = (wgid % nig) / gsz; return true;
    }
    __device__ __forceinline__ void a_ready(const Unit&) const {}
    __device__ __forceinline__ void done(const Unit&) const {}
};

__device__ __forceinline__ unsigned cvt_pk_bf16(float lo, float hi) { unsigned r; asm volatile("v_cvt_pk_bf16_f32 %0, %1, %2" : "=v"(r) : "v"(lo), "v"(hi)); return r; }
template <class Epi, class Sched, bool ALIGN_EPI = false, bool SP2 = false>
__device__ __forceinline__ void gemm_phase(PG8_LAS unsigned char* lds, const Gemm g, const Sched& S, const Epi& E) {
    const int tid = threadIdx.x, wid = __builtin_amdgcn_readfirstlane(tid >> 6), lane = tid & 63, wr = wid >> 2, wc = wid & 3, fr = lane & 15, fq = lane >> 4;
    const int K = g.K, nt = K / BK;
    unsigned voffA[2], voffB[2];
#pragma unroll
    for (int i = 0; i < 2; ++i) { int R, C; stage_rc(tid * 16 + i * 8192, R, C); const int Rb = Epi::PERM ? ((R & ~31) + perm32(R & 31)) : R;
        voffA[i] = (unsigned)(R * K + C) * 2u; voffB[i] = (unsigned)(Rb * K + C) * 2u; }
    const size_t kstep = (size_t)(BK * 2);
    const size_t hstep = (size_t)HALF * K * 2;
    const size_t tstep = 2 * hstep;
    const unsigned ldsw = (unsigned)wid * 1024u;
    const int aoff = lds_byte(wr * 64 + fr, fq * 8), boff = lds_byte(wc * 32 + fr, fq * 8);
#define PG8_SA(b, h) (((b) * 2 + (h)) * HTB)
#define PG8_SB(b, h) ((4 + (b) * 2 + (h)) * HTB)
#define PG8_STAGE(bufoff, gbase, voff) do { _Pragma("unroll") for (int _i = 0; _i < 2; ++_i) \
        __builtin_amdgcn_global_load_lds((const unsigned*)((const char*)(gbase) + (voff)[_i]), (PG8_LAS unsigned*)(lds + (bufoff) + ldsw + _i * 8192), 16, 0, 0); } while (0)
#define PG8_LDA(dst, b, h) do { _Pragma("unroll") for (int m = 0; m < 4; ++m) _Pragma("unroll") for (int k = 0; k < 2; ++k) dst[m][k] = *(const PG8_LAS bf16x8*)(lds + PG8_SA(b, h) + aoff + m * 2048 + k * 1024); } while (0)
#define PG8_LDB(dst, b, h) do { _Pragma("unroll") for (int n = 0; n < 2; ++n) _Pragma("unroll") for (int k = 0; k < 2; ++k) dst[n][k] = *(const PG8_LAS bf16x8*)(lds + PG8_SB(b, h) + boff + n * 2048 + k * 1024); } while (0)
#define PG8_MMA(ai, bj, At, Bt) do { __builtin_amdgcn_s_setprio(1); _Pragma("unroll") for (int m = 0; m < 4; ++m) _Pragma("unroll") for (int n = 0; n < 2; ++n) _Pragma("unroll") for (int k = 0; k < 2; ++k) \
        acc[ai][bj][m][n] = __builtin_amdgcn_mfma_f32_16x16x32_bf16(Bt[n][k], At[m][k], acc[ai][bj][m][n], 0, 0, 0); __builtin_amdgcn_s_setprio(0); } while (0)
#define PG8_WAIT_V(n) asm volatile("s_waitcnt vmcnt(" #n ")" ::: "memory")
#define PG8_WAIT_L(n) asm volatile("s_waitcnt lgkmcnt(" #n ")" ::: "memory")
#define PG8_BAR __builtin_amdgcn_s_barrier()
#define PG8_SCHED __builtin_amdgcn_sched_barrier(0)
    Unit cur, nxt; int ui = 0;
    if (!S.next(0, cur)) return;
    f32x4 acc[2][2][4][2];
#pragma unroll
    for (int a = 0; a < 2; ++a)
#pragma unroll
        for (int b = 0; b < 2; ++b)
#pragma unroll
            for (int m = 0; m < 4; ++m)
#pragma unroll
                for (int n = 0; n < 2; ++n) acc[a][b][m][n] = (f32x4){0.f, 0.f, 0.f, 0.f};
    bf16x8 At[4][2], B0[2][2], B1[2][2];
    const char* cA = (const char*)g.A + (size_t)cur.pm * tstep; const char* cB = (const char*)g.Bt + (size_t)cur.pn * tstep;
    S.a_ready(cur);
    if constexpr (SP2) {
        PG8_STAGE(PG8_SB(0, 0), cB, voffB); PG8_STAGE(PG8_SB(0, 1), cB + hstep, voffB); PG8_STAGE(PG8_SA(0, 0), cA, voffA); PG8_STAGE(PG8_SA(0, 1), cA + hstep, voffA);
        if (wr == 1) PG8_BAR;
        PG8_WAIT_V(2); PG8_BAR;
        PG8_STAGE(PG8_SB(1, 0), cB + kstep, voffB); PG8_STAGE(PG8_SA(1, 0), cA + kstep, voffA); PG8_STAGE(PG8_SB(1, 1), cB + hstep + kstep, voffB);
        PG8_WAIT_V(6); PG8_BAR;
    } else {
        PG8_STAGE(PG8_SB(0, 0), cB, voffB); PG8_STAGE(PG8_SA(0, 0), cA, voffA); PG8_STAGE(PG8_SB(0, 1), cB + hstep, voffB); PG8_STAGE(PG8_SA(0, 1), cA + hstep, voffA);
        if (wr == 1) PG8_BAR;
        PG8_WAIT_V(4); PG8_BAR;
        PG8_STAGE(PG8_SB(1, 0), cB + kstep, voffB); PG8_STAGE(PG8_SA(1, 0), cA + kstep, voffA); PG8_STAGE(PG8_SB(1, 1), cB + hstep + kstep, voffB);
        PG8_WAIT_V(6); PG8_BAR;
    }
    for (;;) {
        const bool has_next = S.next(ui + 1, nxt);
        const char* nA = has_next ? (const char*)g.A + (size_t)nxt.pm * tstep : cA; const char* nB = has_next ? (const char*)g.Bt + (size_t)nxt.pn * tstep : cB;
        for (int t = 0; t < nt; t += 2) {
            const bool last = (t == nt - 2);
            const char* a1 = cA + (size_t)(t + 1) * kstep;
            const char* a2 = last ? nA : cA + (size_t)(t + 2) * kstep; const char* b2 = last ? nB : cB + (size_t)(t + 2) * kstep;
            const char* a3 = a2 + kstep; const char* b3 = b2 + kstep;
            if (last && has_next) S.a_ready(nxt);
            if constexpr (SP2) {
            PG8_LDB(B0, 0, 0); PG8_LDB(B1, 0, 1); PG8_SCHED; PG8_LDA(At, 0, 0); PG8_STAGE(PG8_SA(1, 1), a1 + hstep, voffA);
            PG8_WAIT_V(8); PG8_WAIT_L(0); PG8_BAR; PG8_MMA(0, 0, At, B0); PG8_MMA(0, 1, At, B1); PG8_BAR; PG8_SCHED;
            PG8_LDA(At, 0, 1); PG8_STAGE(PG8_SB(0, 0), b2, voffB); PG8_STAGE(PG8_SB(0, 1), b2 + hstep, voffB); PG8_STAGE(PG8_SA(0, 0), a2, voffA);
            PG8_WAIT_V(8); PG8_WAIT_L(0); PG8_BAR; PG8_MMA(1, 0, At, B0); PG8_MMA(1, 1, At, B1); PG8_BAR; PG8_SCHED;
            PG8_LDB(B0, 1, 0); PG8_LDB(B1, 1, 1); PG8_SCHED; PG8_LDA(At, 1, 0); PG8_STAGE(PG8_SA(0, 1), a2 + hstep, voffA);
            PG8_WAIT_V(8); PG8_WAIT_L(0); PG8_BAR; PG8_MMA(0, 0, At, B0); PG8_MMA(0, 1, At, B1); PG8_BAR; PG8_SCHED;
            PG8_LDA(At, 1, 1); PG8_STAGE(PG8_SB(1, 0), b3, voffB); PG8_STAGE(PG8_SB(1, 1), b3 + hstep, voffB); PG8_STAGE(PG8_SA(1, 0), a3, voffA);
            PG8_WAIT_V(8); PG8_WAIT_L(0); PG8_BAR; PG8_MMA(1, 0, At, B0); PG8_MMA(1, 1, At, B1); PG8_BAR; PG8_SCHED;
            } else {
            PG8_LDB(B0, 0, 0); PG8_SCHED; PG8_LDA(At, 0, 0); PG8_STAGE(PG8_SA(1, 1), a1 + hstep, voffA);
            PG8_WAIT_L(8); PG8_BAR; PG8_WAIT_L(0); PG8_MMA(0, 0, At, B0); PG8_BAR; PG8_SCHED;
            PG8_LDB(B1, 0, 1); PG8_STAGE(PG8_SB(0, 0), b2, voffB);
            PG8_BAR; PG8_WAIT_L(0); PG8_MMA(0, 1, At, B1); PG8_BAR;
            PG8_LDA(At, 0, 1); PG8_STAGE(PG8_SA(0, 0), a2, voffA);
            PG8_BAR; PG8_WAIT_L(0); PG8_MMA(1, 0, At, B0); PG8_BAR; PG8_SCHED;
            PG8_STAGE(PG8_SB(0, 1), b2 + hstep, voffB);
            PG8_WAIT_V(6); PG8_BAR; PG8_MMA(1, 1, At, B1); PG8_BAR;
            PG8_LDB(B0, 1, 0); PG8_SCHED; PG8_LDA(At, 1, 0); PG8_STAGE(PG8_SA(0, 1), a2 + hstep, voffA);
            PG8_WAIT_L(8); PG8_BAR; PG8_WAIT_L(0); PG8_MMA(0, 0, At, B0); PG8_BAR; PG8_SCHED;
            PG8_LDB(B1, 1, 1); PG8_STAGE(PG8_SB(1, 0), b3, voffB);
            PG8_BAR; PG8_WAIT_L(0); PG8_MMA(0, 1, At, B1); PG8_BAR;
            PG8_LDA(At, 1, 1); PG8_STAGE(PG8_SA(1, 0), a3, voffA);
            PG8_BAR; PG8_WAIT_L(0); PG8_MMA(1, 0, At, B0); PG8_BAR; PG8_SCHED;
            PG8_STAGE(PG8_SB(1, 1), b3 + hstep, voffB);
            PG8_WAIT_V(6); PG8_BAR; PG8_MMA(1, 1, At, B1); PG8_BAR;
            }
        }
        if constexpr (ALIGN_EPI) { if (wr == 0) PG8_BAR; }
        if constexpr (!Epi::AFTER_DRAIN) { E(acc, cur, wr, wc, fr, fq); S.done(cur); }
        if (!has_next) break;
#pragma unroll
        for (int a = 0; a < 2; ++a)
#pragma unroll
            for (int b = 0; b < 2; ++b)
#pragma unroll
                for (int m = 0; m < 4; ++m)
#pragma unroll
                    for (int n = 0; n < 2; ++n) acc[a][b][m][n] = (f32x4){0.f, 0.f, 0.f, 0.f};
        cur = nxt; cA = nA; cB = nB; ++ui;
        if constexpr (ALIGN_EPI) { if (wr == 1) PG8_BAR; }
    }
    PG8_WAIT_V(0);
    if constexpr (!ALIGN_EPI) { if (wr == 0) PG8_BAR; }
    PG8_BAR;
    if constexpr (Epi::AFTER_DRAIN) { E.fused(acc, cur, wr, wc, fr, fq, lds, wid, lane); S.done(cur); }
#undef PG8_SA
#undef PG8_SB
#undef PG8_STAGE
#undef PG8_LDA
#undef PG8_LDB
#undef PG8_MMA
#undef PG8_WAIT_V
#undef PG8_WAIT_L
#undef PG8_BAR
#undef PG8_SCHED
}
}

namespace pg8 {
struct EpiQkvF { static constexpr bool PERM = true, AFTER_DRAIN = false; bf16_t* O; const float* bias;
    __device__ __forceinline__ void operator()(const f32x4 (&acc)[2][2][4][2], const Unit& u, int wr, int wc, int fr, int fq) const {
        const int row0 = u.pm * BM + wr * 64 + fr, col0 = u.pn * BM + wc * 32 + 8 * fq; const float sc = (u.pn < 4) ? 0.125f : 1.0f;
        f32x4 bv[2][2];
#pragma unroll
        for (int bj = 0; bj < 2; ++bj)
#pragma unroll
            for (int n = 0; n < 2; ++n) bv[bj][n] = *(const f32x4*)(bias + col0 + bj * HALF + 4 * n) * sc;
#pragma unroll
        for (int ai = 0; ai < 2; ++ai)
#pragma unroll
            for (int m = 0; m < 4; ++m) { bf16_t* rowp = O + (size_t)(row0 + ai * HALF + m * 16) * 1280 + col0;
#pragma unroll
                for (int bj = 0; bj < 2; ++bj) { const f32x4 v0 = acc[ai][bj][m][0] + bv[bj][0], v1 = acc[ai][bj][m][1] + bv[bj][1];
                    u32x4 w; w.x = cvt_pk_bf16(v0[0], v0[1]); w.y = cvt_pk_bf16(v0[2], v0[3]); w.z = cvt_pk_bf16(v1[0], v1[1]); w.w = cvt_pk_bf16(v1[2], v1[3]);
                    *(u32x4*)(rowp + bj * HALF) = w; } }
    }
};
struct EpiResidF { static constexpr bool PERM = false, AFTER_DRAIN = false; const float* base; float* out; const float* bias;
    __device__ __forceinline__ void operator()(const f32x4 (&acc)[2][2][4][2], const Unit& u, int wr, int wc, int fr, int fq) const {
        const int col0 = u.pn * BM + wc * 32 + 4 * fq;
        f32x4 bv[2][2];
#pragma unroll
        for (int bj = 0; bj < 2; ++bj)
#pragma unroll
            for (int n = 0; n < 2; ++n) bv[bj][n] = bias ? *(const f32x4*)(bias + col0 + bj * HALF + n * 16) : (f32x4){0.f, 0.f, 0.f, 0.f};
#pragma unroll
        for (int ai = 0; ai < 2; ++ai)
#pragma unroll
            for (int m = 0; m < 4; ++m) { const size_t off = (size_t)(u.pm * BM + ai * HALF + wr * 64 + m * 16 + fr) * 1024 + col0;
#pragma unroll
                for (int bj = 0; bj < 2; ++bj)
#pragma unroll
                    for (int n = 0; n < 2; ++n) { const f32x4 bs = *(const f32x4*)(base + off + bj * HALF + n * 16); *(f32x4*)(out + off + bj * HALF + n * 16) = bs + acc[ai][bj][m][n] + bv[bj][n]; }
                if (m & 1) asm volatile("" ::: "memory"); }
    }
};
struct EpiSwigluF { static constexpr bool PERM = true, AFTER_DRAIN = false; bf16_t* O;
    __device__ __forceinline__ float silu_mul(float g, float u) const { return g * __builtin_amdgcn_rcpf(1.0f + __expf(-g)) * u; }
    __device__ __forceinline__ void operator()(const f32x4 (&acc)[2][2][4][2], const Unit& u, int wr, int wc, int fr, int fq) const {
        const int row0 = u.pm * BM + wr * 64 + fr, f0 = u.pn * HALF + wc * 32 + 8 * fq;
#pragma unroll
        for (int ai = 0; ai < 2; ++ai)
#pragma unroll
            for (int m = 0; m < 4; ++m) { const f32x4 g0 = acc[ai][0][m][0], g1 = acc[ai][0][m][1], u0 = acc[ai][1][m][0], u1 = acc[ai][1][m][1];
                u32x4 w; w.x = cvt_pk_bf16(silu_mul(g0[0], u0[0]), silu_mul(g0[1], u0[1])); w.y = cvt_pk_bf16(silu_mul(g0[2], u0[2]), silu_mul(g0[3], u0[3]));
                w.z = cvt_pk_bf16(silu_mul(g1[0], u1[0]), silu_mul(g1[1], u1[1])); w.w = cvt_pk_bf16(silu_mul(g1[2], u1[2]), silu_mul(g1[3], u1[3]));
                *(u32x4*)(O + (size_t)(row0 + ai * HALF + m * 16) * 2816 + f0) = w; }
    }
};
struct EpiWinF { static constexpr bool PERM = true, AFTER_DRAIN = false; bf16_t* P; float* gates;
    __device__ __forceinline__ void operator()(const f32x4 (&acc)[2][2][4][2], const Unit& u, int wr, int wc, int fr, int fq) const {
        const int row0 = u.pm * BM + wr * 64 + fr, col0 = u.pn * BM + wc * 32 + 8 * fq;
        if (u.pn < 7) {
#pragma unroll
            for (int ai = 0; ai < 2; ++ai)
#pragma unroll
                for (int m = 0; m < 4; ++m) { bf16_t* rowp = P + (size_t)(row0 + ai * HALF + m * 16) * 1792 + col0;
#pragma unroll
                    for (int bj = 0; bj < 2; ++bj) { const f32x4 v0 = acc[ai][bj][m][0], v1 = acc[ai][bj][m][1];
                        u32x4 w; w.x = cvt_pk_bf16(v0[0], v0[1]); w.y = cvt_pk_bf16(v0[2], v0[3]); w.z = cvt_pk_bf16(v1[0], v1[1]); w.w = cvt_pk_bf16(v1[2], v1[3]);
                        *(u32x4*)(rowp + bj * HALF) = w; } }
        } else {
            const int gc = wc * 32 + 8 * fq;
            if (gc < 48) {
#pragma unroll
                for (int ai = 0; ai < 2; ++ai)
#pragma unroll
                    for (int m = 0; m < 4; ++m) { float* gp = gates + (size_t)(row0 + ai * HALF + m * 16) * 48 + gc;
#pragma unroll
                        for (int n = 0; n < 2; ++n) { const f32x4 v = acc[ai][0][m][n]; f32x4 s;
#pragma unroll
                            for (int j = 0; j < 4; ++j) s[j] = __builtin_amdgcn_rcpf(1.0f + __expf(-v[j]));
                            *(f32x4*)(gp + 4 * n) = s; } }
            }
        }
    }
};
}

struct Args { const float* in[17]; float* out; unsigned char* ws; int ph_lo, ph_hi, li, pad; };
struct Frame {
    LAS unsigned char* lds;
    int tid, lane, wave, G, bid;
    int gw, ngw;
    const float* in[17]; float* out; unsigned char* ws;
};

__device__ __forceinline__ int t5_bucket(int n) {
    if (n < 16) return n;
    const float nf = (float)n;
    const int lb = 16 + (int)(logf(nf / 16.0f) / 4.1588830833596715f * 16.0f);
    return lb < 31 ? lb : 31;
}

struct RmPlain { int off; float s; __device__ int row(int n) const { return n + off; } __device__ float scale(int) const { return s; } };
struct RmQScale { int nq; __device__ int row(int n) const { return n; } __device__ float scale(int n) const { return n < nq ? 0.125f : 1.0f; } };
struct RmGU { __device__ int row(int n) const { const int up = n >= DFF; const int f = up ? n - DFF : n; return (f >> 7) * 256 + (up ? 128 : 0) + (f & 127); } __device__ float scale(int) const { return 1.0f; } };

template <class RM>
__device__ __forceinline__ void transpose_item(const float* W, int K, int N, bf16_t* WT, LAS float* scr, int item, int lane, const RM rm) {
    const int nblk = (N + 31) / 32, kb = item / nblk, nb = item % nblk, k0 = 64 * kb, n0 = 32 * nb;
    const int nl = n0 + (lane & 31);
#pragma unroll 8
    for (int i = 0; i < 32; ++i) { const int kk = 2 * i + (lane >> 5); scr[kk * 33 + (lane & 31)] = (nl < N) ? W[(size_t)(k0 + kk) * N + nl] : 0.f; }
    asm volatile("s_waitcnt lgkmcnt(0)" ::: "memory");
    const int c = lane & 7;
#pragma unroll
    for (int j = 0; j < 4; ++j) { const int nn = (lane >> 3) + 8 * j; const int n = n0 + nn; const LAS float* s = scr + (8 * c) * 33 + nn;
        if (n < N) { const float sc = rm.scale(n);
            u32x4 o; o.x = pk2(s[0 * 33] * sc, s[1 * 33] * sc); o.y = pk2(s[2 * 33] * sc, s[3 * 33] * sc); o.z = pk2(s[4 * 33] * sc, s[5 * 33] * sc); o.w = pk2(s[6 * 33] * sc, s[7 * 33] * sc);
            *(u32x4*)(WT + (size_t)rm.row(n) * K + k0 + 8 * c) = o; } }
    asm volatile("s_waitcnt lgkmcnt(0)" ::: "memory");
}
template <class RM>
__device__ __forceinline__ void transpose_all(Frame& F, const float* W, int K, int N, bf16_t* WT, const RM rm) {
    LAS float* scr = (LAS float*)(F.lds + F.wave * 16384);
    const int nitems = (K / 64) * ((N + 31) / 32);
    for (int it = F.gw; it < nitems; it += F.ngw) transpose_item(W, K, N, WT, scr, it, F.lane, rm);
}
__device__ __forceinline__ void rms_row_to_bf16(const float* xrow, const float* g, bf16_t* orow, int lane) {
    const f32x4* xr = (const f32x4*)xrow + lane; const f32x4* gr = (const f32x4*)g + lane;
    f32x4 v[4]; float s = 0.f;
#pragma unroll
    for (int j = 0; j < 4; ++j) { v[j] = xr[64 * j]; s += (v[j].x * v[j].x + v[j].y * v[j].y) + (v[j].z * v[j].z + v[j].w * v[j].w); }
    const float rstd = 1.0f / sqrtf(wave_sum(s) * (1.0f / DM) + RMS_EPS);
    unsigned long long* o8 = (unsigned long long*)orow + lane;
#pragma unroll
    for (int j = 0; j < 4; ++j) { const f32x4 gg = gr[64 * j];
        o8[64 * j] = (unsigned long long)pk2(v[j].x * rstd * gg.x, v[j].y * rstd * gg.y) | ((unsigned long long)pk2(v[j].z * rstd * gg.z, v[j].w * rstd * gg.w) << 32); }
}
__device__ __forceinline__ void norm_phase(Frame& F, const float* H, const float* g, bf16_t* XA) {
    for (int m = F.gw; m < M; m += F.ngw) rms_row_to_bf16(H + (size_t)m * DM, g, XA + (size_t)m * DM, F.lane);
}
__device__ __forceinline__ void final_norm_phase(Frame& F, float* H, const float* g) {
    for (int m = F.gw; m < M; m += F.ngw) {
        f32x4* xr = (f32x4*)(H + (size_t)m * DM) + F.lane; const f32x4* gr = (const f32x4*)g + F.lane;
        f32x4 v[4]; float s = 0.f;
#pragma unroll
        for (int j = 0; j < 4; ++j) { v[j] = xr[64 * j]; s += (v[j].x * v[j].x + v[j].y * v[j].y) + (v[j].z * v[j].z + v[j].w * v[j].w); }
        const float rstd = 1.0f / sqrtf(wave_sum(s) * (1.0f / DM) + RMS_EPS);
#pragma unroll
        for (int j = 0; j < 4; ++j) { const f32x4 gg = gr[64 * j]; f32x4 o; o.x = v[j].x * rstd * gg.x; o.y = v[j].y * rstd * gg.y; o.z = v[j].z * rstd * gg.z; o.w = v[j].w * rstd * gg.w; xr[64 * j] = o; }
    }
}
__device__ __forceinline__ void p0_prologue(Frame& F) {
    unsigned char* ws = F.ws;
    transpose_all(F, F.in[5], DM, AQKV, (bf16_t*)(ws + WS_WQKVA), RmQScale{1024});
    transpose_all(F, F.in[8], DM, DM, (bf16_t*)(ws + WS_WOA), RmPlain{0, 1.f});
    transpose_all(F, F.in[10], DM, BIN, (bf16_t*)(ws + WS_WIN), RmQScale{1024});
    transpose_all(F, F.in[14], DM, DM, (bf16_t*)(ws + WS_WOB), RmPlain{0, 1.f});
    for (int l = 0; l < 2; ++l) {
        transpose_all(F, F.in[15] + (size_t)l * DM * 2 * DFF, DM, 2 * DFF, (bf16_t*)(ws + WS_WGU) + (size_t)l * 2 * DFF * DM, RmGU{});
        transpose_all(F, F.in[16] + (size_t)l * DFF * DM, DFF, DM, (bf16_t*)(ws + WS_WDN) + (size_t)l * DM * DFF, RmPlain{0, 1.f});
        transpose_all(F, F.in[12] + (size_t)l * 2048 * 256, 2048, 256, (bf16_t*)(ws + WS_CW1) + (size_t)l * 256 * 2048, RmPlain{0, 1.f});
        transpose_all(F, F.in[13] + (size_t)l * 256 * 64, 256, 64, (bf16_t*)(ws + WS_CW2) + (size_t)l * 64 * 256, RmPlain{0, 1.f});
    }
    { u32x4* z = (u32x4*)((bf16_t*)(ws + WS_WIN) + (size_t)BIN * DM); const int n16 = (BINP - BIN) * DM * 2 / 16;
      for (int i = F.bid * NTHR + F.tid; i < n16; i += F.G * NTHR) z[i] = (u32x4){0u, 0u, 0u, 0u}; }
    { float* bd = (float*)(ws + WS_BIASD); const float* rt = F.in[1];
      for (int i = F.bid * NTHR + F.tid; i < 2048 * 16; i += F.G * NTHR) { const int d = i >> 4, h = i & 15; bd[i] = rt[t5_bucket(d) * 16 + h]; } }
    { float* c1 = (float*)(ws + WS_C1);
      for (int o = F.gw; o < 512; o += F.ngw) { const int kv = o >> 8, n = o & 255; const float* pos = F.in[11] + kv * 2048; const float* w1 = F.in[12] + (size_t)kv * 2048 * 256;
          float s = 0.f; for (int k = F.lane; k < 2048; k += 64) s += pos[k] * w1[(size_t)k * 256 + n];
          s = wave_sum(s); if (F.lane == 0) c1[o] = s; } }
    norm_phase(F, F.in[0], F.in[2], (bf16_t*)(ws + WS_XA));
}

template <bool DUAL, class Epi>
__device__ __forceinline__ void gemm_simple(Frame& F, const bf16_t* A, int lda, const bf16_t* Bt, int K, int nfeat_tiles, const Epi& E) {
    const int lane = F.lane, r32 = lane & 31, hi = lane >> 5;
    const int ntiles = (M / 64) * nfeat_tiles;
    for (int t = F.gw; t < ntiles; t += F.ngw) {
        const int mt = t / nfeat_tiles, ft = t % nfeat_tiles;
        const int m0 = mt * 64;
        int brow0, brow1, f0;
        if (DUAL) { f0 = ft * 32; brow0 = (f0 >> 7) * 256 + (f0 & 127); brow1 = brow0 + 128; }
        else { f0 = ft * 64; brow0 = f0; brow1 = f0 + 32; }
        const bf16_t* a0 = A + (size_t)(m0 + r32) * lda + 8 * hi; const bf16_t* a1 = a0 + (size_t)32 * lda;
        const bf16_t* b0 = Bt + (size_t)(brow0 + r32) * K + 8 * hi; const bf16_t* b1 = Bt + (size_t)(brow1 + r32) * K + 8 * hi;
        f32x16 acc00 = {}, acc01 = {}, acc10 = {}, acc11 = {};
#pragma unroll 4
        for (int k = 0; k < K; k += 16) {
            const bf16x8 fa0 = *(const bf16x8*)(a0 + k), fa1 = *(const bf16x8*)(a1 + k), fb0 = *(const bf16x8*)(b0 + k), fb1 = *(const bf16x8*)(b1 + k);
            acc00 = __builtin_amdgcn_mfma_f32_32x32x16_bf16(fa0, fb0, acc00, 0, 0, 0);
            acc01 = __builtin_amdgcn_mfma_f32_32x32x16_bf16(fa0, fb1, acc01, 0, 0, 0);
            acc10 = __builtin_amdgcn_mfma_f32_32x32x16_bf16(fa1, fb0, acc10, 0, 0, 0);
            acc11 = __builtin_amdgcn_mfma_f32_32x32x16_bf16(fa1, fb1, acc11, 0, 0, 0);
        }
#pragma unroll
        for (int r = 0; r < 16; ++r) {
            const int row = m0 + (r & 3) + 8 * (r >> 2) + 4 * hi;
            if (DUAL) { E(row, f0 + r32, acc00[r], acc01[r]); E(row + 32, f0 + r32, acc10[r], acc11[r]); }
            else { E(row, f0 + r32, acc00[r], 0.f); E(row, f0 + 32 + r32, acc01[r], 0.f); E(row + 32, f0 + r32, acc10[r], 0.f); E(row + 32, f0 + 32 + r32, acc11[r], 0.f); }
        }
    }
}
struct EpiQkvA { bf16_t* O; const float* bias; __device__ void operator()(int m, int n, float v, float) const { const float b = bias[n] * (n < 1024 ? 0.125f : 1.0f); O[(size_t)m * AQKV + n] = (bf16_t)f2bf(v + b); } };
struct EpiResid { const float* base; float* out; const float* bias; __device__ void operator()(int m, int n, float v, float) const { const size_t i = (size_t)m * DM + n; out[i] = base[i] + v + (bias ? bias[n] : 0.f); } };
struct EpiSwiglu { bf16_t* O; __device__ void operator()(int m, int f, float g, float u) const { const float s = g / (1.0f + __expf(-g)); O[(size_t)m * DFF + f] = (bf16_t)f2bf(s * u); } };
struct EpiWin { bf16_t* P; float* gates; __device__ void operator()(int m, int n, float v, float) const {
    if (n < PROJW) P[(size_t)m * PROJW + n] = (bf16_t)f2bf(v);
    else if (n < BIN) gates[(size_t)m * 48 + (n - PROJW)] = 1.0f / (1.0f + __expf(-v)); } };

struct KVsrc { const bf16_t* base; int pitch; int koff, voff; };
template <int MODE  >
__device__ __forceinline__ void attn_simple(Frame& F, const bf16_t* Q, int qpitch, KVsrc kv, const float* biasD, const float* sinks, const float* gates, const unsigned* selm, float* Ocomb, bf16_t* O) {
    const int nitems = M * NH / NTHR;
    for (int it = F.bid; it < nitems; it += F.G) {
        const int idx = it * NTHR + F.tid; const int m = idx >> 4, h = idx & 15, g = h >> 3;
        const int b = m / SEQ, t = m % SEQ;
        float q[64];
        { const u32x4* qp = (const u32x4*)(Q + (size_t)m * qpitch + h * 64);
#pragma unroll
          for (int c = 0; c < 8; ++c) { const u32x4 w = qp[c]; q[8 * c + 0] = bflo(w.x); q[8 * c + 1] = bfhi(w.x); q[8 * c + 2] = bflo(w.y); q[8 * c + 3] = bfhi(w.y); q[8 * c + 4] = bflo(w.z); q[8 * c + 5] = bfhi(w.z); q[8 * c + 6] = bflo(w.w); q[8 * c + 7] = bfhi(w.w); } }
        float o[64];
#pragma unroll
        for (int d = 0; d < 64; ++d) o[d] = 0.f;
        float mx = -1e20f, l = 0.f;
        unsigned sm = 0xffffffffu; int s_lo = 0;
        if (MODE == 0) s_lo = t - 127 > 0 ? t - 127 : 0;
        if (MODE == 2) s_lo = t - 511 > 0 ? t - 511 : 0;
        if (MODE == 1) sm = selm[(size_t)(b * 2 + g) * SEQ + t];
        const bf16_t* kb = kv.base + (size_t)b * SEQ * kv.pitch + kv.koff + g * 64;
        const bf16_t* vb = kv.base + (size_t)b * SEQ * kv.pitch + kv.voff + g * 64;
        for (int s = s_lo; s <= t; ++s) {
            if (MODE == 1) { if (!((sm >> (s >> 6)) & 1u)) { s |= 63; continue; } }
            const u32x4* kp = (const u32x4*)(kb + (size_t)s * kv.pitch);
            float dot = 0.f;
#pragma unroll
            for (int c = 0; c < 8; ++c) { const u32x4 w = kp[c];
                dot += q[8 * c + 0] * bflo(w.x) + q[8 * c + 1] * bfhi(w.x) + q[8 * c + 2] * bflo(w.y) + q[8 * c + 3] * bfhi(w.y) + q[8 * c + 4] * bflo(w.z) + q[8 * c + 5] * bfhi(w.z) + q[8 * c + 6] * bflo(w.w) + q[8 * c + 7] * bfhi(w.w); }
            const float sc = dot + biasD[(t - s) * 16 + h];
            const float mn = fmaxf(mx, sc); const float al = __expf(mx - mn), p = __expf(sc - mn);
            l = l * al + p; mx = mn;
            const u32x4* vp = (const u32x4*)(vb + (size_t)s * kv.pitch);
#pragma unroll
            for (int c = 0; c < 8; ++c) { const u32x4 w = vp[c];
                o[8 * c + 0] = o[8 * c + 0] * al + p * bflo(w.x); o[8 * c + 1] = o[8 * c + 1] * al + p * bfhi(w.x); o[8 * c + 2] = o[8 * c + 2] * al + p * bflo(w.y); o[8 * c + 3] = o[8 * c + 3] * al + p * bfhi(w.y);
                o[8 * c + 4] = o[8 * c + 4] * al + p * bflo(w.z); o[8 * c + 5] = o[8 * c + 5] * al + p * bfhi(w.z); o[8 * c + 6] = o[8 * c + 6] * al + p * bflo(w.w); o[8 * c + 7] = o[8 * c + 7] * al + p * bfhi(w.w); }
        }
        float inv;
        if (MODE == 0) { const float sk = sinks[h]; const float mf = fmaxf(mx, sk); const float al = __expf(mx - mf); inv = al / (l * al + __expf(sk - mf)); }
        else inv = (l > 0.f ? 1.0f / l : 0.f) * gates[(size_t)m * 48 + h * 3 + MODE];
        const size_t ob = (size_t)m * DM + h * 64;
        if (MODE == 1) {
#pragma unroll
            for (int c = 0; c < 16; ++c) { f32x4 a = *(f32x4*)(Ocomb + ob + 4 * c); a.x += o[4 * c] * inv; a.y += o[4 * c + 1] * inv; a.z += o[4 * c + 2] * inv; a.w += o[4 * c + 3] * inv; *(f32x4*)(Ocomb + ob + 4 * c) = a; }
        } else {
#pragma unroll
            for (int c = 0; c < 8; ++c) { float e[8];
#pragma unroll
                for (int j = 0; j < 8; ++j) e[j] = o[8 * c + j] * inv;
                if (MODE == 2) { const f32x4 a0 = *(const f32x4*)(Ocomb + ob + 8 * c), a1 = *(const f32x4*)(Ocomb + ob + 8 * c + 4); e[0] += a0.x; e[1] += a0.y; e[2] += a0.z; e[3] += a0.w; e[4] += a1.x; e[5] += a1.y; e[6] += a1.z; e[7] += a1.w; }
                u32x4 w; w.x = pk2(e[0], e[1]); w.y = pk2(e[2], e[3]); w.z = pk2(e[4], e[5]); w.w = pk2(e[6], e[7]); *(u32x4*)(O + ob + 8 * c) = w; }
        }
    }
}

__device__ __forceinline__ float gelu_tanh(float x) { const float u = 0.7978845608028654f * (x + 0.044715f * x * x * x); const float e = __expf(2.0f * u); const float th = 1.0f - 2.0f / (e + 1.0f); return 0.5f * x * (1.0f + th); }
__device__ __forceinline__ void compress_simple(Frame& F) {
    unsigned char* ws = F.ws;
    const bf16_t* P = (const bf16_t*)(ws + WS_QKV);
    LAS float* xs = (LAS float*)F.lds;
    LAS float* hs = xs + 2048;
    LAS float* part = hs + 256;
    const int nitems = 2 * BATCH * 2 * NC;
    for (int it = F.bid; it < nitems; it += F.G) {
        const int c = it % NC, g = (it / NC) & 1, b = (it / (NC * 2)) % BATCH, kvi = it / (NC * 2 * BATCH);
        __syncthreads();
        { const int l = F.tid >> 4, d4 = (F.tid & 15) * 4; const bf16_t* src = P + (size_t)(b * SEQ + 16 * c + l) * PROJW + 1024 + kvi * 128 + g * 64 + d4;
          const u32x2 w = *(const u32x2*)src; xs[l * 64 + d4] = bflo(w.x); xs[l * 64 + d4 + 1] = bfhi(w.x); xs[l * 64 + d4 + 2] = bflo(w.y); xs[l * 64 + d4 + 3] = bfhi(w.y); }
        __syncthreads();
        { const int n = F.tid & 255, half = F.tid >> 8; const bf16_t* w1 = (const bf16_t*)(ws + WS_CW1) + (size_t)kvi * 256 * 2048 + (size_t)n * 2048 + half * 1024;
          float s = 0.f;
          for (int k = 0; k < 1024; k += 8) { const u32x4 w = *(const u32x4*)(w1 + k); const LAS float* x = xs + half * 1024 + k;
              s += x[0] * bflo(w.x) + x[1] * bfhi(w.x) + x[2] * bflo(w.y) + x[3] * bfhi(w.y) + x[4] * bflo(w.z) + x[5] * bfhi(w.z) + x[6] * bflo(w.w) + x[7] * bfhi(w.w); }
          part[F.tid] = s; }
        __syncthreads();
        if (F.tid < 256) hs[F.tid] = gelu_tanh(part[F.tid] + part[F.tid + 256] + ((const float*)(ws + WS_C1))[kvi * 256 + F.tid]);
        __syncthreads();
        if (F.tid < 64) { const bf16_t* w2 = (const bf16_t*)(ws + WS_CW2) + (size_t)kvi * 64 * 256 + (size_t)F.tid * 256; float s = 0.f;
            for (int n = 0; n < 256; n += 2) { const unsigned w = *(const unsigned*)(w2 + n); s += hs[n] * bflo(w) + hs[n + 1] * bfhi(w); }
            ((bf16_t*)(ws + WS_KCVC))[((size_t)((kvi * BATCH + b) * 2 + g) * 128 + c) * 64 + F.tid] = (bf16_t)f2bf(s); }
    }
}

__device__ __forceinline__ void cmp_simple(Frame& F) {
    unsigned char* ws = F.ws;
    const bf16_t* P = (const bf16_t*)(ws + WS_QKV);
    const float* biasD = (const float*)(ws + WS_BIASD);
    const float* gates = (const float*)(ws + WS_GATES);
    float* Ocomb = (float*)(ws + WS_OCOMB);
    unsigned* selm = (unsigned*)(ws + WS_SELM);
    LAS float* Pl = (LAS float*)F.lds;
    LAS float* sc = Pl + 1024;
    const int nitems = BATCH * 2 * SEQ;
    for (int it = F.bid; it < nitems; it += F.G) {
        const int t = it % SEQ, g = (it / SEQ) & 1, b = it / (SEQ * 2);
        const int m = b * SEQ + t, hh = F.wave, h = g * 8 + hh, lane = F.lane;
        const bf16_t* kc = (const bf16_t*)(ws + WS_KCVC) + (size_t)((0 * BATCH + b) * 2 + g) * 128 * 64;
        const bf16_t* vc = (const bf16_t*)(ws + WS_KCVC) + (size_t)((1 * BATCH + b) * 2 + g) * 128 * 64;
        const bf16_t* qp = P + (size_t)m * PROJW + h * 64;
        __syncthreads();
        float s2[2];
#pragma unroll
        for (int u = 0; u < 2; ++u) { const int c = lane + 64 * u; float dot = 0.f; const bool valid = (c < NC) && (16 * c + 31 <= t);
            if (valid) { const u32x4* kp = (const u32x4*)(kc + (size_t)c * 64); const u32x4* qq = (const u32x4*)qp;
#pragma unroll
                for (int j = 0; j < 8; ++j) { const u32x4 a = qq[j], w = kp[j];
                    dot += bflo(a.x) * bflo(w.x) + bfhi(a.x) * bfhi(w.x) + bflo(a.y) * bflo(w.y) + bfhi(a.y) * bfhi(w.y) + bflo(a.z) * bflo(w.z) + bfhi(a.z) * bfhi(w.z) + bflo(a.w) * bflo(w.w) + bfhi(a.w) * bfhi(w.w); }
                dot += biasD[(t - 16 * c - 31) * 16 + h]; }
            s2[u] = valid ? dot : NEG_BIG; }
        const float mx = wave_max(fmaxf(s2[0], s2[1]));
        const float e0 = s2[0] > -1e29f ? __expf(s2[0] - mx) : 0.f, e1 = s2[1] > -1e29f ? __expf(s2[1] - mx) : 0.f;
        const float l = wave_sum(e0 + e1); const float inv = l > 0.f ? 1.0f / l : 0.f;
        Pl[hh * 128 + lane] = e0 * inv; Pl[hh * 128 + 64 + lane] = e1 * inv;
        __syncthreads();
        { float o = 0.f; const int cmax = (t - 31) >= 0 ? (t - 31) / 16 : -1;
          for (int c = 0; c <= cmax && c < NC; ++c) o += Pl[hh * 128 + c] * bf2f(vc[(size_t)c * 64 + lane]);
          Ocomb[(size_t)m * DM + h * 64 + lane] = o * gates[(size_t)m * 48 + h * 3 + 0]; }
        if (F.tid < 32) { const int j = F.tid, cur = t >> 6; float imp = 0.f;
            for (int c = 4 * j - 1; c <= 4 * j + 3; ++c) if (c >= 0 && c < NC) { float a = 0.f;
#pragma unroll
                for (int q = 0; q < 8; ++q) a += Pl[q * 128 + c];
                imp += a; }
            const bool forced = (j == 0) || (cur - j >= 0 && cur - j < 2);
            sc[j] = forced ? 1e6f : (j <= cur ? imp : -1.0f); }
        __syncthreads();
        if (F.tid < 32) { const int j = F.tid; const float mine = sc[j]; int rank = 0;
            for (int k = 0; k < 32; ++k) { const float o = sc[k]; rank += (o > mine || (o == mine && k < j)) ? 1 : 0; }
            const unsigned long long bal = __ballot(rank < 16);
            if (j == 0) selm[(size_t)(b * 2 + g) * SEQ + t] = (unsigned)bal; }
    }
}


namespace fa {
constexpr float LOG2E = 1.4426950408889634f;
constexpr float THR = 5.5f;
constexpr int KVB = 8192;
constexpr int BUFB = 2 * KVB;
constexpr int TC_N = 2112, TC_RC = 2047;
constexpr int TW_N = 640, TW_RC = 575;
constexpr int TS_N = 256, TS_RC = 191;
constexpr int L_KV = 0, L_TC = 2 * BUFB, L_TW = L_TC + 8 * TC_N * 4, L_SC = L_TW + 8 * TW_N * 4, L_SELM = L_SC + 4096, L_END = L_SELM + 128;
static_assert(L_END <= LDS_MAIN, "attention LDS map");
typedef float f32x2_t __attribute__((ext_vector_type(2))); typedef __bf16 bf16x2_t __attribute__((ext_vector_type(2)));
typedef short v4i16_t __attribute__((ext_vector_type(4)));
__device__ __forceinline__ unsigned cvtpk(float lo, float hi) { f32x2_t v = {lo, hi}; bf16x2_t b = __builtin_convertvector(v, bf16x2_t); return __builtin_bit_cast(unsigned, b); }
__device__ __forceinline__ v4i16_t vtr(const LAS unsigned char* p) { return __builtin_amdgcn_ds_read_tr16_b64_v4i16((LAS v4i16_t*)p); }
__device__ __forceinline__ int swz_f(int key) { return (((key >> 1) & 1) << 2) | ((key >> 2) & 3); }
__device__ __forceinline__ int swz_off(int key, int chunk) { return key * 128 + ((chunk ^ swz_f(key)) << 4); }
__device__ __forceinline__ float hswap_max(float v) { return fmaxf(v, __shfl_xor(v, 32)); }
__device__ __forceinline__ float hswap_sum(float v) { return v + __shfl_xor(v, 32); }

struct TileSrc { const bf16_t* k; const bf16_t* v; int pitch; };
__device__ __forceinline__ void tile_load(const TileSrc& s, int tid, u32x4& kr, u32x4& vr) {
    const int key = tid >> 3, ch = tid & 7;
    kr = *(const u32x4*)(s.k + (size_t)key * s.pitch + ch * 8); vr = *(const u32x4*)(s.v + (size_t)key * s.pitch + ch * 8);
}
__device__ __forceinline__ void tile_store(LAS unsigned char* buf, int tid, const u32x4& kr, const u32x4& vr) {
    const int key = tid >> 3, ch = tid & 7; const int o = swz_off(key, ch);
    *(LAS u32x4*)(buf + o) = kr; *(LAS u32x4*)(buf + KVB + o) = vr;
}
__device__ __forceinline__ void qk_tile(const LAS unsigned char* buf, const bf16x8 (&qf)[4], const int (&koff)[4], f32x16& p0, f32x16& p1) {
    p0 = (f32x16){}; p1 = (f32x16){};
#pragma unroll
    for (int ks = 0; ks < 4; ++ks) {
        const bf16x8 a0 = *(const LAS bf16x8*)(buf + koff[ks]); const bf16x8 a1 = *(const LAS bf16x8*)(buf + koff[ks] + 4096);
        p0 = __builtin_amdgcn_mfma_f32_32x32x16_bf16(a0, qf[ks], p0, 0, 0, 0);
        p1 = __builtin_amdgcn_mfma_f32_32x32x16_bf16(a1, qf[ks], p1, 0, 0, 0);
    }
}
__device__ __forceinline__ void pv_tile(const LAS unsigned char* buf, const int (&voff)[4], const f32x16& p0, const f32x16& p1, f32x16& o0, f32x16& o1) {
#pragma unroll
    for (int s = 0; s < 4; ++s) {
        u32x4 pw;
        if (s < 2) { const int b = 8 * (s & 1); pw.x = cvtpk(p0[b], p0[b + 1]); pw.y = cvtpk(p0[b + 2], p0[b + 3]); pw.z = cvtpk(p0[b + 4], p0[b + 5]); pw.w = cvtpk(p0[b + 6], p0[b + 7]); }
        else       { const int b = 8 * (s & 1); pw.x = cvtpk(p1[b], p1[b + 1]); pw.y = cvtpk(p1[b + 2], p1[b + 3]); pw.z = cvtpk(p1[b + 4], p1[b + 5]); pw.w = cvtpk(p1[b + 6], p1[b + 7]); }
        const bf16x8 pb = __builtin_bit_cast(bf16x8, pw);
        { const v4i16_t va = vtr(buf + voff[0] + 2048 * s), vb = vtr(buf + voff[1] + 2048 * s);
          const bf16x8 A = (bf16x8){va[0], va[1], va[2], va[3], vb[0], vb[1], vb[2], vb[3]};
          o0 = __builtin_amdgcn_mfma_f32_32x32x16_bf16(A, pb, o0, 0, 0, 0); }
        { const v4i16_t va = vtr(buf + voff[2] + 2048 * s), vb = vtr(buf + voff[3] + 2048 * s);
          const bf16x8 A = (bf16x8){va[0], va[1], va[2], va[3], vb[0], vb[1], vb[2], vb[3]};
          o1 = __builtin_amdgcn_mfma_f32_32x32x16_bf16(A, pb, o1, 0, 0, 0); }
    }
}
__device__ __forceinline__ void tile_step(const LAS unsigned char* buf, const bf16x8 (&qf)[4], const int (&koff)[4], const int (&voff)[4], const LAS float* tp,
                                          float& m, float& l, f32x16& o0, f32x16& o1) {
    f32x16 p0, p1;
    qk_tile(buf, qf, koff, p0, p1);
#pragma unroll
    for (int r = 0; r < 16; ++r) { p0[r] += tp[(r & 3) + 8 * (r >> 2)]; p1[r] += tp[32 + (r & 3) + 8 * (r >> 2)]; }
    float mx = fmaxf(p0[0], p1[0]);
#pragma unroll
    for (int r = 1; r < 16; ++r) mx = fmaxf(mx, fmaxf(p0[r], p1[r]));
    mx = hswap_max(mx);
    if (__any(mx > m + THR)) {
        const float mn = fmaxf(m, mx); const float al = __builtin_amdgcn_exp2f((m - mn) * LOG2E);
        l *= al; m = mn;
#pragma unroll
        for (int r = 0; r < 16; ++r) { o0[r] *= al; o1[r] *= al; }
    }
    const float c = -m * LOG2E; float ls = 0.f;
#pragma unroll
    for (int r = 0; r < 16; ++r) { p0[r] = __builtin_amdgcn_exp2f(__builtin_fmaf(p0[r], LOG2E, c)); p1[r] = __builtin_amdgcn_exp2f(__builtin_fmaf(p1[r], LOG2E, c)); ls += p0[r] + p1[r]; }
    l += ls;
    pv_tile(buf, voff, p0, p1, o0, o1);
}
__device__ __forceinline__ void lane_offsets(int lane, int (&koff)[4], int (&voff)[4]) {
    const int r32 = lane & 31, hi = lane >> 5;
#pragma unroll
    for (int ks = 0; ks < 4; ++ks) koff[ks] = swz_off(r32, 2 * ks + hi);
    const int kq = (lane & 15) >> 2, gidx = (lane >> 4) & 1, within = 8 * (lane & 1);
    const int fA = ((kq >> 1) << 2) | hi, fB = ((kq >> 1) << 2) | (hi + 2);
#pragma unroll
    for (int dh = 0; dh < 2; ++dh) { const int chunk = 4 * dh + 2 * gidx + ((lane & 3) >> 1);
        voff[2 * dh + 0] = KVB + (4 * hi + kq) * 128 + ((chunk ^ fA) << 4) + within;
        voff[2 * dh + 1] = KVB + (4 * hi + kq + 8) * 128 + ((chunk ^ fB) << 4) + within; }
}
__device__ __forceinline__ void unit_decode(int it, int& b, int& g, int& qt) {
    const int k = it >> 8, v = it & 255, pair = v >> 4, s = v & 15;
    b = pair >> 1; g = pair & 1; qt = (k == 0) ? s : (k == 1) ? 31 - s : (k == 2) ? 32 + s : 63 - s;
}
__device__ __forceinline__ void store_o(bf16_t* orow  , int hi, const f32x16& o0, const f32x16& o1) {
#pragma unroll
    for (int rg = 0; rg < 4; ++rg) {
        u32x2 w0; w0.x = cvtpk(o0[4 * rg], o0[4 * rg + 1]); w0.y = cvtpk(o0[4 * rg + 2], o0[4 * rg + 3]);
        u32x2 w1; w1.x = cvtpk(o1[4 * rg], o1[4 * rg + 1]); w1.y = cvtpk(o1[4 * rg + 2], o1[4 * rg + 3]);
        *(u32x2*)(orow + 8 * rg + 4 * hi) = w0; *(u32x2*)(orow + 32 + 8 * rg + 4 * hi) = w1; }
}

__device__ __forceinline__ void swa_phase(Frame& F, const bf16_t* QKV, const float* biasD, const float* sinks, bf16_t* O) {
    LAS unsigned char* kvb = F.lds + L_KV; LAS float* tabS = (LAS float*)(F.lds + L_TC);
    const int lane = F.lane, r32 = lane & 31, hi = lane >> 5, w = F.wave, tid = F.tid;
    int koff[4], voff[4]; lane_offsets(lane, koff, voff);
    const int vcu = (F.G % 8 == 0) ? (F.bid % 8) * (F.G / 8) + F.bid / 8 : F.bid;
    int built_g = -1;
    for (int it = vcu; it < 1024; it += F.G) {
        int b, g, qt; unit_decode(it, b, g, qt);
        const int t0 = 32 * qt, cur = qt >> 1, h = 8 * g + w, t = t0 + r32;
        if (g != built_g) { __syncthreads();
            for (int i = tid; i < 8 * TS_N; i += NTHR) { const int hh = i >> 8, j = i & 255; const int dist = TS_RC - j; tabS[i] = (dist >= 0 && dist < 128) ? biasD[dist * 16 + 8 * g + hh] : NEG_BIG; }
            built_g = g; __syncthreads(); }
        const LAS float* tab = tabS + w * TS_N;
        const bf16_t* rowb = QKV + (size_t)b * SEQ * AQKV;
        bf16x8 qf[4];
#pragma unroll
        for (int ks = 0; ks < 4; ++ks) qf[ks] = *(const bf16x8*)(rowb + (size_t)t * AQKV + h * 64 + 16 * ks + 8 * hi);
        f32x16 o0 = {}, o1 = {}; float m = -1e20f, l = 0.f;
        const int kt_lo = cur - 2 > 0 ? cur - 2 : 0;
        u32x4 kr, vr;
        { const TileSrc s{rowb + (size_t)(64 * kt_lo) * AQKV + 1024 + g * 64, rowb + (size_t)(64 * kt_lo) * AQKV + 1152 + g * 64, AQKV}; tile_load(s, tid, kr, vr); }
        tile_store(kvb, tid, kr, vr);
        __syncthreads();
        int bufi = 0;
        for (int kt = kt_lo; kt <= cur; ++kt) {
            const bool has_n = kt < cur;
            if (has_n) { const TileSrc s{rowb + (size_t)(64 * (kt + 1)) * AQKV + 1024 + g * 64, rowb + (size_t)(64 * (kt + 1)) * AQKV + 1152 + g * 64, AQKV}; tile_load(s, tid, kr, vr); }
            tile_step(kvb + bufi * BUFB, qf, koff, voff, tab + (64 * kt - t + TS_RC + 4 * hi), m, l, o0, o1);
            if (has_n) tile_store(kvb + (bufi ^ 1) * BUFB, tid, kr, vr);
            __syncthreads();
            bufi ^= 1;
        }
        { const float lt = hswap_sum(l); const float sk = sinks[h]; const float mf = fmaxf(m, sk); const float al = __expf(m - mf); const float inv = al / (lt * al + __expf(sk - mf));
#pragma unroll
          for (int r = 0; r < 16; ++r) { o0[r] *= inv; o1[r] *= inv; }
          store_o(O + (size_t)(b * SEQ + t) * DM + h * 64, hi, o0, o1); }
    }
}

__device__ __forceinline__ void nsa_phase(Frame& F, const bf16_t* P, const bf16_t* KC, const bf16_t* VC, const float* biasD, const float* gates, bf16_t* O) {
    LAS unsigned char* kvb = F.lds + L_KV; LAS float* tabC = (LAS float*)(F.lds + L_TC); LAS float* tabW = (LAS float*)(F.lds + L_TW);
    LAS float* stg = (LAS float*)(F.lds + L_KV);
    LAS float* scl = (LAS float*)(F.lds + L_SC);
    LAS unsigned* selm = (LAS unsigned*)(F.lds + L_SELM);
    const int lane = F.lane, r32 = lane & 31, hi = lane >> 5, w = F.wave, tid = F.tid;
    int koff[4], voff[4]; lane_offsets(lane, koff, voff);
    const int vcu = (F.G % 8 == 0) ? (F.bid % 8) * (F.G / 8) + F.bid / 8 : F.bid;
    int built_g = -1;
    for (int it = vcu; it < 1024; it += F.G) {
        int b, g, qt; unit_decode(it, b, g, qt);
        const int t0 = 32 * qt, cur = qt >> 1, h = 8 * g + w, t = t0 + r32;
        if (g != built_g) { __syncthreads();
            for (int i = tid; i < 8 * TC_N; i += NTHR) { const int hh = i / TC_N, j = i - hh * TC_N; tabC[i] = (j <= TC_RC) ? biasD[(TC_RC - j) * 16 + 8 * g + hh] : NEG_BIG; }
            for (int i = tid; i < 8 * TW_N; i += NTHR) { const int hh = i / TW_N, j = i - hh * TW_N; const int dist = TW_RC - j; tabW[i] = (dist >= 0 && dist < 512) ? biasD[dist * 16 + 8 * g + hh] : NEG_BIG; }
            built_g = g; __syncthreads(); }
        const LAS float* tc = tabC + w * TC_N; const LAS float* tw = tabW + w * TW_N;
        const bf16_t* rowb = P + (size_t)b * SEQ * PROJW;
        const size_t mrow = (size_t)(b * SEQ + t);
        bf16x8 qf[4];
#pragma unroll
        for (int ks = 0; ks < 4; ++ks) qf[ks] = *(const bf16x8*)(rowb + (size_t)t * PROJW + h * 64 + 16 * ks + 8 * hi);
        const float g0 = gates[mrow * 48 + h * 3 + 0], g1 = gates[mrow * 48 + h * 3 + 1], g2 = gates[mrow * 48 + h * 3 + 2];
        f32x16 f0, f1;
        {
            const bf16_t* kc = KC + (size_t)(b * 2 + g) * 128 * 64; const bf16_t* vc = VC + (size_t)(b * 2 + g) * 128 * 64;
            u32x4 kr, vr;
            { const TileSrc s{kc, vc, 64}; tile_load(s, tid, kr, vr); tile_store(kvb, tid, kr, vr); }
            { const TileSrc s{kc + 64 * 64, vc + 64 * 64, 64}; tile_load(s, tid, kr, vr); tile_store(kvb + BUFB, tid, kr, vr); }
            __syncthreads();
            f32x16 s00, s01, s10, s11;
            qk_tile(kvb, qf, koff, s00, s01); qk_tile(kvb + BUFB, qf, koff, s10, s11);
            const int e0 = TC_RC - (t - 31 - 64 * hi);
#define CMP_BIAS(S, KT, KB) _Pragma("unroll") for (int r = 0; r < 16; ++r) { int idx = e0 + 16 * (64 * (KT) + 32 * (KB) + (r & 3) + 8 * (r >> 2)); idx = idx < 2048 ? idx : 2048; S[r] += tc[idx]; }
            CMP_BIAS(s00, 0, 0) CMP_BIAS(s01, 0, 1) CMP_BIAS(s10, 1, 0) CMP_BIAS(s11, 1, 1)
#undef CMP_BIAS
            float mx = -1e20f;
#pragma unroll
            for (int r = 0; r < 16; ++r) mx = fmaxf(fmaxf(mx, fmaxf(s00[r], s01[r])), fmaxf(s10[r], s11[r]));
            mx = hswap_max(mx);
            const float c = -mx * LOG2E; float ls = 0.f;
#pragma unroll
            for (int r = 0; r < 16; ++r) { s00[r] = __builtin_amdgcn_exp2f(__builtin_fmaf(s00[r], LOG2E, c)); s01[r] = __builtin_amdgcn_exp2f(__builtin_fmaf(s01[r], LOG2E, c));
                s10[r] = __builtin_amdgcn_exp2f(__builtin_fmaf(s10[r], LOG2E, c)); s11[r] = __builtin_amdgcn_exp2f(__builtin_fmaf(s11[r], LOG2E, c)); ls += (s00[r] + s01[r]) + (s10[r] + s11[r]); }
            ls = hswap_sum(ls); const float inv = ls > 0.f ? 1.0f / ls : 0.f;
#pragma unroll
            for (int r = 0; r < 16; ++r) { s00[r] *= inv; s01[r] *= inv; s10[r] *= inv; s11[r] *= inv; }
            float gs[16], xl[16];
#pragma unroll
            for (int rg = 0; rg < 4; ++rg) {
                gs[0 + rg] = (s00[4 * rg] + s00[4 * rg + 1]) + (s00[4 * rg + 2] + s00[4 * rg + 3]); xl[0 + rg] = s00[4 * rg + 3];
                gs[4 + rg] = (s01[4 * rg] + s01[4 * rg + 1]) + (s01[4 * rg + 2] + s01[4 * rg + 3]); xl[4 + rg] = s01[4 * rg + 3];
                gs[8 + rg] = (s10[4 * rg] + s10[4 * rg + 1]) + (s10[4 * rg + 2] + s10[4 * rg + 3]); xl[8 + rg] = s10[4 * rg + 3];
                gs[12 + rg] = (s11[4 * rg] + s11[4 * rg + 1]) + (s11[4 * rg + 2] + s11[4 * rg + 3]); xl[12 + rg] = s11[4 * rg + 3]; }
            float rv[16];
#pragma unroll
            for (int n = 0; n < 16; ++n) rv[n] = __shfl_xor(xl[n], 32);
#pragma unroll
            for (int n = 0; n < 16; ++n) { const float prev_lo = (n > 0) ? rv[n > 0 ? n - 1 : 0] : 0.f; gs[n] += hi ? rv[n] : prev_lo; }
            f0 = (f32x16){}; f1 = (f32x16){};
            pv_tile(kvb, voff, s00, s01, f0, f1); pv_tile(kvb + BUFB, voff, s10, s11, f0, f1);
#pragma unroll
            for (int r = 0; r < 16; ++r) { f0[r] *= g0; f1[r] *= g0; }
            __syncthreads();
#pragma unroll
            for (int n = 0; n < 16; ++n) stg[(w * 32 + r32) * 32 + 2 * n + hi] = gs[n];
            __syncthreads();
#pragma unroll
            for (int ps = 0; ps < 2; ++ps) { const int q = (tid >> 5) + 16 * ps, j = tid & 31; float imp = 0.f;
#pragma unroll
                for (int ww = 0; ww < 8; ++ww) imp += stg[(ww * 32 + q) * 32 + j];
                const bool forced = (j == 0) || (cur - j >= 0 && cur - j < 2);
                scl[q * 32 + j] = forced ? 1e6f : (j <= cur ? imp : -1.0f); }
            __syncthreads();
#pragma unroll
            for (int ps = 0; ps < 2; ++ps) { const int q = (tid >> 5) + 16 * ps, j = tid & 31; const float mine = scl[q * 32 + j]; int rank = 0;
                for (int k = 0; k < 32; ++k) { const float ov = scl[q * 32 + k]; rank += (ov > mine || (ov == mine && k < j)) ? 1 : 0; }
                const unsigned long long bal = __ballot(rank < 16);
                if (lane == 0) { selm[2 * w + 16 * ps] = (unsigned)bal; selm[2 * w + 1 + 16 * ps] = (unsigned)(bal >> 32); } }
            __syncthreads();
        }
        const unsigned mymask = selm[r32];
        unsigned un = mymask;
#pragma unroll
        for (int o = 1; o < 32; o <<= 1) un |= (unsigned)__shfl_xor((int)un, o);
        un = (unsigned)__builtin_amdgcn_readfirstlane((int)un);
        unsigned rem = un & ((cur >= 31) ? 0xffffffffu : ((2u << cur) - 1u));
        int wk = cur - 8 > 0 ? cur - 8 : 0;
        const bf16_t* ksel = rowb + 1024 + 2 * 128 + g * 64; const bf16_t* vsel = rowb + 1024 + 3 * 128 + g * 64;
        const bf16_t* kwin = rowb + 1024 + 4 * 128 + g * 64; const bf16_t* vwin = rowb + 1024 + 5 * 128 + g * 64;
        int n_br, n_kt; bool has_n;
#define NEXT_TILE() do { if (rem) { n_kt = __builtin_ctz(rem); rem &= rem - 1u; n_br = 1; has_n = true; } else if (wk <= cur) { n_kt = wk++; n_br = 2; has_n = true; } else has_n = false; } while (0)
#define LOAD_NEXT() do { const TileSrc s_{(n_br == 1 ? ksel : kwin) + (size_t)(64 * n_kt) * PROJW, (n_br == 1 ? vsel : vwin) + (size_t)(64 * n_kt) * PROJW, PROJW}; tile_load(s_, tid, kr, vr); } while (0)
        u32x4 kr, vr;
        NEXT_TILE();
        LOAD_NEXT(); tile_store(kvb, tid, kr, vr);
        __syncthreads();
        int c_br = n_br, c_kt = n_kt, bufi = 0;
        f32x16 o0 = {}, o1 = {}; float m = -1e20f, l = 0.f; bool switched = false;
        for (;;) {
            NEXT_TILE();
            if (has_n) LOAD_NEXT();
            if (c_br == 2 && !switched) {
                const float lt = hswap_sum(l); const float inv = (lt > 0.f ? 1.0f / lt : 0.f) * g1;
#pragma unroll
                for (int r = 0; r < 16; ++r) { f0[r] += o0[r] * inv; f1[r] += o1[r] * inv; o0[r] = 0.f; o1[r] = 0.f; }
                m = -1e20f; l = 0.f; switched = true; }
            const LAS float* tp;
            if (c_br == 1) { const bool sel = (mymask >> c_kt) & 1u; tp = tc + (sel ? (64 * c_kt - t + TC_RC + 4 * hi) : 2048); }
            else tp = tw + (64 * c_kt - t + TW_RC + 4 * hi);
            tile_step(kvb + bufi * BUFB, qf, koff, voff, tp, m, l, o0, o1);
            if (!has_n) break;
            tile_store(kvb + (bufi ^ 1) * BUFB, tid, kr, vr);
            __syncthreads();
            c_br = n_br; c_kt = n_kt; bufi ^= 1;
        }
#undef NEXT_TILE
#undef LOAD_NEXT
        { const float lt = hswap_sum(l); const float inv = (lt > 0.f ? 1.0f / lt : 0.f) * (switched ? g2 : g1);
#pragma unroll
          for (int r = 0; r < 16; ++r) { f0[r] += o0[r] * inv; f1[r] += o1[r] * inv; }
          store_o(O + mrow * DM + h * 64, hi, f0, f1); }
        __syncthreads();
    }
}
}

template <class Epi> __device__ __forceinline__ void gemm_fast(Frame& F, const bf16_t* A, const bf16_t* Bt, int N, int K, const Epi& E) {
    pg8::Gemm g{A, Bt, M, N, K}; pg8::StaticOrder S; S.init(M, N, F.G, F.bid);
    pg8::gemm_phase<Epi, pg8::StaticOrder, true, true>(F.lds, g, S, E);
}
constexpr int NPHASES = 17;
__global__ void __launch_bounds__(NTHR, 2) trunk_fwd(Args args) {
    extern __shared__ __attribute__((aligned(16))) unsigned char lds[];
    Frame F;
    F.lds = (LAS unsigned char*)lds;
    F.tid = threadIdx.x; F.lane = F.tid & 63; F.wave = __builtin_amdgcn_readfirstlane(F.tid >> 6);
    F.G = gridDim.x; F.bid = blockIdx.x; F.gw = F.bid * NWAVES + F.wave; F.ngw = F.G * NWAVES;
#pragma unroll
    for (int i = 0; i < 17; ++i) F.in[i] = args.in[i];
    F.out = args.out; F.ws = args.ws;
    unsigned char* ws = args.ws;
    volatile LAS unsigned* MISC = (volatile LAS unsigned*)(F.lds + MISC_OFF);
    if (F.tid < 32) MISC[F.tid] = 0u;
    __syncthreads();
    unsigned* barw = (unsigned*)(ws + WS_CTL) + CW_BAR + args.li * XCD_BAR_WORDS;
    XcdBarrier bar; bar.bar = barw; bar.x = 0; bar.st = nullptr;
    const int lo = args.ph_lo, hi = args.ph_hi;
    if (hi - lo > 1) bar = xcd_barrier_post(barw, MISC + 8);
#define IN(k) (lo <= (k) && (k) < hi)
#define SEAM(k) do { if (IN(k) && IN((k) + 1)) xcd_barrier(bar); } while (0)

    bf16_t* XA = (bf16_t*)(ws + WS_XA); bf16_t* QKV = (bf16_t*)(ws + WS_QKV); bf16_t* Ob = (bf16_t*)(ws + WS_O); bf16_t* HID = (bf16_t*)(ws + WS_HID);
    float* Hres = F.out; float* Ocomb = (float*)(ws + WS_OCOMB); float* gates = (float*)(ws + WS_GATES);
    const float* biasD = (const float*)(ws + WS_BIASD);

    if (IN(0)) { p0_prologue(F); } SEAM(0);
    if (IN(1)) { if (FAST_GEMM) gemm_fast(F, XA, (const bf16_t*)(ws + WS_WQKVA), AQKV, DM, pg8::EpiQkvF{QKV, F.in[6]}); else gemm_simple<false>(F, XA, DM, (const bf16_t*)(ws + WS_WQKVA), DM, AQKV / 64, EpiQkvA{QKV, F.in[6]}); } SEAM(1);
    if (IN(2)) { if (FAST_ATTN & 1) fa::swa_phase(F, QKV, biasD, F.in[7], Ob); else attn_simple<0>(F, QKV, AQKV, KVsrc{QKV, AQKV, 1024, 1152}, biasD, F.in[7], nullptr, nullptr, nullptr, Ob); } SEAM(2);
    if (IN(3)) { if (FAST_GEMM) gemm_fast(F, Ob, (const bf16_t*)(ws + WS_WOA), DM, DM, pg8::EpiResidF{F.in[0], Hres, F.in[9]}); else gemm_simple<false>(F, Ob, DM, (const bf16_t*)(ws + WS_WOA), DM, DM / 64, EpiResid{F.in[0], Hres, F.in[9]}); } SEAM(3);
    if (IN(4)) { norm_phase(F, Hres, F.in[3], XA); } SEAM(4);
    if (IN(5)) { if (FAST_GEMM) gemm_fast(F, XA, (const bf16_t*)(ws + WS_WGU), 2 * DFF, DM, pg8::EpiSwigluF{HID}); else gemm_simple<true>(F, XA, DM, (const bf16_t*)(ws + WS_WGU), DM, DFF / 32, EpiSwiglu{HID}); } SEAM(5);
    if (IN(6)) { if (FAST_GEMM) gemm_fast(F, HID, (const bf16_t*)(ws + WS_WDN), DM, DFF, pg8::EpiResidF{Hres, Hres, nullptr}); else gemm_simple<false>(F, HID, DFF, (const bf16_t*)(ws + WS_WDN), DFF, DM / 64, EpiResid{Hres, Hres, nullptr}); } SEAM(6);
    if (IN(7)) { norm_phase(F, Hres, F.in[2] + DM, XA); } SEAM(7);
    if (IN(8)) { if (FAST_GEMM) gemm_fast(F, XA, (const bf16_t*)(ws + WS_WIN), BINP, DM, pg8::EpiWinF{QKV, gates}); else gemm_simple<false>(F, XA, DM, (const bf16_t*)(ws + WS_WIN), DM, (BIN + 63) / 64, EpiWin{QKV, gates}); } SEAM(8);
    if (IN(9)) { compress_simple(F); } SEAM(9);
    if (IN(10)) { if (!(FAST_ATTN & 2)) cmp_simple(F); } SEAM(10);
    if (IN(11)) { if (FAST_ATTN & 2) fa::nsa_phase(F, QKV, (const bf16_t*)(ws + WS_KCVC), (const bf16_t*)(ws + WS_KCVC) + (size_t)BATCH * 2 * 128 * 64, biasD, gates, Ob); else { attn_simple<1>(F, QKV, PROJW, KVsrc{QKV, PROJW, 1024 + 2 * 128, 1024 + 3 * 128}, biasD, nullptr, gates, (const unsigned*)(ws + WS_SELM), Ocomb, Ob);
                  attn_simple<2>(F, QKV, PROJW, KVsrc{QKV, PROJW, 1024 + 4 * 128, 1024 + 5 * 128}, biasD, nullptr, gates, nullptr, Ocomb, Ob); } } SEAM(11);
    if (IN(12)) { if (FAST_GEMM) gemm_fast(F, Ob, (const bf16_t*)(ws + WS_WOB), DM, DM, pg8::EpiResidF{Hres, Hres, nullptr}); else gemm_simple<false>(F, Ob, DM, (const bf16_t*)(ws + WS_WOB), DM, DM / 64, EpiResid{Hres, Hres, nullptr}); } SEAM(12);
    if (IN(13)) { norm_phase(F, Hres, F.in[3] + DM, XA); } SEAM(13);
    if (IN(14)) { if (FAST_GEMM) gemm_fast(F, XA, (const bf16_t*)(ws + WS_WGU) + (size_t)2 * DFF * DM, 2 * DFF, DM, pg8::EpiSwigluF{HID}); else gemm_simple<true>(F, XA, DM, (const bf16_t*)(ws + WS_WGU) + (size_t)2 * DFF * DM, DM, DFF / 32, EpiSwiglu{HID}); } SEAM(14);
    if (IN(15)) { if (FAST_GEMM) gemm_fast(F, HID, (const bf16_t*)(ws + WS_WDN) + (size_t)DM * DFF, DM, DFF, pg8::EpiResidF{Hres, Hres, nullptr}); else gemm_simple<false>(F, HID, DFF, (const bf16_t*)(ws + WS_WDN) + (size_t)DM * DFF, DFF, DM / 64, EpiResid{Hres, Hres, nullptr}); } SEAM(15);
    if (IN(16)) { final_norm_phase(F, Hres, F.in[4]); }
#undef IN
#undef SEAM
}

extern "C" void kernel_launch(void* const* d_in, const int* in_sizes, int n_in, void* d_out, int out_size, void* d_ws, size_t ws_size, hipStream_t stream) {
    static int grid = 0;
    if (grid == 0) {
        if (n_in != 17 || out_size != M * DM || ws_size < WS_END) { fprintf(stderr, "kernel_launch: unexpected shapes (n_in %d out %d ws %zu)\n", n_in, out_size, ws_size); grid = -1; return; }
        int dev = 0, cus = 0, per_cu = 0;
        (void)hipGetDevice(&dev); (void)hipDeviceGetAttribute(&cus, hipDeviceAttributeMultiprocessorCount, dev);
        (void)hipFuncSetAttribute((const void*)trunk_fwd, hipFuncAttributeMaxDynamicSharedMemorySize, LDS_BYTES);
        (void)hipOccupancyMaxActiveBlocksPerMultiprocessor(&per_cu, (const void*)trunk_fwd, NTHR, LDS_BYTES);
        (void)hipGetLastError();
        if (per_cu < 1) fprintf(stderr, "kernel_launch: occupancy query says %d blocks per CU\n", per_cu);
        grid = cus > 0 ? cus : 256;
    }
    if (grid < 0) return;
    (void)hipMemsetAsync((char*)d_ws + WS_CTL, 0, CTL_ZERO_BYTES, stream);
    Args a{};
    for (int i = 0; i < 17; ++i) a.in[i] = (const float*)d_in[i];
    a.out = (float*)d_out; a.ws = (unsigned char*)d_ws;
#if MK_ONE_LAUNCH
    a.ph_lo = 0; a.ph_hi = NPHASES; a.li = 0;
    void* kargs[] = {&a};
    hipError_t e = hipLaunchCooperativeKernel((const void*)trunk_fwd, dim3(grid), dim3(NTHR), kargs, LDS_BYTES, stream);
    if (e != hipSuccess) fprintf(stderr, "cooperative launch failed: %s\n", hipGetErrorString(e));
#else
    for (int p = 0; p < NPHASES; ++p) { a.ph_lo = p; a.ph_hi = p + 1; a.li = 0;
        hipLaunchKernelGGL(trunk_fwd, dim3(grid), dim3(NTHR), LDS_BYTES, stream, a); }
#endif
}
```

```cpp
#include <hip/hip_runtime.h>
#include <cstdio>
#include <cstdint>

#ifndef REPEAT_PHASE
#define REPEAT_PHASE -1
#endif
#ifndef REPEAT_N
#define REPEAT_N 2
#endif
#ifndef FAST_CMPR
#define FAST_CMPR 1
#endif
#ifndef FAST_ATTN
#define FAST_ATTN 3
#endif
#ifndef FAST_GEMM
#define FAST_GEMM 1
#endif
#ifndef MK_ONE_LAUNCH
#define MK_ONE_LAUNCH 1
#endif

#define GAS __attribute__((address_space(1)))
#define LAS __attribute__((address_space(3)))
typedef unsigned short bf16_t;
typedef short bf16x8 __attribute__((ext_vector_type(8)));
typedef float f32x4 __attribute__((ext_vector_type(4)));
typedef float f32x16 __attribute__((ext_vector_type(16)));
typedef unsigned u32x4 __attribute__((ext_vector_type(4)));
typedef unsigned u32x2 __attribute__((ext_vector_type(2)));

constexpr int BATCH = 8, SEQ = 2048, DM = 1024, NH = 16, HD = 64, M = BATCH * SEQ;
constexpr int AQKV = 1280;
constexpr int BIN = 1840;
constexpr int BINP = 2048;
constexpr int PROJW = 1792;
constexpr int DFF = 2816;
constexpr int NC = 127;
constexpr int NSEL = 32;
constexpr int NWAVES = 8, NTHR = 512;
constexpr float RMS_EPS = 1e-6f;
constexpr float NEG_BIG = -1e30f;

constexpr size_t MiB = 1u << 20;
constexpr size_t WS_CTL = 0, CTL_ZERO_BYTES = 1 * MiB;
constexpr size_t WS_BIASD = 1 * MiB;
constexpr size_t WS_C1 = WS_BIASD + 128 * 1024;
constexpr size_t WS_KCVC = WS_C1 + 4096;
constexpr size_t WS_SELM = WS_KCVC + 512 * 1024;
constexpr size_t WS_GATES = 4 * MiB;
constexpr size_t WS_WQKVA = 8 * MiB;
constexpr size_t WS_WOA = WS_WQKVA + 3 * MiB;
constexpr size_t WS_WIN = WS_WOA + 2 * MiB;
constexpr size_t WS_WOB = WS_WIN + 4 * MiB;
constexpr size_t WS_WGU = WS_WOB + 2 * MiB;
constexpr size_t WS_WDN = WS_WGU + 22 * MiB;
constexpr size_t WS_CW1 = WS_WDN + 11 * MiB;
constexpr size_t WS_CW2 = WS_CW1 + 2 * MiB;
constexpr size_t WS_XA = 56 * MiB;
constexpr size_t WS_QKV = 88 * MiB;
constexpr size_t WS_O = 144 * MiB;
constexpr size_t WS_HID = WS_QKV;
constexpr size_t WS_OCOMB = 176 * MiB;
constexpr size_t WS_END = 240 * MiB;
static_assert(WS_CW2 + 64 * 1024 <= WS_XA, "weights fit");
static_assert(WS_SELM + 128 * 1024 <= WS_GATES, "small region");
constexpr int CW_BAR = 4096;

constexpr int LDS_MAIN = 147456;
constexpr int MISC_OFF = LDS_MAIN;
constexpr int LDS_BYTES = LDS_MAIN + 128;

#define RLX_AGENT __ATOMIC_RELAXED, __HIP_MEMORY_SCOPE_AGENT
__device__ __forceinline__ unsigned f2bf(float f) { unsigned u = __builtin_bit_cast(unsigned, f); return (u + 0x7fffu + ((u >> 16) & 1u)) >> 16; }
__device__ __forceinline__ unsigned pk2(float lo, float hi) { return f2bf(lo) | (f2bf(hi) << 16); }
__device__ __forceinline__ float bf2f(unsigned short b) { return __builtin_bit_cast(float, (unsigned)b << 16); }
__device__ __forceinline__ float bflo(unsigned w) { return __builtin_bit_cast(float, w << 16); }
__device__ __forceinline__ float bfhi(unsigned w) { return __builtin_bit_cast(float, w & 0xffff0000u); }
__device__ __forceinline__ float wave_sum(float v) {
#pragma unroll
    for (int o = 1; o < 64; o <<= 1) v += __shfl_xor(v, o);
    return v;
}
__device__ __forceinline__ float wave_max(float v) {
#pragma unroll
    for (int o = 1; o < 64; o <<= 1) v = fmaxf(v, __shfl_xor(v, o));
    return v;
}

#define XB_TMO      128
#define XB_XCNT(j)  (256  + 64 * (j))
#define XB_XSUB(j)  (1280 + 64 * (j))
#define XB_XGEN(j)  (2304 + 64 * (j))
#define XB_TOP      3328
#define XB_TOPGEN   3392
#define XCD_BAR_WORDS 3456
#define XB_SPIN_CAP (1u << 25)
__device__ __forceinline__ unsigned xb_ld(unsigned* p)              { return __hip_atomic_load(p, __ATOMIC_RELAXED, __HIP_MEMORY_SCOPE_AGENT); }
__device__ __forceinline__ unsigned xb_add(unsigned* p, unsigned v) { return __hip_atomic_fetch_add(p, v, __ATOMIC_RELAXED, __HIP_MEMORY_SCOPE_AGENT); }
__device__ __forceinline__ unsigned xb_xcc_id() { return (unsigned)__builtin_amdgcn_s_getreg((3 << 11) | 20) & 0xFu; }
#define XB_SPIN(cond, bar) do { unsigned _sp = 0; while (cond) { __builtin_amdgcn_s_sleep(1); \
    if ((++_sp & 255u) == 0u) { if (xb_ld(&(bar)[XB_TMO])) break; if (_sp > XB_SPIN_CAP) { atomicAdd(&(bar)[XB_TMO], 1u); break; } } } } while (0)
struct XcdBarrier { unsigned* bar; unsigned x; volatile LAS unsigned* st; };
__device__ __forceinline__ XcdBarrier xcd_barrier_post(unsigned* bar, volatile LAS unsigned* st) {
    XcdBarrier b; b.bar = bar; b.x = xb_xcc_id(); b.st = st;
    if (threadIdx.x == 0) (void)xb_add(&bar[XB_XCNT(b.x)], 1u);
    return b;
}
__device__ __forceinline__ void xcd_barrier_complete(unsigned* bar, unsigned x, unsigned& nloc, unsigned& nx) {
    const unsigned G = gridDim.x * gridDim.y * gridDim.z;
    unsigned sum, cnt, mine, sp = 0u;
    for (;;) {
        sum = 0u; cnt = 0u; mine = 0u;
#pragma unroll
        for (unsigned j = 0; j < 16; ++j) { const unsigned c = xb_ld(&bar[XB_XCNT(j)]); sum += c; cnt += (c > 0u) ? 1u : 0u; mine = (j == x) ? c : mine; }
        if (sum == G) break;
        __builtin_amdgcn_s_sleep(1);
        if ((++sp & 255u) == 0u) { if (xb_ld(&bar[XB_TMO])) break; if (sp > XB_SPIN_CAP) { atomicAdd(&bar[XB_TMO], 1u); break; } }
    }
    nloc = mine > 0u ? mine : 1u; nx = cnt > 0u ? cnt : 1u;
}
__device__ __forceinline__ void xcd_barrier(const XcdBarrier& b) {
    asm volatile("s_waitcnt vmcnt(0)" ::: "memory");
    __syncthreads();
    if (threadIdx.x == 0) {
        unsigned* bar = b.bar;
        __builtin_amdgcn_s_waitcnt(0);
        unsigned nloc = b.st[0], nx = b.st[1];
        if (nloc == 0u) { xcd_barrier_complete(bar, b.x, nloc, nx); b.st[0] = nloc; b.st[1] = nx; }
        const unsigned old = xb_add(&bar[XB_XSUB(b.x)], 1u);
        const unsigned gen = old / nloc;
        if (old + 1u == (gen + 1u) * nloc) {
            __builtin_amdgcn_fence(__ATOMIC_RELEASE, "agent");
            asm volatile("s_waitcnt vmcnt(0)" ::: "memory");
            const unsigned og = xb_add(&bar[XB_TOP], 1u);
            const unsigned tg = og / nx;
            if (og + 1u == (tg + 1u) * nx) xb_add(&bar[XB_TOPGEN], 1u);
            else XB_SPIN(xb_ld(&bar[XB_TOPGEN]) == tg, bar);
            __builtin_amdgcn_fence(__ATOMIC_ACQUIRE, "agent");
            xb_add(&bar[XB_XGEN(b.x)], 1u);
            asm volatile("s_waitcnt vmcnt(0)" ::: "memory");
        } else {
            XB_SPIN(xb_ld(&bar[XB_XGEN(b.x)]) == gen, bar);
            __builtin_amdgcn_fence(__ATOMIC_ACQUIRE, "agent");
            asm volatile("s_waitcnt vmcnt(0)" ::: "memory");
        }
    }
    __syncthreads();
}

namespace pg8 {
#define PG8_LAS __attribute__((address_space(3)))
typedef unsigned short bf16_t;
typedef short bf16x8 __attribute__((ext_vector_type(8)));
typedef float f32x4 __attribute__((ext_vector_type(4)));
typedef unsigned u32x4 __attribute__((ext_vector_type(4)));
constexpr int BM = 256, BK = 64, HALF = 128, HTB = HALF * BK * 2  , STAGE_BYTES = 8 * HTB, NXCD = 8, WGM = 8;

__host__ __device__ __forceinline__ int lds_byte(int r, int c) { const int st = (r >> 4) * 2 + (c >> 5), rr = r & 15, cc = c & 31, ob = rr * 64 + cc * 2; return st * 1024 + (ob ^ (((ob >> 9) & 1) << 5)); }
__host__ __device__ __forceinline__ void stage_rc(int b, int& R, int& C) { const int st = b / 1024, sb = b % 1024, swz = sb ^ (((sb >> 9) & 1) << 5); R = (st >> 1) * 16 + swz / 64; C = (st & 1) * 32 + (swz % 64) / 2; }
__host__ __device__ __forceinline__ int perm32(int rho) { const int n = rho >> 4, i = rho & 15; return 8 * (i >> 2) + 4 * n + (i & 3); }

struct Unit { int pm, pn; };
struct Gemm { const bf16_t* A; const bf16_t* Bt; int M, N, K; };

struct StaticOrder {
    int nM, nN, nwg, G, c;
    __host__ __device__ void init(int M, int N, int G_, int c_) { nM = M / BM; nN = N / BM; nwg = nM * nN; G = G_; c = c_; }
    __host__ __device__ bool next(int i, Unit& u) const {
        const long L = (long)i * G + c; if (L >= nwg) return false;
        int wgid = (int)L; { const int q = nwg / NXCD, r = nwg % NXCD, xcd = wgid % NXCD, off = wgid / NXCD; wgid = (xcd < r ? xcd * (q + 1) : r * (q + 1) + (xcd - r) * q) + off; }
        const int nig = WGM * nN, gid = wgid / nig, fm = gid * WGM, gsz = (nM - fm) < WGM ? (nM - fm) : WGM;
        u.pm = fm + ((wgid % nig) % gsz); u.pn = (wgid % nig) / gsz; return true;
    }
    __device__ __forceinline__ void a_ready(const Unit&) const {}
    __device__ __forceinline__ void done(const Unit&) const {}
};

__device__ __forceinline__ unsigned cvt_pk_bf16(float lo, float hi) { unsigned r; asm volatile("v_cvt_pk_bf16_f32 %0, %1, %2" : "=v"(r) : "v"(lo), "v"(hi)); return r; }
template <class Epi, class Sched, bool ALIGN_EPI = false, bool SP2 = false>
__device__ __forceinline__ void gemm_phase(PG8_LAS unsigned char* lds, const Gemm g, const Sched& S, const Epi& E) {
    const int tid = threadIdx.x, wid = __builtin_amdgcn_readfirstlane(tid >> 6), lane = tid & 63, wr = wid >> 2, wc = wid & 3, fr = lane & 15, fq = lane >> 4;
    const int K = g.K, nt = K / BK;
    unsigned voffA[2], voffB[2];
#pragma unroll
    for (int i = 0; i < 2; ++i) { int R, C; stage_rc(tid * 16 + i * 8192, R, C); const int Rb = Epi::PERM ? ((R & ~31) + perm32(R & 31)) : R;
        voffA[i] = (unsigned)(R * K + C) * 2u; voffB[i] = (unsigned)(Rb * K + C) * 2u; }
    const size_t kstep = (size_t)(BK * 2);
    const size_t hstep = (size_t)HALF * K * 2;
    const size_t tstep = 2 * hstep;
    const unsigned ldsw = (unsigned)wid * 1024u;
    const int aoff = lds_byte(wr * 64 + fr, fq * 8), boff = lds_byte(wc * 32 + fr, fq * 8);
#define PG8_SA(b, h) (((b) * 2 + (h)) * HTB)
#define PG8_SB(b, h) ((4 + (b) * 2 + (h)) * HTB)
#define PG8_STAGE(bufoff, gbase, voff) do { _Pragma("unroll") for (int _i = 0; _i < 2; ++_i) \
        __builtin_amdgcn_global_load_lds((const unsigned*)((const char*)(gbase) + (voff)[_i]), (PG8_LAS unsigned*)(lds + (bufoff) + ldsw + _i * 8192), 16, 0, 0); } while (0)
#define PG8_LDA(dst, b, h) do { _Pragma("unroll") for (int m = 0; m < 4; ++m) _Pragma("unroll") for (int k = 0; k < 2; ++k) dst[m][k] = *(const PG8_LAS bf16x8*)(lds + PG8_SA(b, h) + aoff + m * 2048 + k * 1024); } while (0)
#define PG8_LDB(dst, b, h) do { _Pragma("unroll") for (int n = 0; n < 2; ++n) _Pragma("unroll") for (int k = 0; k < 2; ++k) dst[n][k] = *(const PG8_LAS bf16x8*)(lds + PG8_SB(b, h) + boff + n * 2048 + k * 1024); } while (0)
#define PG8_MMA(ai, bj, At, Bt) do { __builtin_amdgcn_s_setprio(1); _Pragma("unroll") for (int m = 0; m < 4; ++m) _Pragma("unroll") for (int n = 0; n < 2; ++n) _Pragma("unroll") for (int k = 0; k < 2; ++k) \
        acc[ai][bj][m][n] = __builtin_amdgcn_mfma_f32_16x16x32_bf16(Bt[n][k], At[m][k], acc[ai][bj][m][n], 0, 0, 0); __builtin_amdgcn_s_setprio(0); } while (0)
#define PG8_WAIT_V(n) asm volatile("s_waitcnt vmcnt(" #n ")" ::: "memory")
#define PG8_WAIT_L(n) asm volatile("s_waitcnt lgkmcnt(" #n ")" ::: "memory")
#define PG8_BAR __builtin_amdgcn_s_barrier()
#define PG8_SCHED __builtin_amdgcn_sched_barrier(0)
    Unit cur, nxt; int ui = 0;
    if (!S.next(0, cur)) return;
    f32x4 acc[2][2][4][2];
#pragma unroll
    for (int a = 0; a < 2; ++a)
#pragma unroll
        for (int b = 0; b < 2; ++b)
#pragma unroll
            for (int m = 0; m < 4; ++m)
#pragma unroll
                for (int n = 0; n < 2; ++n) acc[a][b][m][n] = (f32x4){0.f, 0.f, 0.f, 0.f};
    bf16x8 At[4][2], B0[2][2], B1[2][2];
    const char* cA = (const char*)g.A + (size_t)cur.pm * tstep; const char* cB = (const char*)g.Bt + (size_t)cur.pn * tstep;
    S.a_ready(cur);
    if constexpr (SP2) {
        PG8_STAGE(PG8_SB(0, 0), cB, voffB); PG8_STAGE(PG8_SB(0, 1), cB + hstep, voffB); PG8_STAGE(PG8_SA(0, 0), cA, voffA); PG8_STAGE(PG8_SA(0, 1), cA + hstep, voffA);
        if (wr == 1) PG8_BAR;
        PG8_WAIT_V(2); PG8_BAR;
        PG8_STAGE(PG8_SB(1, 0), cB + kstep, voffB); PG8_STAGE(PG8_SA(1, 0), cA + kstep, voffA); PG8_STAGE(PG8_SB(1, 1), cB + hstep + kstep, voffB);
        PG8_WAIT_V(6); PG8_BAR;
    } else {
        PG8_STAGE(PG8_SB(0, 0), cB, voffB); PG8_STAGE(PG8_SA(0, 0), cA, voffA); PG8_STAGE(PG8_SB(0, 1), cB + hstep, voffB); PG8_STAGE(PG8_SA(0, 1), cA + hstep, voffA);
        if (wr == 1) PG8_BAR;
        PG8_WAIT_V(4); PG8_BAR;
        PG8_STAGE(PG8_SB(1, 0), cB + kstep, voffB); PG8_STAGE(PG8_SA(1, 0), cA + kstep, voffA); PG8_STAGE(PG8_SB(1, 1), cB + hstep + kstep, voffB);
        PG8_WAIT_V(6); PG8_BAR;
    }
    for (;;) {
        const bool has_next = S.next(ui + 1, nxt);
        const char* nA = has_next ? (const char*)g.A + (size_t)nxt.pm * tstep : cA; const char* nB = has_next ? (const char*)g.Bt + (size_t)nxt.pn * tstep : cB;
        for (int t = 0; t < nt; t += 2) {
            const bool last = (t == nt - 2);
            const char* a1 = cA + (size_t)(t + 1) * kstep;
            const char* a2 = last ? nA : cA + (size_t)(t + 2) * kstep; const char* b2 = last ? nB : cB + (size_t)(t + 2) * kstep;
            const char* a3 = a2 + kstep; const char* b3 = b2 + kstep;
            if (last && has_next) S.a_ready(nxt);
            if constexpr (SP2) {
            PG8_LDB(B0, 0, 0); PG8_LDB(B1, 0, 1); PG8_SCHED; PG8_LDA(At, 0, 0); PG8_STAGE(PG8_SA(1, 1), a1 + hstep, voffA);
            PG8_WAIT_V(8); PG8_WAIT_L(0); PG8_BAR; PG8_MMA(0, 0, At, B0); PG8_MMA(0, 1, At, B1); PG8_BAR; PG8_SCHED;
            PG8_LDA(At, 0, 1); PG8_STAGE(PG8_SB(0, 0), b2, voffB); PG8_STAGE(PG8_SB(0, 1), b2 + hstep, voffB); PG8_STAGE(PG8_SA(0, 0), a2, voffA);
            PG8_WAIT_V(8); PG8_WAIT_L(0); PG8_BAR; PG8_MMA(1, 0, At, B0); PG8_MMA(1, 1, At, B1); PG8_BAR; PG8_SCHED;
            PG8_LDB(B0, 1, 0); PG8_LDB(B1, 1, 1); PG8_SCHED; PG8_LDA(At, 1, 0); PG8_STAGE(PG8_SA(0, 1), a2 + hstep, voffA);
            PG8_WAIT_V(8); PG8_WAIT_L(0); PG8_BAR; PG8_MMA(0, 0, At, B0); PG8_MMA(0, 1, At, B1); PG8_BAR; PG8_SCHED;
            PG8_LDA(At, 1, 1); PG8_STAGE(PG8_SB(1, 0), b3, voffB); PG8_STAGE(PG8_SB(1, 1), b3 + hstep, voffB); PG8_STAGE(PG8_SA(1, 0), a3, voffA);
            PG8_WAIT_V(8); PG8_WAIT_L(0); PG8_BAR; PG8_MMA(1, 0, At, B0); PG8_MMA(1, 1, At, B1); PG8_BAR; PG8_SCHED;
            } else {
            PG8_LDB(B0, 0, 0); PG8_SCHED; PG8_LDA(At, 0, 0); PG8_STAGE(PG8_SA(1, 1), a1 + hstep, voffA);
            PG8_WAIT_L(8); PG8_BAR; PG8_WAIT_L(0); PG8_MMA(0, 0, At, B0); PG8_BAR; PG8_SCHED;
            PG8_LDB(B1, 0, 1); PG8_STAGE(PG8_SB(0, 0), b2, voffB);
            PG8_BAR; PG8_WAIT_L(0); PG8_MMA(0, 1, At, B1); PG8_BAR;
            PG8_LDA(At, 0, 1); PG8_STAGE(PG8_SA(0, 0), a2, voffA);
            PG8_BAR; PG8_WAIT_L(0); PG8_MMA(1, 0, At, B0); PG8_BAR; PG8_SCHED;
            PG8_STAGE(PG8_SB(0, 1), b2 + hstep, voffB);
            PG8_WAIT_V(6); PG8_BAR; PG8_MMA(1, 1, At, B1); PG8_BAR;
            PG8_LDB(B0, 1, 0); PG8_SCHED; PG8_LDA(At, 1, 0); PG8_STAGE(PG8_SA(0, 1), a2 + hstep, voffA);
            PG8_WAIT_L(8); PG8_BAR; PG8_WAIT_L(0); PG8_MMA(0, 0, At, B0); PG8_BAR; PG8_SCHED;
            PG8_LDB(B1, 1, 1); PG8_STAGE(PG8_SB(1, 0), b3, voffB);
            PG8_BAR; PG8_WAIT_L(0); PG8_MMA(0, 1, At, B1); PG8_BAR;
            PG8_LDA(At, 1, 1); PG8_STAGE(PG8_SA(1, 0), a3, voffA);
            PG8_BAR; PG8_WAIT_L(0); PG8_MMA(1, 0, At, B0); PG8_BAR; PG8_SCHED;
            PG8_STAGE(PG8_SB(1, 1), b3 + hstep, voffB);
            PG8_WAIT_V(6); PG8_BAR; PG8_MMA(1, 1, At, B1); PG8_BAR;
            }
        }
        if constexpr (ALIGN_EPI) { if (wr == 0) PG8_BAR; }
        if constexpr (!Epi::AFTER_DRAIN) { E(acc, cur, wr, wc, fr, fq); S.done(cur); }
        if (!has_next) break;
#pragma unroll
        for (int a = 0; a < 2; ++a)
#pragma unroll
            for (int b = 0; b < 2; ++b)
#pragma unroll
                for (int m = 0; m < 4; ++m)
#pragma unroll
                    for (int n = 0; n < 2; ++n) acc[a][b][m][n] = (f32x4){0.f, 0.f, 0.f, 0.f};
        cur = nxt; cA = nA; cB = nB; ++ui;
        if constexpr (ALIGN_EPI) { if (wr == 1) PG8_BAR; }
    }
    PG8_WAIT_V(0);
    if constexpr (!ALIGN_EPI) { if (wr == 0) PG8_BAR; }
    PG8_BAR;
    if constexpr (Epi::AFTER_DRAIN) { E.fused(acc, cur, wr, wc, fr, fq, lds, wid, lane); S.done(cur); }
#undef PG8_SA
#undef PG8_SB
#undef PG8_STAGE
#undef PG8_LDA
#undef PG8_LDB
#undef PG8_MMA
#undef PG8_WAIT_V
#undef PG8_WAIT_L
#undef PG8_BAR
#undef PG8_SCHED
}
}

namespace pg8 {
struct EpiQkvF { static constexpr bool PERM = true, AFTER_DRAIN = false; bf16_t* O; const float* bias;
    __device__ __forceinline__ void operator()(const f32x4 (&acc)[2][2][4][2], const Unit& u, int wr, int wc, int fr, int fq) const {
        const int row0 = u.pm * BM + wr * 64 + fr, col0 = u.pn * BM + wc * 32 + 8 * fq; const float sc = (u.pn < 4) ? 0.125f : 1.0f;
        f32x4 bv[2][2];
#pragma unroll
        for (int bj = 0; bj < 2; ++bj)
#pragma unroll
            for (int n = 0; n < 2; ++n) bv[bj][n] = *(const f32x4*)(bias + col0 + bj * HALF + 4 * n) * sc;
#pragma unroll
        for (int ai = 0; ai < 2; ++ai)
#pragma unroll
            for (int m = 0; m < 4; ++m) { bf16_t* rowp = O + (size_t)(row0 + ai * HALF + m * 16) * 1280 + col0;
#pragma unroll
                for (int bj = 0; bj < 2; ++bj) { const f32x4 v0 = acc[ai][bj][m][0] + bv[bj][0], v1 = acc[ai][bj][m][1] + bv[bj][1];
                    u32x4 w; w.x = cvt_pk_bf16(v0[0], v0[1]); w.y = cvt_pk_bf16(v0[2], v0[3]); w.z = cvt_pk_bf16(v1[0], v1[1]); w.w = cvt_pk_bf16(v1[2], v1[3]);
                    *(u32x4*)(rowp + bj * HALF) = w; } }
    }
};
struct EpiResidF { static constexpr bool PERM = false, AFTER_DRAIN = false; const float* base; float* out; const float* bias;
    __device__ __forceinline__ void operator()(const f32x4 (&acc)[2][2][4][2], const Unit& u, int wr, int wc, int fr, int fq) const {
        const int col0 = u.pn * BM + wc * 32 + 4 * fq;
        f32x4 bv[2][2];
#pragma unroll
        for (int bj = 0; bj < 2; ++bj)
#pragma unroll
            for (int n = 0; n < 2; ++n) bv[bj][n] = bias ? *(const f32x4*)(bias + col0 + bj * HALF + n * 16) : (f32x4){0.f, 0.f, 0.f, 0.f};
#pragma unroll
        for (int ai = 0; ai < 2; ++ai)
#pragma unroll
            for (int m = 0; m < 4; ++m) { const size_t off = (size_t)(u.pm * BM + ai * HALF + wr * 64 + m * 16 + fr) * 1024 + col0;
#pragma unroll
                for (int bj = 0; bj < 2; ++bj)
#pragma unroll
                    for (int n = 0; n < 2; ++n) { const f32x4 bs = *(const f32x4*)(base + off + bj * HALF + n * 16); *(f32x4*)(out + off + bj * HALF + n * 16) = bs + acc[ai][bj][m][n] + bv[bj][n]; }
                if (m & 1) asm volatile("" ::: "memory"); }
    }
};
struct EpiSwigluF { static constexpr bool PERM = true, AFTER_DRAIN = false; bf16_t* O;
    __device__ __forceinline__ float silu_mul(float g, float u) const { return g * __builtin_amdgcn_rcpf(1.0f + __expf(-g)) * u; }
    __device__ __forceinline__ void operator()(const f32x4 (&acc)[2][2][4][2], const Unit& u, int wr, int wc, int fr, int fq) const {
        const int row0 = u.pm * BM + wr * 64 + fr, f0 = u.pn * HALF + wc * 32 + 8 * fq;
#pragma unroll
        for (int ai = 0; ai < 2; ++ai)
#pragma unroll
            for (int m = 0; m < 4; ++m) { const f32x4 g0 = acc[ai][0][m][0], g1 = acc[ai][0][m][1], u0 = acc[ai][1][m][0], u1 = acc[ai][1][m][1];
                u32x4 w; w.x = cvt_pk_bf16(silu_mul(g0[0], u0[0]), silu_mul(g0[1], u0[1])); w.y = cvt_pk_bf16(silu_mul(g0[2], u0[2]), silu_mul(g0[3], u0[3]));
                w.z = cvt_pk_bf16(silu_mul(g1[0], u1[0]), silu_mul(g1[1], u1[1])); w.w = cvt_pk_bf16(silu_mul(g1[2], u1[2]), silu_mul(g1[3], u1[3]));
                *(u32x4*)(O + (size_t)(row0 + ai * HALF + m * 16) * 2816 + f0) = w; }
    }
};
struct EpiWinF { static constexpr bool PERM = true, AFTER_DRAIN = false; bf16_t* P; float* gates;
    __device__ __forceinline__ void operator()(const f32x4 (&acc)[2][2][4][2], const Unit& u, int wr, int wc, int fr, int fq) const {
        const int row0 = u.pm * BM + wr * 64 + fr, col0 = u.pn * BM + wc * 32 + 8 * fq;
        if (u.pn < 7) {
#pragma unroll
            for (int ai = 0; ai < 2; ++ai)
#pragma unroll
                for (int m = 0; m < 4; ++m) { bf16_t* rowp = P + (size_t)(row0 + ai * HALF + m * 16) * 1792 + col0;
#pragma unroll
                    for (int bj = 0; bj < 2; ++bj) { const f32x4 v0 = acc[ai][bj][m][0], v1 = acc[ai][bj][m][1];
                        u32x4 w; w.x = cvt_pk_bf16(v0[0], v0[1]); w.y = cvt_pk_bf16(v0[2], v0[3]); w.z = cvt_pk_bf16(v1[0], v1[1]); w.w = cvt_pk_bf16(v1[2], v1[3]);
                        *(u32x4*)(rowp + bj * HALF) = w; } }
        } else {
            const int gc = wc * 32 + 8 * fq;
            if (gc < 48) {
#pragma unroll
                for (int ai = 0; ai < 2; ++ai)
#pragma unroll
                    for (int m = 0; m < 4; ++m) { float* gp = gates + (size_t)(row0 + ai * HALF + m * 16) * 48 + gc;
#pragma unroll
                        for (int n = 0; n < 2; ++n) { const f32x4 v = acc[ai][0][m][n]; f32x4 s;
#pragma unroll
                            for (int j = 0; j < 4; ++j) s[j] = __builtin_amdgcn_rcpf(1.0f + __expf(-v[j]));
                            *(f32x4*)(gp + 4 * n) = s; } }
            }
        }
    }
};
}

struct Args { const float* in[17]; float* out; unsigned char* ws; int ph_lo, ph_hi, li, pad; };
struct Frame {
    LAS unsigned char* lds;
    int tid, lane, wave, G, bid;
    int gw, ngw;
    const float* in[17]; float* out; unsigned char* ws;
};

__device__ __forceinline__ int t5_bucket(int n) {
    if (n < 16) return n;
    const float nf = (float)n;
    const int lb = 16 + (int)(logf(nf / 16.0f) / 4.1588830833596715f * 16.0f);
    return lb < 31 ? lb : 31;
}

struct RmPlain { int off; float s; __device__ int row(int n) const { return n + off; } __device__ float scale(int) const { return s; } };
struct RmQScale { int nq; __device__ int row(int n) const { return n; } __device__ float scale(int n) const { return n < nq ? 0.125f : 1.0f; } };
struct RmGU { __device__ int row(int n) const { const int up = n >= DFF; const int f = up ? n - DFF : n; return (f >> 7) * 256 + (up ? 128 : 0) + (f & 127); } __device__ float scale(int) const { return 1.0f; } };

template <class RM>
__device__ __forceinline__ void transpose_item(const float* W, int K, int N, bf16_t* WT, LAS float* scr, int item, int lane, const RM rm) {
    const int nblk = (N + 63) / 64, kb = item / nblk, nb = item % nblk, k0 = 64 * kb, n0 = 64 * nb;
    const int n4 = n0 + 4 * (lane & 15);
    f32x4 v[16];
#pragma unroll
    for (int i = 0; i < 16; ++i) { const int kk = 4 * i + (lane >> 4); v[i] = (n4 < N) ? *(const f32x4*)(W + (size_t)(k0 + kk) * N + n4) : (f32x4){0.f, 0.f, 0.f, 0.f}; }
#pragma unroll
    for (int i = 0; i < 16; ++i) { const int kk = 4 * i + (lane >> 4); LAS float* s = scr + kk * 65 + 4 * (lane & 15); s[0] = v[i].x; s[1] = v[i].y; s[2] = v[i].z; s[3] = v[i].w; }
    asm volatile("s_waitcnt lgkmcnt(0)" ::: "memory");
    const int c = lane & 7;
#pragma unroll
    for (int j = 0; j < 8; ++j) { const int nn = (lane >> 3) + 8 * j; const int n = n0 + nn; const LAS float* s = scr + (8 * c) * 65 + nn;
        if (n < N) { const float sc = rm.scale(n);
            u32x4 o; o.x = pk2(s[0 * 65] * sc, s[1 * 65] * sc); o.y = pk2(s[2 * 65] * sc, s[3 * 65] * sc); o.z = pk2(s[4 * 65] * sc, s[5 * 65] * sc); o.w = pk2(s[6 * 65] * sc, s[7 * 65] * sc);
            *(u32x4*)(WT + (size_t)rm.row(n) * K + k0 + 8 * c) = o; } }
    asm volatile("s_waitcnt lgkmcnt(0)" ::: "memory");
}
template <class RM>
__device__ __forceinline__ void transpose_all(Frame& F, const float* W, int K, int N, bf16_t* WT, const RM rm) {
    LAS float* scr = (LAS float*)(F.lds + F.wave * 16896);
    const int nitems = (K / 64) * ((N + 63) / 64);
    for (int it = F.gw; it < nitems; it += F.ngw) transpose_item(W, K, N, WT, scr, it, F.lane, rm);
}
__device__ __forceinline__ void rms_row_to_bf16(const float* xrow, const float* g, bf16_t* orow, int lane) {
    const f32x4* xr = (const f32x4*)xrow + lane; const f32x4* gr = (const f32x4*)g + lane;
    f32x4 v[4]; float s = 0.f;
#pragma unroll
    for (int j = 0; j < 4; ++j) { v[j] = xr[64 * j]; s += (v[j].x * v[j].x + v[j].y * v[j].y) + (v[j].z * v[j].z + v[j].w * v[j].w); }
    const float rstd = 1.0f / sqrtf(wave_sum(s) * (1.0f / DM) + RMS_EPS);
    unsigned long long* o8 = (unsigned long long*)orow + lane;
#pragma unroll
    for (int j = 0; j < 4; ++j) { const f32x4 gg = gr[64 * j];
        o8[64 * j] = (unsigned long long)pk2(v[j].x * rstd * gg.x, v[j].y * rstd * gg.y) | ((unsigned long long)pk2(v[j].z * rstd * gg.z, v[j].w * rstd * gg.w) << 32); }
}
__device__ __forceinline__ void norm_phase(Frame& F, const float* H, const float* g, bf16_t* XA) {
    for (int m = F.gw; m < M; m += F.ngw) rms_row_to_bf16(H + (size_t)m * DM, g, XA + (size_t)m * DM, F.lane);
}
__device__ __forceinline__ void final_norm_phase(Frame& F, float* H, const float* g) {
    for (int m = F.gw; m < M; m += F.ngw) {
        f32x4* xr = (f32x4*)(H + (size_t)m * DM) + F.lane; const f32x4* gr = (const f32x4*)g + F.lane;
        f32x4 v[4]; float s = 0.f;
#pragma unroll
        for (int j = 0; j < 4; ++j) { v[j] = xr[64 * j]; s += (v[j].x * v[j].x + v[j].y * v[j].y) + (v[j].z * v[j].z + v[j].w * v[j].w); }
        const float rstd = 1.0f / sqrtf(wave_sum(s) * (1.0f / DM) + RMS_EPS);
#pragma unroll
        for (int j = 0; j < 4; ++j) { const f32x4 gg = gr[64 * j]; f32x4 o; o.x = v[j].x * rstd * gg.x; o.y = v[j].y * rstd * gg.y; o.z = v[j].z * rstd * gg.z; o.w = v[j].w * rstd * gg.w; xr[64 * j] = o; }
    }
}
__device__ __forceinline__ void p0_prologue(Frame& F) {
    unsigned char* ws = F.ws;
    transpose_all(F, F.in[5], DM, AQKV, (bf16_t*)(ws + WS_WQKVA), RmQScale{1024});
    transpose_all(F, F.in[8], DM, DM, (bf16_t*)(ws + WS_WOA), RmPlain{0, 1.f});
    transpose_all(F, F.in[10], DM, BIN, (bf16_t*)(ws + WS_WIN), RmQScale{1024});
    transpose_all(F, F.in[14], DM, DM, (bf16_t*)(ws + WS_WOB), RmPlain{0, 1.f});
    for (int l = 0; l < 2; ++l) {
        transpose_all(F, F.in[15] + (size_t)l * DM * 2 * DFF, DM, 2 * DFF, (bf16_t*)(ws + WS_WGU) + (size_t)l * 2 * DFF * DM, RmGU{});
        transpose_all(F, F.in[16] + (size_t)l * DFF * DM, DFF, DM, (bf16_t*)(ws + WS_WDN) + (size_t)l * DM * DFF, RmPlain{0, 1.f});
        transpose_all(F, F.in[12] + (size_t)l * 2048 * 256, 2048, 256, (bf16_t*)(ws + WS_CW1) + (size_t)l * 256 * 2048, RmPlain{0, 1.f});
        transpose_all(F, F.in[13] + (size_t)l * 256 * 64, 256, 64, (bf16_t*)(ws + WS_CW2) + (size_t)l * 64 * 256, RmPlain{0, 1.f});
    }
    { u32x4* z = (u32x4*)((bf16_t*)(ws + WS_WIN) + (size_t)BIN * DM); const int n16 = (BINP - BIN) * DM * 2 / 16;
      for (int i = F.bid * NTHR + F.tid; i < n16; i += F.G * NTHR) z[i] = (u32x4){0u, 0u, 0u, 0u}; }
    { float* bd = (float*)(ws + WS_BIASD); const float* rt = F.in[1];
      for (int i = F.bid * NTHR + F.tid; i < 2048 * 16; i += F.G * NTHR) { const int d = i >> 4, h = i & 15; bd[i] = rt[t5_bucket(d) * 16 + h]; } }
    { float* c1 = (float*)(ws + WS_C1);
      for (int o = F.gw; o < 512; o += F.ngw) { const int kv = o >> 8, n = o & 255; const float* pos = F.in[11] + kv * 2048; const float* w1 = F.in[12] + (size_t)kv * 2048 * 256;
          float s = 0.f; for (int k = F.lane; k < 2048; k += 64) s += pos[k] * w1[(size_t)k * 256 + n];
          s = wave_sum(s); if (F.lane == 0) c1[o] = s; } }
    norm_phase(F, F.in[0], F.in[2], (bf16_t*)(ws + WS_XA));
}

template <bool DUAL, class Epi>
__device__ __forceinline__ void gemm_simple(Frame& F, const bf16_t* A, int lda, const bf16_t* Bt, int K, int nfeat_tiles, const Epi& E) {
    const int lane = F.lane, r32 = lane & 31, hi = lane >> 5;
    const int ntiles = (M / 64) * nfeat_tiles;
    for (int t = F.gw; t < ntiles; t += F.ngw) {
        const int mt = t / nfeat_tiles, ft = t % nfeat_tiles;
        const int m0 = mt * 64;
        int brow0, brow1, f0;
        if (DUAL) { f0 = ft * 32; brow0 = (f0 >> 7) * 256 + (f0 & 127); brow1 = brow0 + 128; }
        else { f0 = ft * 64; brow0 = f0; brow1 = f0 + 32; }
        const bf16_t* a0 = A + (size_t)(m0 + r32) * lda + 8 * hi; const bf16_t* a1 = a0 + (size_t)32 * lda;
        const bf16_t* b0 = Bt + (size_t)(brow0 + r32) * K + 8 * hi; const bf16_t* b1 = Bt + (size_t)(brow1 + r32) * K + 8 * hi;
        f32x16 acc00 = {}, acc01 = {}, acc10 = {}, acc11 = {};
#pragma unroll 4
        for (int k = 0; k < K; k += 16) {
            const bf16x8 fa0 = *(const bf16x8*)(a0 + k), fa1 = *(const bf16x8*)(a1 + k), fb0 = *(const bf16x8*)(b0 + k), fb1 = *(const bf16x8*)(b1 + k);
            acc00 = __builtin_amdgcn_mfma_f32_32x32x16_bf16(fa0, fb0, acc00, 0, 0, 0);
            acc01 = __builtin_amdgcn_mfma_f32_32x32x16_bf16(fa0, fb1, acc01, 0, 0, 0);
            acc10 = __builtin_amdgcn_mfma_f32_32x32x16_bf16(fa1, fb0, acc10, 0, 0, 0);
            acc11 = __builtin_amdgcn_mfma_f32_32x32x16_bf16(fa1, fb1, acc11, 0, 0, 0);
        }
#pragma unroll
        for (int r = 0; r < 16; ++r) {
            const int row = m0 + (r & 3) + 8 * (r >> 2) + 4 * hi;
            if (DUAL) { E(row, f0 + r32, acc00[r], acc01[r]); E(row + 32, f0 + r32, acc10[r], acc11[r]); }
            else { E(row, f0 + r32, acc00[r], 0.f); E(row, f0 + 32 + r32, acc01[r], 0.f); E(row + 32, f0 + r32, acc10[r], 0.f); E(row + 32, f0 + 32 + r32, acc11[r], 0.f); }
        }
    }
}
struct EpiQkvA { bf16_t* O; const float* bias; __device__ void operator()(int m, int n, float v, float) const { const float b = bias[n] * (n < 1024 ? 0.125f : 1.0f); O[(size_t)m * AQKV + n] = (bf16_t)f2bf(v + b); } };
struct EpiResid { const float* base; float* out; const float* bias; __device__ void operator()(int m, int n, float v, float) const { const size_t i = (size_t)m * DM + n; out[i] = base[i] + v + (bias ? bias[n] : 0.f); } };
struct EpiSwiglu { bf16_t* O; __device__ void operator()(int m, int f, float g, float u) const { const float s = g / (1.0f + __expf(-g)); O[(size_t)m * DFF + f] = (bf16_t)f2bf(s * u); } };
struct EpiWin { bf16_t* P; float* gates; __device__ void operator()(int m, int n, float v, float) const {
    if (n < PROJW) P[(size_t)m * PROJW + n] = (bf16_t)f2bf(v);
    else if (n < BIN) gates[(size_t)m * 48 + (n - PROJW)] = 1.0f / (1.0f + __expf(-v)); } };

struct KVsrc { const bf16_t* base; int pitch; int koff, voff; };
template <int MODE  >
__device__ __forceinline__ void attn_simple(Frame& F, const bf16_t* Q, int qpitch, KVsrc kv, const float* biasD, const float* sinks, const float* gates, const unsigned* selm, float* Ocomb, bf16_t* O) {
    const int nitems = M * NH / NTHR;
    for (int it = F.bid; it < nitems; it += F.G) {
        const int idx = it * NTHR + F.tid; const int m = idx >> 4, h = idx & 15, g = h >> 3;
        const int b = m / SEQ, t = m % SEQ;
        float q[64];
        { const u32x4* qp = (const u32x4*)(Q + (size_t)m * qpitch + h * 64);
#pragma unroll
          for (int c = 0; c < 8; ++c) { const u32x4 w = qp[c]; q[8 * c + 0] = bflo(w.x); q[8 * c + 1] = bfhi(w.x); q[8 * c + 2] = bflo(w.y); q[8 * c + 3] = bfhi(w.y); q[8 * c + 4] = bflo(w.z); q[8 * c + 5] = bfhi(w.z); q[8 * c + 6] = bflo(w.w); q[8 * c + 7] = bfhi(w.w); } }
        float o[64];
#pragma unroll
        for (int d = 0; d < 64; ++d) o[d] = 0.f;
        float mx = -1e20f, l = 0.f;
        unsigned sm = 0xffffffffu; int s_lo = 0;
        if (MODE == 0) s_lo = t - 127 > 0 ? t - 127 : 0;
        if (MODE == 2) s_lo = t - 511 > 0 ? t - 511 : 0;
        if (MODE == 1) sm = selm[(size_t)(b * 2 + g) * SEQ + t];
        const bf16_t* kb = kv.base + (size_t)b * SEQ * kv.pitch + kv.koff + g * 64;
        const bf16_t* vb = kv.base + (size_t)b * SEQ * kv.pitch + kv.voff + g * 64;
        for (int s = s_lo; s <= t; ++s) {
            if (MODE == 1) { if (!((sm >> (s >> 6)) & 1u)) { s |= 63; continue; } }
            const u32x4* kp = (const u32x4*)(kb + (size_t)s * kv.pitch);
            float dot = 0.f;
#pragma unroll
            for (int c = 0; c < 8; ++c) { const u32x4 w = kp[c];
                dot += q[8 * c + 0] * bflo(w.x) + q[8 * c + 1] * bfhi(w.x) + q[8 * c + 2] * bflo(w.y) + q[8 * c + 3] * bfhi(w.y) + q[8 * c + 4] * bflo(w.z) + q[8 * c + 5] * bfhi(w.z) + q[8 * c + 6] * bflo(w.w) + q[8 * c + 7] * bfhi(w.w); }
            const float sc = dot + biasD[(t - s) * 16 + h];
            const float mn = fmaxf(mx, sc); const float al = __expf(mx - mn), p = __expf(sc - mn);
            l = l * al + p; mx = mn;
            const u32x4* vp = (const u32x4*)(vb + (size_t)s * kv.pitch);
#pragma unroll
            for (int c = 0; c < 8; ++c) { const u32x4 w = vp[c];
                o[8 * c + 0] = o[8 * c + 0] * al + p * bflo(w.x); o[8 * c + 1] = o[8 * c + 1] * al + p * bfhi(w.x); o[8 * c + 2] = o[8 * c + 2] * al + p * bflo(w.y); o[8 * c + 3] = o[8 * c + 3] * al + p * bfhi(w.y);
                o[8 * c + 4] = o[8 * c + 4] * al + p * bflo(w.z); o[8 * c + 5] = o[8 * c + 5] * al + p * bfhi(w.z); o[8 * c + 6] = o[8 * c + 6] * al + p * bflo(w.w); o[8 * c + 7] = o[8 * c + 7] * al + p * bfhi(w.w); }
        }
        float inv;
        if (MODE == 0) { const float sk = sinks[h]; const float mf = fmaxf(mx, sk); const float al = __expf(mx - mf); inv = al / (l * al + __expf(sk - mf)); }
        else inv = (l > 0.f ? 1.0f / l : 0.f) * gates[(size_t)m * 48 + h * 3 + MODE];
        const size_t ob = (size_t)m * DM + h * 64;
        if (MODE == 1) {
#pragma unroll
            for (int c = 0; c < 16; ++c) { f32x4 a = *(f32x4*)(Ocomb + ob + 4 * c); a.x += o[4 * c] * inv; a.y += o[4 * c + 1] * inv; a.z += o[4 * c + 2] * inv; a.w += o[4 * c + 3] * inv; *(f32x4*)(Ocomb + ob + 4 * c) = a; }
        } else {
#pragma unroll
            for (int c = 0; c < 8; ++c) { float e[8];
#pragma unroll
                for (int j = 0; j < 8; ++j) e[j] = o[8 * c + j] * inv;
                if (MODE == 2) { const f32x4 a0 = *(const f32x4*)(Ocomb + ob + 8 * c), a1 = *(const f32x4*)(Ocomb + ob + 8 * c + 4); e[0] += a0.x; e[1] += a0.y; e[2] += a0.z; e[3] += a0.w; e[4] += a1.x; e[5] += a1.y; e[6] += a1.z; e[7] += a1.w; }
                u32x4 w; w.x = pk2(e[0], e[1]); w.y = pk2(e[2], e[3]); w.z = pk2(e[4], e[5]); w.w = pk2(e[6], e[7]); *(u32x4*)(O + ob + 8 * c) = w; }
        }
    }
}

__device__ __forceinline__ float gelu_tanh(float x) { const float u = 0.7978845608028654f * (x + 0.044715f * x * x * x); const float e = __expf(2.0f * u); const float th = 1.0f - 2.0f / (e + 1.0f); return 0.5f * x * (1.0f + th); }
__device__ __forceinline__ void compress_simple(Frame& F) {
    unsigned char* ws = F.ws;
    const bf16_t* P = (const bf16_t*)(ws + WS_QKV);
    LAS float* xs = (LAS float*)F.lds;
    LAS float* hs = xs + 2048;
    LAS float* part = hs + 256;
    const int nitems = 2 * BATCH * 2 * NC;
    for (int it = F.bid; it < nitems; it += F.G) {
        const int c = it % NC, g = (it / NC) & 1, b = (it / (NC * 2)) % BATCH, kvi = it / (NC * 2 * BATCH);
        __syncthreads();
        { const int l = F.tid >> 4, d4 = (F.tid & 15) * 4; const bf16_t* src = P + (size_t)(b * SEQ + 16 * c + l) * PROJW + 1024 + kvi * 128 + g * 64 + d4;
          const u32x2 w = *(const u32x2*)src; xs[l * 64 + d4] = bflo(w.x); xs[l * 64 + d4 + 1] = bfhi(w.x); xs[l * 64 + d4 + 2] = bflo(w.y); xs[l * 64 + d4 + 3] = bfhi(w.y); }
        __syncthreads();
        { const int n = F.tid & 255, half = F.tid >> 8; const bf16_t* w1 = (const bf16_t*)(ws + WS_CW1) + (size_t)kvi * 256 * 2048 + (size_t)n * 2048 + half * 1024;
          float s = 0.f;
          for (int k = 0; k < 1024; k += 8) { const u32x4 w = *(const u32x4*)(w1 + k); const LAS float* x = xs + half * 1024 + k;
              s += x[0] * bflo(w.x) + x[1] * bfhi(w.x) + x[2] * bflo(w.y) + x[3] * bfhi(w.y) + x[4] * bflo(w.z) + x[5] * bfhi(w.z) + x[6] * bflo(w.w) + x[7] * bfhi(w.w); }
          part[F.tid] = s; }
        __syncthreads();
        if (F.tid < 256) hs[F.tid] = gelu_tanh(part[F.tid] + part[F.tid + 256] + ((const float*)(ws + WS_C1))[kvi * 256 + F.tid]);
        __syncthreads();
        if (F.tid < 64) { const bf16_t* w2 = (const bf16_t*)(ws + WS_CW2) + (size_t)kvi * 64 * 256 + (size_t)F.tid * 256; float s = 0.f;
            for (int n = 0; n < 256; n += 2) { const unsigned w = *(const unsigned*)(w2 + n); s += hs[n] * bflo(w) + hs[n + 1] * bfhi(w); }
            ((bf16_t*)(ws + WS_KCVC))[((size_t)((kvi * BATCH + b) * 2 + g) * 128 + c) * 64 + F.tid] = (bf16_t)f2bf(s); }
    }
}

__device__ __forceinline__ void compress_fast(Frame& F) {
    unsigned char* ws = F.ws;
    const bf16_t* P = (const bf16_t*)(ws + WS_QKV);
    const bf16_t* w1t = (const bf16_t*)(ws + WS_CW1); const bf16_t* w2t = (const bf16_t*)(ws + WS_CW2);
    const float* c1 = (const float*)(ws + WS_C1);
    bf16_t* KV = (bf16_t*)(ws + WS_KCVC);
    LAS unsigned char* hl = F.lds;
    const int lane = F.lane, r32 = lane & 31, hi = lane >> 5, w = F.wave;
    for (int it = F.bid; it < 128; it += F.G) {
        const int ct = it & 3, g = (it >> 2) & 1, b = (it >> 3) & 7, kvi = it >> 6;
        const int c0 = 32 * ct;
        const int cl = (c0 + r32) < 126 ? (c0 + r32) : 126;
        const bf16_t* abase = P + (size_t)(b * SEQ + 16 * cl) * PROJW + 1024 + kvi * 128 + g * 64 + 8 * hi;
        const bf16_t* bbase = w1t + (size_t)kvi * 256 * 2048 + (size_t)(32 * w + r32) * 2048 + 8 * hi;
        f32x16 acc = {};
#pragma unroll 8
        for (int ks = 0; ks < 128; ++ks) {
            const bf16x8 a = *(const bf16x8*)(abase + (size_t)(ks >> 2) * PROJW + 16 * (ks & 3));
            const bf16x8 bb = *(const bf16x8*)(bbase + 16 * ks);
            acc = __builtin_amdgcn_mfma_f32_32x32x16_bf16(a, bb, acc, 0, 0, 0);
        }
        const float c1v = c1[kvi * 256 + 32 * w + r32];
        __syncthreads();
#pragma unroll
        for (int r = 0; r < 16; ++r) { const int cr = (r & 3) + 8 * (r >> 2) + 4 * hi; *(LAS bf16_t*)(hl + cr * 528 + (32 * w + r32) * 2) = (bf16_t)f2bf(gelu_tanh(acc[r] + c1v)); }
        __syncthreads();
        if (w < 2) {
            f32x16 o = {};
            const bf16_t* w2 = w2t + (size_t)kvi * 64 * 256 + (size_t)(32 * w + r32) * 256 + 8 * hi;
#pragma unroll
            for (int ks = 0; ks < 16; ++ks) {
                const bf16x8 a = *(const LAS bf16x8*)(hl + r32 * 528 + (16 * ks + 8 * hi) * 2);
                const bf16x8 bb = *(const bf16x8*)(w2 + 16 * ks);
                o = __builtin_amdgcn_mfma_f32_32x32x16_bf16(a, bb, o, 0, 0, 0);
            }
            bf16_t* outp = KV + (size_t)((kvi * BATCH + b) * 2 + g) * 128 * 64 + 32 * w + r32;
#pragma unroll
            for (int r = 0; r < 16; ++r) { const int c = c0 + (r & 3) + 8 * (r >> 2) + 4 * hi; outp[(size_t)c * 64] = (c < NC) ? (bf16_t)f2bf(o[r]) : (bf16_t)0; }
        }
    }
}

__device__ __forceinline__ void cmp_simple(Frame& F) {
    unsigned char* ws = F.ws;
    const bf16_t* P = (const bf16_t*)(ws + WS_QKV);
    const float* biasD = (const float*)(ws + WS_BIASD);
    const float* gates = (const float*)(ws + WS_GATES);
    float* Ocomb = (float*)(ws + WS_OCOMB);
    unsigned* selm = (unsigned*)(ws + WS_SELM);
    LAS float* Pl = (LAS float*)F.lds;
    LAS float* sc = Pl + 1024;
    const int nitems = BATCH * 2 * SEQ;
    for (int it = F.bid; it < nitems; it += F.G) {
        const int t = it % SEQ, g = (it / SEQ) & 1, b = it / (SEQ * 2);
        const int m = b * SEQ + t, hh = F.wave, h = g * 8 + hh, lane = F.lane;
        const bf16_t* kc = (const bf16_t*)(ws + WS_KCVC) + (size_t)((0 * BATCH + b) * 2 + g) * 128 * 64;
        const bf16_t* vc = (const bf16_t*)(ws + WS_KCVC) + (size_t)((1 * BATCH + b) * 2 + g) * 128 * 64;
        const bf16_t* qp = P + (size_t)m * PROJW + h * 64;
        __syncthreads();
        float s2[2];
#pragma unroll
        for (int u = 0; u < 2; ++u) { const int c = lane + 64 * u; float dot = 0.f; const bool valid = (c < NC) && (16 * c + 31 <= t);
            if (valid) { const u32x4* kp = (const u32x4*)(kc + (size_t)c * 64); const u32x4* qq = (const u32x4*)qp;
#pragma unroll
                for (int j = 0; j < 8; ++j) { const u32x4 a = qq[j], w = kp[j];
                    dot += bflo(a.x) * bflo(w.x) + bfhi(a.x) * bfhi(w.x) + bflo(a.y) * bflo(w.y) + bfhi(a.y) * bfhi(w.y) + bflo(a.z) * bflo(w.z) + bfhi(a.z) * bfhi(w.z) + bflo(a.w) * bflo(w.w) + bfhi(a.w) * bfhi(w.w); }
                dot += biasD[(t - 16 * c - 31) * 16 + h]; }
            s2[u] = valid ? dot : NEG_BIG; }
        const float mx = wave_max(fmaxf(s2[0], s2[1]));
        const float e0 = s2[0] > -1e29f ? __expf(s2[0] - mx) : 0.f, e1 = s2[1] > -1e29f ? __expf(s2[1] - mx) : 0.f;
        const float l = wave_sum(e0 + e1); const float inv = l > 0.f ? 1.0f / l : 0.f;
        Pl[hh * 128 + lane] = e0 * inv; Pl[hh * 128 + 64 + lane] = e1 * inv;
        __syncthreads();
        { float o = 0.f; const int cmax = (t - 31) >= 0 ? (t - 31) / 16 : -1;
          for (int c = 0; c <= cmax && c < NC; ++c) o += Pl[hh * 128 + c] * bf2f(vc[(size_t)c * 64 + lane]);
          Ocomb[(size_t)m * DM + h * 64 + lane] = o * gates[(size_t)m * 48 + h * 3 + 0]; }
        if (F.tid < 32) { const int j = F.tid, cur = t >> 6; float imp = 0.f;
            for (int c = 4 * j - 1; c <= 4 * j + 3; ++c) if (c >= 0 && c < NC) { float a = 0.f;
#pragma unroll
                for (int q = 0; q < 8; ++q) a += Pl[q * 128 + c];
                imp += a; }
            const bool forced = (j == 0) || (cur - j >= 0 && cur - j < 2);
            sc[j] = forced ? 1e6f : (j <= cur ? imp : -1.0f); }
        __syncthreads();
        if (F.tid < 32) { const int j = F.tid; const float mine = sc[j]; int rank = 0;
            for (int k = 0; k < 32; ++k) { const float o = sc[k]; rank += (o > mine || (o == mine && k < j)) ? 1 : 0; }
            const unsigned long long bal = __ballot(rank < 16);
            if (j == 0) selm[(size_t)(b * 2 + g) * SEQ + t] = (unsigned)bal; }
    }
}


namespace fa {
constexpr float LOG2E = 1.4426950408889634f;
constexpr float THR = 5.5f;
constexpr int KVB = 8192;
constexpr int BUFB = 2 * KVB;
constexpr int TC_N = 2112, TC_RC = 2047;
constexpr int TW_N = 640, TW_RC = 575;
constexpr int TS_N = 256, TS_RC = 191;
constexpr int L_KV = 0, L_TC = 2 * BUFB, L_TW = L_TC + 8 * TC_N * 4, L_SC = L_TW + 8 * TW_N * 4, L_SELM = L_SC + 4096, L_END = L_SELM + 128;
static_assert(L_END <= LDS_MAIN, "attention LDS map");
typedef float f32x2_t __attribute__((ext_vector_type(2))); typedef __bf16 bf16x2_t __attribute__((ext_vector_type(2)));
typedef short v4i16_t __attribute__((ext_vector_type(4)));
__device__ __forceinline__ unsigned cvtpk(float lo, float hi) { f32x2_t v = {lo, hi}; bf16x2_t b = __builtin_convertvector(v, bf16x2_t); return __builtin_bit_cast(unsigned, b); }
__device__ __forceinline__ v4i16_t vtr(const LAS unsigned char* p) { return __builtin_amdgcn_ds_read_tr16_b64_v4i16((LAS v4i16_t*)p); }
__device__ __forceinline__ int swz_f(int key) { return (((key >> 1) & 1) << 2) | ((key >> 2) & 3); }
__device__ __forceinline__ int swz_off(int key, int chunk) { return key * 128 + ((chunk ^ swz_f(key)) << 4); }
__device__ __forceinline__ float hswap_max(float v) { return fmaxf(v, __shfl_xor(v, 32)); }
__device__ __forceinline__ float hswap_sum(float v) { return v + __shfl_xor(v, 32); }

struct TileSrc { const bf16_t* k; const bf16_t* v; int pitch; };
__device__ __forceinline__ void tile_load(const TileSrc& s, int tid, u32x4& kr, u32x4& vr) {
    const int key = tid >> 3, ch = tid & 7;
    kr = *(const u32x4*)(s.k + (size_t)key * s.pitch + ch * 8); vr = *(const u32x4*)(s.v + (size_t)key * s.pitch + ch * 8);
}
__device__ __forceinline__ void tile_store(LAS unsigned char* buf, int tid, const u32x4& kr, const u32x4& vr) {
    const int key = tid >> 3, ch = tid & 7; const int o = swz_off(key, ch);
    *(LAS u32x4*)(buf + o) = kr; *(LAS u32x4*)(buf + KVB + o) = vr;
}
__device__ __forceinline__ void qk_tile(const LAS unsigned char* buf, const bf16x8 (&qf)[4], const int (&koff)[4], f32x16& p0, f32x16& p1) {
    p0 = (f32x16){}; p1 = (f32x16){};
#pragma unroll
    for (int ks = 0; ks < 4; ++ks) {
        const bf16x8 a0 = *(const LAS bf16x8*)(buf + koff[ks]); const bf16x8 a1 = *(const LAS bf16x8*)(buf + koff[ks] + 4096);
        p0 = __builtin_amdgcn_mfma_f32_32x32x16_bf16(a0, qf[ks], p0, 0, 0, 0);
        p1 = __builtin_amdgcn_mfma_f32_32x32x16_bf16(a1, qf[ks], p1, 0, 0, 0);
    }
}
__device__ __forceinline__ void pv_tile(const LAS unsigned char* buf, const int (&voff)[4], const f32x16& p0, const f32x16& p1, f32x16& o0, f32x16& o1) {
#pragma unroll
    for (int s = 0; s < 4; ++s) {
        u32x4 pw;
        if (s < 2) { const int b = 8 * (s & 1); pw.x = cvtpk(p0[b], p0[b + 1]); pw.y = cvtpk(p0[b + 2], p0[b + 3]); pw.z = cvtpk(p0[b + 4], p0[b + 5]); pw.w = cvtpk(p0[b + 6], p0[b + 7]); }
        else       { const int b = 8 * (s & 1); pw.x = cvtpk(p1[b], p1[b + 1]); pw.y = cvtpk(p1[b + 2], p1[b + 3]); pw.z = cvtpk(p1[b + 4], p1[b + 5]); pw.w = cvtpk(p1[b + 6], p1[b + 7]); }
        const bf16x8 pb = __builtin_bit_cast(bf16x8, pw);
        { const v4i16_t va = vtr(buf + voff[0] + 2048 * s), vb = vtr(buf + voff[1] + 2048 * s);
          const bf16x8 A = (bf16x8){va[0], va[1], va[2], va[3], vb[0], vb[1], vb[2], vb[3]};
          o0 = __builtin_amdgcn_mfma_f32_32x32x16_bf16(A, pb, o0, 0, 0, 0); }
        { const v4i16_t va = vtr(buf + voff[2] + 2048 * s), vb = vtr(buf + voff[3] + 2048 * s);
          const bf16x8 A = (bf16x8){va[0], va[1], va[2], va[3], vb[0], vb[1], vb[2], vb[3]};
          o1 = __builtin_amdgcn_mfma_f32_32x32x16_bf16(A, pb, o1, 0, 0, 0); }
    }
}
__device__ __forceinline__ void tile_step(const LAS unsigned char* buf, const bf16x8 (&qf)[4], const int (&koff)[4], const int (&voff)[4], const LAS float* tp,
                                          float& m, float& l, f32x16& o0, f32x16& o1) {
    f32x16 p0, p1;
    qk_tile(buf, qf, koff, p0, p1);
#pragma unroll
    for (int r = 0; r < 16; ++r) { p0[r] += tp[(r & 3) + 8 * (r >> 2)]; p1[r] += tp[32 + (r & 3) + 8 * (r >> 2)]; }
    float mx = fmaxf(p0[0], p1[0]);
#pragma unroll
    for (int r = 1; r < 16; ++r) mx = fmaxf(mx, fmaxf(p0[r], p1[r]));
    mx = hswap_max(mx);
    if (__any(mx > m + THR)) {
        const float mn = fmaxf(m, mx); const float al = __builtin_amdgcn_exp2f((m - mn) * LOG2E);
        l *= al; m = mn;
#pragma unroll
        for (int r = 0; r < 16; ++r) { o0[r] *= al; o1[r] *= al; }
    }
    const float c = -m * LOG2E; float ls = 0.f;
#pragma unroll
    for (int r = 0; r < 16; ++r) { p0[r] = __builtin_amdgcn_exp2f(__builtin_fmaf(p0[r], LOG2E, c)); p1[r] = __builtin_amdgcn_exp2f(__builtin_fmaf(p1[r], LOG2E, c)); ls += p0[r] + p1[r]; }
    l += ls;
    pv_tile(buf, voff, p0, p1, o0, o1);
}
__device__ __forceinline__ void lane_offsets(int lane, int (&koff)[4], int (&voff)[4]) {
    const int r32 = lane & 31, hi = lane >> 5;
#pragma unroll
    for (int ks = 0; ks < 4; ++ks) koff[ks] = swz_off(r32, 2 * ks + hi);
    const int kq = (lane & 15) >> 2, gidx = (lane >> 4) & 1, within = 8 * (lane & 1);
    const int fA = ((kq >> 1) << 2) | hi, fB = ((kq >> 1) << 2) | (hi + 2);
#pragma unroll
    for (int dh = 0; dh < 2; ++dh) { const int chunk = 4 * dh + 2 * gidx + ((lane & 3) >> 1);
        voff[2 * dh + 0] = KVB + (4 * hi + kq) * 128 + ((chunk ^ fA) << 4) + within;
        voff[2 * dh + 1] = KVB + (4 * hi + kq + 8) * 128 + ((chunk ^ fB) << 4) + within; }
}
__device__ __forceinline__ void unit_decode(int it, int& b, int& g, int& qt) {
    const int k = it >> 8, v = it & 255, pair = v >> 4, s = v & 15;
    b = pair >> 1; g = pair & 1; qt = (k == 0) ? s : (k == 1) ? 31 - s : (k == 2) ? 32 + s : 63 - s;
}
__device__ __forceinline__ void store_o(bf16_t* orow  , int hi, const f32x16& o0, const f32x16& o1) {
#pragma unroll
    for (int rg = 0; rg < 4; ++rg) {
        u32x2 w0; w0.x = cvtpk(o0[4 * rg], o0[4 * rg + 1]); w0.y = cvtpk(o0[4 * rg + 2], o0[4 * rg + 3]);
        u32x2 w1; w1.x = cvtpk(o1[4 * rg], o1[4 * rg + 1]); w1.y = cvtpk(o1[4 * rg + 2], o1[4 * rg + 3]);
        *(u32x2*)(orow + 8 * rg + 4 * hi) = w0; *(u32x2*)(orow + 32 + 8 * rg + 4 * hi) = w1; }
}

__device__ __forceinline__ void swa_phase(Frame& F, const bf16_t* QKV, const float* biasD, const float* sinks, bf16_t* O) {
    LAS unsigned char* kvb = F.lds + L_KV; LAS float* tabS = (LAS float*)(F.lds + L_TC);
    const int lane = F.lane, r32 = lane & 31, hi = lane >> 5, w = F.wave, tid = F.tid;
    int koff[4], voff[4]; lane_offsets(lane, koff, voff);
    const int vcu = (F.G % 8 == 0) ? (F.bid % 8) * (F.G / 8) + F.bid / 8 : F.bid;
    int built_g = -1;
    for (int it = vcu; it < 1024; it += F.G) {
        int b, g, qt; unit_decode(it, b, g, qt);
        const int t0 = 32 * qt, cur = qt >> 1, h = 8 * g + w, t = t0 + r32;
        if (g != built_g) { __syncthreads();
            for (int i = tid; i < 8 * TS_N; i += NTHR) { const int hh = i >> 8, j = i & 255; const int dist = TS_RC - j; tabS[i] = (dist >= 0 && dist < 128) ? biasD[dist * 16 + 8 * g + hh] : NEG_BIG; }
            built_g = g; __syncthreads(); }
        const LAS float* tab = tabS + w * TS_N;
        const bf16_t* rowb = QKV + (size_t)b * SEQ * AQKV;
        bf16x8 qf[4];
#pragma unroll
        for (int ks = 0; ks < 4; ++ks) qf[ks] = *(const bf16x8*)(rowb + (size_t)t * AQKV + h * 64 + 16 * ks + 8 * hi);
        f32x16 o0 = {}, o1 = {}; float m = -1e20f, l = 0.f;
        const int kt_lo = cur - 2 > 0 ? cur - 2 : 0;
        u32x4 kr, vr;
        { const TileSrc s{rowb + (size_t)(64 * kt_lo) * AQKV + 1024 + g * 64, rowb + (size_t)(64 * kt_lo) * AQKV + 1152 + g * 64, AQKV}; tile_load(s, tid, kr, vr); }
        tile_store(kvb, tid, kr, vr);
        __syncthreads();
        int bufi = 0;
        for (int kt = kt_lo; kt <= cur; ++kt) {
            const bool has_n = kt < cur;
            if (has_n) { const TileSrc s{rowb + (size_t)(64 * (kt + 1)) * AQKV + 1024 + g * 64, rowb + (size_t)(64 * (kt + 1)) * AQKV + 1152 + g * 64, AQKV}; tile_load(s, tid, kr, vr); }
            tile_step(kvb + bufi * BUFB, qf, koff, voff, tab + (64 * kt - t + TS_RC + 4 * hi), m, l, o0, o1);
            if (has_n) tile_store(kvb + (bufi ^ 1) * BUFB, tid, kr, vr);
            __syncthreads();
            bufi ^= 1;
        }
        { const float lt = hswap_sum(l); const float sk = sinks[h]; const float mf = fmaxf(m, sk); const float al = __expf(m - mf); const float inv = al / (lt * al + __expf(sk - mf));
#pragma unroll
          for (int r = 0; r < 16; ++r) { o0[r] *= inv; o1[r] *= inv; }
          store_o(O + (size_t)(b * SEQ + t) * DM + h * 64, hi, o0, o1); }
    }
}

__device__ __forceinline__ void nsa_phase(Frame& F, const bf16_t* P, const bf16_t* KC, const bf16_t* VC, const float* biasD, const float* gates, bf16_t* O) {
    LAS unsigned char* kvb = F.lds + L_KV; LAS float* tabC = (LAS float*)(F.lds + L_TC); LAS float* tabW = (LAS float*)(F.lds + L_TW);
    LAS float* stg = (LAS float*)(F.lds + L_KV);
    LAS float* scl = (LAS float*)(F.lds + L_SC);
    LAS unsigned* selm = (LAS unsigned*)(F.lds + L_SELM);
    const int lane = F.lane, r32 = lane & 31, hi = lane >> 5, w = F.wave, tid = F.tid;
    int koff[4], voff[4]; lane_offsets(lane, koff, voff);
    const int vcu = (F.G % 8 == 0) ? (F.bid % 8) * (F.G / 8) + F.bid / 8 : F.bid;
    int built_g = -1;
    for (int it = vcu; it < 1024; it += F.G) {
        int b, g, qt; unit_decode(it, b, g, qt);
        const int t0 = 32 * qt, cur = qt >> 1, h = 8 * g + w, t = t0 + r32;
        if (g != built_g) { __syncthreads();
            for (int i = tid; i < 8 * TC_N; i += NTHR) { const int hh = i / TC_N, j = i - hh * TC_N; tabC[i] = (j <= TC_RC) ? biasD[(TC_RC - j) * 16 + 8 * g + hh] : NEG_BIG; }
            for (int i = tid; i < 8 * TW_N; i += NTHR) { const int hh = i / TW_N, j = i - hh * TW_N; const int dist = TW_RC - j; tabW[i] = (dist >= 0 && dist < 512) ? biasD[dist * 16 + 8 * g + hh] : NEG_BIG; }
            built_g = g; __syncthreads(); }
        const LAS float* tc = tabC + w * TC_N; const LAS float* tw = tabW + w * TW_N;
        const bf16_t* rowb = P + (size_t)b * SEQ * PROJW;
        const size_t mrow = (size_t)(b * SEQ + t);
        bf16x8 qf[4];
#pragma unroll
        for (int ks = 0; ks < 4; ++ks) qf[ks] = *(const bf16x8*)(rowb + (size_t)t * PROJW + h * 64 + 16 * ks + 8 * hi);
        const float g0 = gates[mrow * 48 + h * 3 + 0], g1 = gates[mrow * 48 + h * 3 + 1], g2 = gates[mrow * 48 + h * 3 + 2];
        f32x16 f0, f1;
        {
            const bf16_t* kc = KC + (size_t)(b * 2 + g) * 128 * 64; const bf16_t* vc = VC + (size_t)(b * 2 + g) * 128 * 64;
            u32x4 kr, vr;
            { const TileSrc s{kc, vc, 64}; tile_load(s, tid, kr, vr); tile_store(kvb, tid, kr, vr); }
            { const TileSrc s{kc + 64 * 64, vc + 64 * 64, 64}; tile_load(s, tid, kr, vr); tile_store(kvb + BUFB, tid, kr, vr); }
            __syncthreads();
            f32x16 s00, s01, s10, s11;
            qk_tile(kvb, qf, koff, s00, s01); qk_tile(kvb + BUFB, qf, koff, s10, s11);
            const int e0 = TC_RC - (t - 31 - 64 * hi);
#define CMP_BIAS(S, KT, KB) _Pragma("unroll") for (int r = 0; r < 16; ++r) { int idx = e0 + 16 * (64 * (KT) + 32 * (KB) + (r & 3) + 8 * (r >> 2)); idx = idx < 2048 ? idx : 2048; S[r] += tc[idx]; }
            CMP_BIAS(s00, 0, 0) CMP_BIAS(s01, 0, 1) CMP_BIAS(s10, 1, 0) CMP_BIAS(s11, 1, 1)
#undef CMP_BIAS
            float mx = -1e20f;
#pragma unroll
            for (int r = 0; r < 16; ++r) mx = fmaxf(fmaxf(mx, fmaxf(s00[r], s01[r])), fmaxf(s10[r], s11[r]));
            mx = hswap_max(mx);
            const float c = -mx * LOG2E; float ls = 0.f;
#pragma unroll
            for (int r = 0; r < 16; ++r) { s00[r] = __builtin_amdgcn_exp2f(__builtin_fmaf(s00[r], LOG2E, c)); s01[r] = __builtin_amdgcn_exp2f(__builtin_fmaf(s01[r], LOG2E, c));
                s10[r] = __builtin_amdgcn_exp2f(__builtin_fmaf(s10[r], LOG2E, c)); s11[r] = __builtin_amdgcn_exp2f(__builtin_fmaf(s11[r], LOG2E, c)); ls += (s00[r] + s01[r]) + (s10[r] + s11[r]); }
            ls = hswap_sum(ls); const float inv = ls > 0.f ? 1.0f / ls : 0.f;
#pragma unroll
            for (int r = 0; r < 16; ++r) { s00[r] *= inv; s01[r] *= inv; s10[r] *= inv; s11[r] *= inv; }
            float gs[16], xl[16];
#pragma unroll
            for (int rg = 0; rg < 4; ++rg) {
                gs[0 + rg] = (s00[4 * rg] + s00[4 * rg + 1]) + (s00[4 * rg + 2] + s00[4 * rg + 3]); xl[0 + rg] = s00[4 * rg + 3];
                gs[4 + rg] = (s01[4 * rg] + s01[4 * rg + 1]) + (s01[4 * rg + 2] + s01[4 * rg + 3]); xl[4 + rg] = s01[4 * rg + 3];
                gs[8 + rg] = (s10[4 * rg] + s10[4 * rg + 1]) + (s10[4 * rg + 2] + s10[4 * rg + 3]); xl[8 + rg] = s10[4 * rg + 3];
                gs[12 + rg] = (s11[4 * rg] + s11[4 * rg + 1]) + (s11[4 * rg + 2] + s11[4 * rg + 3]); xl[12 + rg] = s11[4 * rg + 3]; }
            float rv[16];
#pragma unroll
            for (int n = 0; n < 16; ++n) rv[n] = __shfl_xor(xl[n], 32);
#pragma unroll
            for (int n = 0; n < 16; ++n) { const float prev_lo = (n > 0) ? rv[n > 0 ? n - 1 : 0] : 0.f; gs[n] += hi ? rv[n] : prev_lo; }
            f0 = (f32x16){}; f1 = (f32x16){};
            pv_tile(kvb, voff, s00, s01, f0, f1); pv_tile(kvb + BUFB, voff, s10, s11, f0, f1);
#pragma unroll
            for (int r = 0; r < 16; ++r) { f0[r] *= g0; f1[r] *= g0; }
            __syncthreads();
#pragma unroll
            for (int n = 0; n < 16; ++n) stg[(w * 32 + r32) * 32 + 2 * n + hi] = gs[n];
            __syncthreads();
#pragma unroll
            for (int ps = 0; ps < 2; ++ps) { const int q = (tid >> 5) + 16 * ps, j = tid & 31; float imp = 0.f;
#pragma unroll
                for (int ww = 0; ww < 8; ++ww) imp += stg[(ww * 32 + q) * 32 + j];
                const bool forced = (j == 0) || (cur - j >= 0 && cur - j < 2);
                scl[q * 32 + j] = forced ? 1e6f : (j <= cur ? imp : -1.0f); }
            __syncthreads();
#pragma unroll
            for (int ps = 0; ps < 2; ++ps) { const int q = (tid >> 5) + 16 * ps, j = tid & 31; const float mine = scl[q * 32 + j]; int rank = 0;
                for (int k = 0; k < 32; ++k) { const float ov = scl[q * 32 + k]; rank += (ov > mine || (ov == mine && k < j)) ? 1 : 0; }
                const unsigned long long bal = __ballot(rank < 16);
                if (lane == 0) { selm[2 * w + 16 * ps] = (unsigned)bal; selm[2 * w + 1 + 16 * ps] = (unsigned)(bal >> 32); } }
            __syncthreads();
        }
        const unsigned mymask = selm[r32];
        unsigned un = mymask;
#pragma unroll
        for (int o = 1; o < 32; o <<= 1) un |= (unsigned)__shfl_xor((int)un, o);
        un = (unsigned)__builtin_amdgcn_readfirstlane((int)un);
        unsigned rem = un & ((cur >= 31) ? 0xffffffffu : ((2u << cur) - 1u));
        int wk = cur - 8 > 0 ? cur - 8 : 0;
        const bf16_t* ksel = rowb + 1024 + 2 * 128 + g * 64; const bf16_t* vsel = rowb + 1024 + 3 * 128 + g * 64;
        const bf16_t* kwin = rowb + 1024 + 4 * 128 + g * 64; const bf16_t* vwin = rowb + 1024 + 5 * 128 + g * 64;
        int n_br, n_kt; bool has_n;
#define NEXT_TILE() do { if (rem) { n_kt = __builtin_ctz(rem); rem &= rem - 1u; n_br = 1; has_n = true; } else if (wk <= cur) { n_kt = wk++; n_br = 2; has_n = true; } else has_n = false; } while (0)
#define LOAD_NEXT() do { const TileSrc s_{(n_br == 1 ? ksel : kwin) + (size_t)(64 * n_kt) * PROJW, (n_br == 1 ? vsel : vwin) + (size_t)(64 * n_kt) * PROJW, PROJW}; tile_load(s_, tid, kr, vr); } while (0)
        u32x4 kr, vr;
        NEXT_TILE();
        LOAD_NEXT(); tile_store(kvb, tid, kr, vr);
        __syncthreads();
        int c_br = n_br, c_kt = n_kt, bufi = 0;
        f32x16 o0 = {}, o1 = {}; float m = -1e20f, l = 0.f; bool switched = false;
        for (;;) {
            NEXT_TILE();
            if (has_n) LOAD_NEXT();
            if (c_br == 2 && !switched) {
                const float lt = hswap_sum(l); const float inv = (lt > 0.f ? 1.0f / lt : 0.f) * g1;
#pragma unroll
                for (int r = 0; r < 16; ++r) { f0[r] += o0[r] * inv; f1[r] += o1[r] * inv; o0[r] = 0.f; o1[r] = 0.f; }
                m = -1e20f; l = 0.f; switched = true; }
            const LAS float* tp;
            if (c_br == 1) { const bool sel = (mymask >> c_kt) & 1u; tp = tc + (sel ? (64 * c_kt - t + TC_RC + 4 * hi) : 2048); }
            else tp = tw + (64 * c_kt - t + TW_RC + 4 * hi);
            tile_step(kvb + bufi * BUFB, qf, koff, voff, tp, m, l, o0, o1);
            if (!has_n) break;
            tile_store(kvb + (bufi ^ 1) * BUFB, tid, kr, vr);
            __syncthreads();
            c_br = n_br; c_kt = n_kt; bufi ^= 1;
        }
#undef NEXT_TILE
#undef LOAD_NEXT
        { const float lt = hswap_sum(l); const float inv = (lt > 0.f ? 1.0f / lt : 0.f) * (switched ? g2 : g1);
#pragma unroll
          for (int r = 0; r < 16; ++r) { f0[r] += o0[r] * inv; f1[r] += o1[r] * inv; }
          store_o(O + mrow * DM + h * 64, hi, f0, f1); }
        __syncthreads();
    }
}
}

template <class Epi> __device__ __forceinline__ void gemm_fast(Frame& F, const bf16_t* A, const bf16_t* Bt, int N, int K, const Epi& E) {
    pg8::Gemm g{A, Bt, M, N, K}; pg8::StaticOrder S; S.init(M, N, F.G, F.bid);
    pg8::gemm_phase<Epi, pg8::StaticOrder, true, true>(F.lds, g, S, E);
}
constexpr int NPHASES = 17;
__global__ void __launch_bounds__(NTHR, 2) trunk_fwd(Args args) {
    extern __shared__ __attribute__((aligned(16))) unsigned char lds[];
    Frame F;
    F.lds = (LAS unsigned char*)lds;
    F.tid = threadIdx.x; F.lane = F.tid & 63; F.wave = __builtin_amdgcn_readfirstlane(F.tid >> 6);
    F.G = gridDim.x; F.bid = blockIdx.x; F.gw = F.bid * NWAVES + F.wave; F.ngw = F.G * NWAVES;
#pragma unroll
    for (int i = 0; i < 17; ++i) F.in[i] = args.in[i];
    F.out = args.out; F.ws = args.ws;
    unsigned char* ws = args.ws;
    volatile LAS unsigned* MISC = (volatile LAS unsigned*)(F.lds + MISC_OFF);
    if (F.tid < 32) MISC[F.tid] = 0u;
    __syncthreads();
    unsigned* barw = (unsigned*)(ws + WS_CTL) + CW_BAR + args.li * XCD_BAR_WORDS;
    XcdBarrier bar; bar.bar = barw; bar.x = 0; bar.st = nullptr;
    const int lo = args.ph_lo, hi = args.ph_hi;
    if (hi - lo > 1) bar = xcd_barrier_post(barw, MISC + 8);
#define IN(k) (lo <= (k) && (k) < hi)
#define SEAM(k) do { if (IN(k) && IN((k) + 1)) xcd_barrier(bar); } while (0)

    bf16_t* XA = (bf16_t*)(ws + WS_XA); bf16_t* QKV = (bf16_t*)(ws + WS_QKV); bf16_t* Ob = (bf16_t*)(ws + WS_O); bf16_t* HID = (bf16_t*)(ws + WS_HID);
    float* Hres = F.out; float* Ocomb = (float*)(ws + WS_OCOMB); float* gates = (float*)(ws + WS_GATES);
    const float* biasD = (const float*)(ws + WS_BIASD);

#define PHASE(k, BODY) if (IN(k)) { const int reps_ = ((k) == REPEAT_PHASE) ? 1 + REPEAT_N : 1; for (int rep_ = 0; rep_ < reps_; ++rep_) { BODY; if (rep_ + 1 < reps_) xcd_barrier(bar); } }
    PHASE(0, { p0_prologue(F); }) SEAM(0);
    PHASE(1, { if (FAST_GEMM) gemm_fast(F, XA, (const bf16_t*)(ws + WS_WQKVA), AQKV, DM, pg8::EpiQkvF{QKV, F.in[6]}); else gemm_simple<false>(F, XA, DM, (const bf16_t*)(ws + WS_WQKVA), DM, AQKV / 64, EpiQkvA{QKV, F.in[6]}); }) SEAM(1);
    PHASE(2, { if (FAST_ATTN & 1) fa::swa_phase(F, QKV, biasD, F.in[7], Ob); else attn_simple<0>(F, QKV, AQKV, KVsrc{QKV, AQKV, 1024, 1152}, biasD, F.in[7], nullptr, nullptr, nullptr, Ob); }) SEAM(2);
    PHASE(3, { if (FAST_GEMM) gemm_fast(F, Ob, (const bf16_t*)(ws + WS_WOA), DM, DM, pg8::EpiResidF{F.in[0], Hres, F.in[9]}); else gemm_simple<false>(F, Ob, DM, (const bf16_t*)(ws + WS_WOA), DM, DM / 64, EpiResid{F.in[0], Hres, F.in[9]}); }) SEAM(3);
    PHASE(4, { norm_phase(F, Hres, F.in[3], XA); }) SEAM(4);
    PHASE(5, { if (FAST_GEMM) gemm_fast(F, XA, (const bf16_t*)(ws + WS_WGU), 2 * DFF, DM, pg8::EpiSwigluF{HID}); else gemm_simple<true>(F, XA, DM, (const bf16_t*)(ws + WS_WGU), DM, DFF / 32, EpiSwiglu{HID}); }) SEAM(5);
    PHASE(6, { if (FAST_GEMM) gemm_fast(F, HID, (const bf16_t*)(ws + WS_WDN), DM, DFF, pg8::EpiResidF{Hres, Hres, nullptr}); else gemm_simple<false>(F, HID, DFF, (const bf16_t*)(ws + WS_WDN), DFF, DM / 64, EpiResid{Hres, Hres, nullptr}); }) SEAM(6);
    PHASE(7, { norm_phase(F, Hres, F.in[2] + DM, XA); }) SEAM(7);
    PHASE(8, { if (FAST_GEMM) gemm_fast(F, XA, (const bf16_t*)(ws + WS_WIN), BINP, DM, pg8::EpiWinF{QKV, gates}); else gemm_simple<false>(F, XA, DM, (const bf16_t*)(ws + WS_WIN), DM, (BIN + 63) / 64, EpiWin{QKV, gates}); }) SEAM(8);
    PHASE(9, { if (FAST_CMPR) compress_fast(F); else compress_simple(F); }) SEAM(9);
    PHASE(10, { if (!(FAST_ATTN & 2)) cmp_simple(F); }) SEAM(10);
    PHASE(11, { if (FAST_ATTN & 2) fa::nsa_phase(F, QKV, (const bf16_t*)(ws + WS_KCVC), (const bf16_t*)(ws + WS_KCVC) + (size_t)BATCH * 2 * 128 * 64, biasD, gates, Ob); else { attn_simple<1>(F, QKV, PROJW, KVsrc{QKV, PROJW, 1024 + 2 * 128, 1024 + 3 * 128}, biasD, nullptr, gates, (const unsigned*)(ws + WS_SELM), Ocomb, Ob);
                  attn_simple<2>(F, QKV, PROJW, KVsrc{QKV, PROJW, 1024 + 4 * 128, 1024 + 5 * 128}, biasD, nullptr, gates, nullptr, Ocomb, Ob); } }) SEAM(11);
    PHASE(12, { if (FAST_GEMM) gemm_fast(F, Ob, (const bf16_t*)(ws + WS_WOB), DM, DM, pg8::EpiResidF{Hres, Hres, nullptr}); else gemm_simple<false>(F, Ob, DM, (const bf16_t*)(ws + WS_WOB), DM, DM / 64, EpiResid{Hres, Hres, nullptr}); }) SEAM(12);
    PHASE(13, { norm_phase(F, Hres, F.in[3] + DM, XA); }) SEAM(13);
    PHASE(14, { if (FAST_GEMM) gemm_fast(F, XA, (const bf16_t*)(ws + WS_WGU) + (size_t)2 * DFF * DM, 2 * DFF, DM, pg8::EpiSwigluF{HID}); else gemm_simple<true>(F, XA, DM, (const bf16_t*)(ws + WS_WGU) + (size_t)2 * DFF * DM, DM, DFF / 32, EpiSwiglu{HID}); }) SEAM(14);
    PHASE(15, { if (FAST_GEMM) gemm_fast(F, HID, (const bf16_t*)(ws + WS_WDN) + (size_t)DM * DFF, DM, DFF, pg8::EpiResidF{Hres, Hres, nullptr}); else gemm_simple<false>(F, HID, DFF, (const bf16_t*)(ws + WS_WDN) + (size_t)DM * DFF, DFF, DM / 64, EpiResid{Hres, Hres, nullptr}); }) SEAM(15);
    PHASE(16, { final_norm_phase(F, Hres, F.in[4]); })
#undef IN
#undef SEAM
#undef PHASE
}

extern "C" void kernel_launch(void* const* d_in, const int* in_sizes, int n_in, void* d_out, int out_size, void* d_ws, size_t ws_size, hipStream_t stream) {
    static int grid = 0;
    if (grid == 0) {
        if (n_in != 17 || out_size != M * DM || ws_size < WS_END) { fprintf(stderr, "kernel_launch: unexpected shapes (n_in %d out %d ws %zu)\n", n_in, out_size, ws_size); grid = -1; return; }
        int dev = 0, cus = 0, per_cu = 0;
        (void)hipGetDevice(&dev); (void)hipDeviceGetAttribute(&cus, hipDeviceAttributeMultiprocessorCount, dev);
        (void)hipFuncSetAttribute((const void*)trunk_fwd, hipFuncAttributeMaxDynamicSharedMemorySize, LDS_BYTES);
        (void)hipOccupancyMaxActiveBlocksPerMultiprocessor(&per_cu, (const void*)trunk_fwd, NTHR, LDS_BYTES);
        (void)hipGetLastError();
        if (per_cu < 1) fprintf(stderr, "kernel_launch: occupancy query says %d blocks per CU\n", per_cu);
        grid = cus > 0 ? cus : 256;
    }
    if (grid < 0) return;
    (void)hipMemsetAsync((char*)d_ws + WS_CTL, 0, CTL_ZERO_BYTES, stream);
    Args a{};
    for (int i = 0; i < 17; ++i) a.in[i] = (const float*)d_in[i];
    a.out = (float*)d_out; a.ws = (unsigned char*)d_ws;
#if MK_ONE_LAUNCH
    a.ph_lo = 0; a.ph_hi = NPHASES; a.li = 0;
    void* kargs[] = {&a};
    hipError_t e = hipLaunchCooperativeKernel((const void*)trunk_fwd, dim3(grid), dim3(NTHR), kargs, LDS_BYTES, stream);
    if (e != hipSuccess) fprintf(stderr, "cooperative launch failed: %s\n", hipGetErrorString(e));
#else
    for (int p = 0; p < NPHASES; ++p) { a.ph_lo = p; a.ph_hi = p + 1; a.li = 0;
        hipLaunchKernelGGL(trunk_fwd, dim3(grid), dim3(NTHR), LDS_BYTES, stream, a); }
#endif
}
```

```cpp
#include <hip/hip_runtime.h>
#include <cstdio>
#include <cstdint>

#ifndef REPEAT_PHASE
#define REPEAT_PHASE -1
#endif
#ifndef REPEAT_N
#define REPEAT_N 2
#endif
#ifndef FUSE_NORM
#define FUSE_NORM 1
#endif
#ifndef FAST_CMPR
#define FAST_CMPR 1
#endif
#ifndef FAST_ATTN
#define FAST_ATTN 3
#endif
#ifndef FAST_GEMM
#define FAST_GEMM 1
#endif
#ifndef MK_ONE_LAUNCH
#define MK_ONE_LAUNCH 1
#endif

#define GAS __attribute__((address_space(1)))
#define LAS __attribute__((address_space(3)))
typedef unsigned short bf16_t;
typedef short bf16x8 __attribute__((ext_vector_type(8)));
typedef float f32x4 __attribute__((ext_vector_type(4)));
typedef float f32x16 __attribute__((ext_vector_type(16)));
typedef unsigned u32x4 __attribute__((ext_vector_type(4)));
typedef unsigned u32x2 __attribute__((ext_vector_type(2)));

constexpr int BATCH = 8, SEQ = 2048, DM = 1024, NH = 16, HD = 64, M = BATCH * SEQ;
constexpr int AQKV = 1280;
constexpr int BIN = 1840;
constexpr int BINP = 2048;
constexpr int PROJW = 1792;
constexpr int DFF = 2816;
constexpr int NC = 127;
constexpr int NSEL = 32;
constexpr int NWAVES = 8, NTHR = 512;
constexpr float RMS_EPS = 1e-6f;
constexpr float NEG_BIG = -1e30f;

constexpr size_t MiB = 1u << 20;
constexpr size_t WS_CTL = 0, CTL_ZERO_BYTES = 1 * MiB;
constexpr size_t WS_BIASD = 1 * MiB;
constexpr size_t WS_C1 = WS_BIASD + 128 * 1024;
constexpr size_t WS_KCVC = WS_C1 + 4096;
constexpr size_t WS_SELM = WS_KCVC + 512 * 1024;
constexpr size_t WS_SS = 3 * MiB;
constexpr size_t WS_GATES = 4 * MiB;
constexpr size_t WS_WQKVA = 8 * MiB;
constexpr size_t WS_WOA = WS_WQKVA + 3 * MiB;
constexpr size_t WS_WIN = WS_WOA + 2 * MiB;
constexpr size_t WS_WOB = WS_WIN + 4 * MiB;
constexpr size_t WS_WGU = WS_WOB + 2 * MiB;
constexpr size_t WS_WDN = WS_WGU + 22 * MiB;
constexpr size_t WS_CW1 = WS_WDN + 11 * MiB;
constexpr size_t WS_CW2 = WS_CW1 + 2 * MiB;
constexpr size_t WS_XA = 56 * MiB;
constexpr size_t WS_QKV = 88 * MiB;
constexpr size_t WS_O = 144 * MiB;
constexpr size_t WS_HID = WS_QKV;
constexpr size_t WS_OCOMB = 176 * MiB;
constexpr size_t WS_END = 240 * MiB;
static_assert(WS_CW2 + 64 * 1024 <= WS_XA, "weights fit");
static_assert(WS_SELM + 128 * 1024 <= WS_GATES, "small region");
constexpr int CW_BAR = 4096;

constexpr int LDS_MAIN = 147456;
constexpr int MISC_OFF = LDS_MAIN;
constexpr int LDS_BYTES = LDS_MAIN + 128;

#define RLX_AGENT __ATOMIC_RELAXED, __HIP_MEMORY_SCOPE_AGENT
__device__ __forceinline__ unsigned f2bf(float f) { unsigned u = __builtin_bit_cast(unsigned, f); return (u + 0x7fffu + ((u >> 16) & 1u)) >> 16; }
__device__ __forceinline__ unsigned pk2(float lo, float hi) { return f2bf(lo) | (f2bf(hi) << 16); }
__device__ __forceinline__ float bf2f(unsigned short b) { return __builtin_bit_cast(float, (unsigned)b << 16); }
__device__ __forceinline__ float bflo(unsigned w) { return __builtin_bit_cast(float, w << 16); }
__device__ __forceinline__ float bfhi(unsigned w) { return __builtin_bit_cast(float, w & 0xffff0000u); }
__device__ __forceinline__ float wave_sum(float v) {
#pragma unroll
    for (int o = 1; o < 64; o <<= 1) v += __shfl_xor(v, o);
    return v;
}
__device__ __forceinline__ float wave_max(float v) {
#pragma unroll
    for (int o = 1; o < 64; o <<= 1) v = fmaxf(v, __shfl_xor(v, o));
    return v;
}

#define XB_TMO      128
#define XB_XCNT(j)  (256  + 64 * (j))
#define XB_XSUB(j)  (1280 + 64 * (j))
#define XB_XGEN(j)  (2304 + 64 * (j))
#define XB_TOP      3328
#define XB_TOPGEN   3392
#define XCD_BAR_WORDS 3456
#define XB_SPIN_CAP (1u << 25)
__device__ __forceinline__ unsigned xb_ld(unsigned* p)              { return __hip_atomic_load(p, __ATOMIC_RELAXED, __HIP_MEMORY_SCOPE_AGENT); }
__device__ __forceinline__ unsigned xb_add(unsigned* p, unsigned v) { return __hip_atomic_fetch_add(p, v, __ATOMIC_RELAXED, __HIP_MEMORY_SCOPE_AGENT); }
__device__ __forceinline__ unsigned xb_xcc_id() { return (unsigned)__builtin_amdgcn_s_getreg((3 << 11) | 20) & 0xFu; }
#define XB_SPIN(cond, bar) do { unsigned _sp = 0; while (cond) { __builtin_amdgcn_s_sleep(1); \
    if ((++_sp & 255u) == 0u) { if (xb_ld(&(bar)[XB_TMO])) break; if (_sp > XB_SPIN_CAP) { atomicAdd(&(bar)[XB_TMO], 1u); break; } } } } while (0)
struct XcdBarrier { unsigned* bar; unsigned x; volatile LAS unsigned* st; };
__device__ __forceinline__ XcdBarrier xcd_barrier_post(unsigned* bar, volatile LAS unsigned* st) {
    XcdBarrier b; b.bar = bar; b.x = xb_xcc_id(); b.st = st;
    if (threadIdx.x == 0) (void)xb_add(&bar[XB_XCNT(b.x)], 1u);
    return b;
}
__device__ __forceinline__ void xcd_barrier_complete(unsigned* bar, unsigned x, unsigned& nloc, unsigned& nx) {
    const unsigned G = gridDim.x * gridDim.y * gridDim.z;
    unsigned sum, cnt, mine, sp = 0u;
    for (;;) {
        sum = 0u; cnt = 0u; mine = 0u;
#pragma unroll
        for (unsigned j = 0; j < 16; ++j) { const unsigned c = xb_ld(&bar[XB_XCNT(j)]); sum += c; cnt += (c > 0u) ? 1u : 0u; mine = (j == x) ? c : mine; }
        if (sum == G) break;
        __builtin_amdgcn_s_sleep(1);
        if ((++sp & 255u) == 0u) { if (xb_ld(&bar[XB_TMO])) break; if (sp > XB_SPIN_CAP) { atomicAdd(&bar[XB_TMO], 1u); break; } }
    }
    nloc = mine > 0u ? mine : 1u; nx = cnt > 0u ? cnt : 1u;
}
__device__ __forceinline__ void xcd_barrier(const XcdBarrier& b) {
    asm volatile("s_waitcnt vmcnt(0)" ::: "memory");
    __syncthreads();
    if (threadIdx.x == 0) {
        unsigned* bar = b.bar;
        __builtin_amdgcn_s_waitcnt(0);
        unsigned nloc = b.st[0], nx = b.st[1];
        if (nloc == 0u) { xcd_barrier_complete(bar, b.x, nloc, nx); b.st[0] = nloc; b.st[1] = nx; }
        const unsigned old = xb_add(&bar[XB_XSUB(b.x)], 1u);
        const unsigned gen = old / nloc;
        if (old + 1u == (gen + 1u) * nloc) {
            __builtin_amdgcn_fence(__ATOMIC_RELEASE, "agent");
            asm volatile("s_waitcnt vmcnt(0)" ::: "memory");
            const unsigned og = xb_add(&bar[XB_TOP], 1u);
            const unsigned tg = og / nx;
            if (og + 1u == (tg + 1u) * nx) xb_add(&bar[XB_TOPGEN], 1u);
            else XB_SPIN(xb_ld(&bar[XB_TOPGEN]) == tg, bar);
            __builtin_amdgcn_fence(__ATOMIC_ACQUIRE, "agent");
            xb_add(&bar[XB_XGEN(b.x)], 1u);
            asm volatile("s_waitcnt vmcnt(0)" ::: "memory");
        } else {
            XB_SPIN(xb_ld(&bar[XB_XGEN(b.x)]) == gen, bar);
            __builtin_amdgcn_fence(__ATOMIC_ACQUIRE, "agent");
            asm volatile("s_waitcnt vmcnt(0)" ::: "memory");
        }
    }
    __syncthreads();
}

namespace pg8 {
#define PG8_LAS __attribute__((address_space(3)))
typedef unsigned short bf16_t;
typedef short bf16x8 __attribute__((ext_vector_type(8)));
typedef float f32x4 __attribute__((ext_vector_type(4)));
typedef unsigned u32x4 __attribute__((ext_vector_type(4)));
constexpr int BM = 256, BK = 64, HALF = 128, HTB = HALF * BK * 2  , STAGE_BYTES = 8 * HTB, NXCD = 8, WGM = 8;

__host__ __device__ __forceinline__ int lds_byte(int r, int c) { const int st = (r >> 4) * 2 + (c >> 5), rr = r & 15, cc = c & 31, ob = rr * 64 + cc * 2; return st * 1024 + (ob ^ (((ob >> 9) & 1) << 5)); }
__host__ __device__ __forceinline__ void stage_rc(int b, int& R, int& C) { const int st = b / 1024, sb = b % 1024, swz = sb ^ (((sb >> 9) & 1) << 5); R = (st >> 1) * 16 + swz / 64; C = (st & 1) * 32 + (swz % 64) / 2; }
__host__ __device__ __forceinline__ int perm32(int rho) { const int n = rho >> 4, i = rho & 15; return 8 * (i >> 2) + 4 * n + (i & 3); }

struct Unit { int pm, pn; };
struct Gemm { const bf16_t* A; const bf16_t* Bt; int M, N, K; };

struct StaticOrder {
    int nM, nN, nwg, G, c;
    __host__ __device__ void init(int M, int N, int G_, int c_) { nM = M / BM; nN = N / BM; nwg = nM * nN; G = G_; c = c_; }
    __host__ __device__ bool next(int i, Unit& u) const {
        const long L = (long)i * G + c; if (L >= nwg) return false;
        int wgid = (int)L; { const int q = nwg / NXCD, r = nwg % NXCD, xcd = wgid % NXCD, off = wgid / NXCD; wgid = (xcd < r ? xcd * (q + 1) : r * (q + 1) + (xcd - r) * q) + off; }
        const int nig = WGM * nN, gid = wgid / nig, fm = gid * WGM, gsz = (nM - fm) < WGM ? (nM - fm) : WGM;
        u.pm = fm + ((wgid % nig) % gsz); u.pn = (wgid % nig) / gsz; return true;
    }
    __device__ __forceinline__ void a_ready(const Unit&) const {}
    __device__ __forceinline__ void done(const Unit&) const {}
};

__device__ __forceinline__ unsigned cvt_pk_bf16(float lo, float hi) { unsigned r; asm volatile("v_cvt_pk_bf16_f32 %0, %1, %2" : "=v"(r) : "v"(lo), "v"(hi)); return r; }
template <class Epi, class Sched, bool ALIGN_EPI = false, bool SP2 = false>
__device__ __forceinline__ void gemm_phase(PG8_LAS unsigned char* lds, const Gemm g, const Sched& S, const Epi& E) {
    const int tid = threadIdx.x, wid = __builtin_amdgcn_readfirstlane(tid >> 6), lane = tid & 63, wr = wid >> 2, wc = wid & 3, fr = lane & 15, fq = lane >> 4;
    const int K = g.K, nt = K / BK;
    unsigned voffA[2], voffB[2];
#pragma unroll
    for (int i = 0; i < 2; ++i) { int R, C; stage_rc(tid * 16 + i * 8192, R, C); const int Rb = Epi::PERM ? ((R & ~31) + perm32(R & 31)) : R;
        voffA[i] = (unsigned)(R * K + C) * 2u; voffB[i] = (unsigned)(Rb * K + C) * 2u; }
    const size_t kstep = (size_t)(BK * 2);
    const size_t hstep = (size_t)HALF * K * 2;
    const size_t tstep = 2 * hstep;
    const unsigned ldsw = (unsigned)wid * 1024u;
    const int aoff = lds_byte(wr * 64 + fr, fq * 8), boff = lds_byte(wc * 32 + fr, fq * 8);
#define PG8_SA(b, h) (((b) * 2 + (h)) * HTB)
#define PG8_SB(b, h) ((4 + (b) * 2 + (h)) * HTB)
#define PG8_STAGE(bufoff, gbase, voff) do { _Pragma("unroll") for (int _i = 0; _i < 2; ++_i) \
        __builtin_amdgcn_global_load_lds((const unsigned*)((const char*)(gbase) + (voff)[_i]), (PG8_LAS unsigned*)(lds + (bufoff) + ldsw + _i * 8192), 16, 0, 0); } while (0)
#define PG8_LDA(dst, b, h) do { _Pragma("unroll") for (int m = 0; m < 4; ++m) _Pragma("unroll") for (int k = 0; k < 2; ++k) dst[m][k] = *(const PG8_LAS bf16x8*)(lds + PG8_SA(b, h) + aoff + m * 2048 + k * 1024); } while (0)
#define PG8_LDB(dst, b, h) do { _Pragma("unroll") for (int n = 0; n < 2; ++n) _Pragma("unroll") for (int k = 0; k < 2; ++k) dst[n][k] = *(const PG8_LAS bf16x8*)(lds + PG8_SB(b, h) + boff + n * 2048 + k * 1024); } while (0)
#define PG8_MMA(ai, bj, At, Bt) do { __builtin_amdgcn_s_setprio(1); _Pragma("unroll") for (int m = 0; m < 4; ++m) _Pragma("unroll") for (int n = 0; n < 2; ++n) _Pragma("unroll") for (int k = 0; k < 2; ++k) \
        acc[ai][bj][m][n] = __builtin_amdgcn_mfma_f32_16x16x32_bf16(Bt[n][k], At[m][k], acc[ai][bj][m][n], 0, 0, 0); __builtin_amdgcn_s_setprio(0); } while (0)
#define PG8_WAIT_V(n) asm volatile("s_waitcnt vmcnt(" #n ")" ::: "memory")
#define PG8_WAIT_L(n) asm volatile("s_waitcnt lgkmcnt(" #n ")" ::: "memory")
#define PG8_BAR __builtin_amdgcn_s_barrier()
#define PG8_SCHED __builtin_amdgcn_sched_barrier(0)
    Unit cur, nxt; int ui = 0;
    if (!S.next(0, cur)) return;
    f32x4 acc[2][2][4][2];
#pragma unroll
    for (int a = 0; a < 2; ++a)
#pragma unroll
        for (int b = 0; b < 2; ++b)
#pragma unroll
            for (int m = 0; m < 4; ++m)
#pragma unroll
                for (int n = 0; n < 2; ++n) acc[a][b][m][n] = (f32x4){0.f, 0.f, 0.f, 0.f};
    bf16x8 At[4][2], B0[2][2], B1[2][2];
    const char* cA = (const char*)g.A + (size_t)cur.pm * tstep; const char* cB = (const char*)g.Bt + (size_t)cur.pn * tstep;
    S.a_ready(cur);
    if constexpr (SP2) {
        PG8_STAGE(PG8_SB(0, 0), cB, voffB); PG8_STAGE(PG8_SB(0, 1), cB + hstep, voffB); PG8_STAGE(PG8_SA(0, 0), cA, voffA); PG8_STAGE(PG8_SA(0, 1), cA + hstep, voffA);
        if (wr == 1) PG8_BAR;
        PG8_WAIT_V(2); PG8_BAR;
        PG8_STAGE(PG8_SB(1, 0), cB + kstep, voffB); PG8_STAGE(PG8_SA(1, 0), cA + kstep, voffA); PG8_STAGE(PG8_SB(1, 1), cB + hstep + kstep, voffB);
        PG8_WAIT_V(6); PG8_BAR;
    } else {
        PG8_STAGE(PG8_SB(0, 0), cB, voffB); PG8_STAGE(PG8_SA(0, 0), cA, voffA); PG8_STAGE(PG8_SB(0, 1), cB + hstep, voffB); PG8_STAGE(PG8_SA(0, 1), cA + hstep, voffA);
        if (wr == 1) PG8_BAR;
        PG8_WAIT_V(4); PG8_BAR;
        PG8_STAGE(PG8_SB(1, 0), cB + kstep, voffB); PG8_STAGE(PG8_SA(1, 0), cA + kstep, voffA); PG8_STAGE(PG8_SB(1, 1), cB + hstep + kstep, voffB);
        PG8_WAIT_V(6); PG8_BAR;
    }
    for (;;) {
        const bool has_next = S.next(ui + 1, nxt);
        const char* nA = has_next ? (const char*)g.A + (size_t)nxt.pm * tstep : cA; const char* nB = has_next ? (const char*)g.Bt + (size_t)nxt.pn * tstep : cB;
        for (int t = 0; t < nt; t += 2) {
            const bool last = (t == nt - 2);
            const char* a1 = cA + (size_t)(t + 1) * kstep;
            const char* a2 = last ? nA : cA + (size_t)(t + 2) * kstep; const char* b2 = last ? nB : cB + (size_t)(t + 2) * kstep;
            const char* a3 = a2 + kstep; const char* b3 = b2 + kstep;
            if (last && has_next) S.a_ready(nxt);
            if constexpr (SP2) {
            PG8_LDB(B0, 0, 0); PG8_LDB(B1, 0, 1); PG8_SCHED; PG8_LDA(At, 0, 0); PG8_STAGE(PG8_SA(1, 1), a1 + hstep, voffA);
            PG8_WAIT_V(8); PG8_WAIT_L(0); PG8_BAR; PG8_MMA(0, 0, At, B0); PG8_MMA(0, 1, At, B1); PG8_BAR; PG8_SCHED;
            PG8_LDA(At, 0, 1); PG8_STAGE(PG8_SB(0, 0), b2, voffB); PG8_STAGE(PG8_SB(0, 1), b2 + hstep, voffB); PG8_STAGE(PG8_SA(0, 0), a2, voffA);
            PG8_WAIT_V(8); PG8_WAIT_L(0); PG8_BAR; PG8_MMA(1, 0, At, B0); PG8_MMA(1, 1, At, B1); PG8_BAR; PG8_SCHED;
            PG8_LDB(B0, 1, 0); PG8_LDB(B1, 1, 1); PG8_SCHED; PG8_LDA(At, 1, 0); PG8_STAGE(PG8_SA(0, 1), a2 + hstep, voffA);
            PG8_WAIT_V(8); PG8_WAIT_L(0); PG8_BAR; PG8_MMA(0, 0, At, B0); PG8_MMA(0, 1, At, B1); PG8_BAR; PG8_SCHED;
            PG8_LDA(At, 1, 1); PG8_STAGE(PG8_SB(1, 0), b3, voffB); PG8_STAGE(PG8_SB(1, 1), b3 + hstep, voffB); PG8_STAGE(PG8_SA(1, 0), a3, voffA);
            PG8_WAIT_V(8); PG8_WAIT_L(0); PG8_BAR; PG8_MMA(1, 0, At, B0); PG8_MMA(1, 1, At, B1); PG8_BAR; PG8_SCHED;
            } else {
            PG8_LDB(B0, 0, 0); PG8_SCHED; PG8_LDA(At, 0, 0); PG8_STAGE(PG8_SA(1, 1), a1 + hstep, voffA);
            PG8_WAIT_L(8); PG8_BAR; PG8_WAIT_L(0); PG8_MMA(0, 0, At, B0); PG8_BAR; PG8_SCHED;
            PG8_LDB(B1, 0, 1); PG8_STAGE(PG8_SB(0, 0), b2, voffB);
            PG8_BAR; PG8_WAIT_L(0); PG8_MMA(0, 1, At, B1); PG8_BAR;
            PG8_LDA(At, 0, 1); PG8_STAGE(PG8_SA(0, 0), a2, voffA);
            PG8_BAR; PG8_WAIT_L(0); PG8_MMA(1, 0, At, B0); PG8_BAR; PG8_SCHED;
            PG8_STAGE(PG8_SB(0, 1), b2 + hstep, voffB);
            PG8_WAIT_V(6); PG8_BAR; PG8_MMA(1, 1, At, B1); PG8_BAR;
            PG8_LDB(B0, 1, 0); PG8_SCHED; PG8_LDA(At, 1, 0); PG8_STAGE(PG8_SA(0, 1), a2 + hstep, voffA);
            PG8_WAIT_L(8); PG8_BAR; PG8_WAIT_L(0); PG8_MMA(0, 0, At, B0); PG8_BAR; PG8_SCHED;
            PG8_LDB(B1, 1, 1); PG8_STAGE(PG8_SB(1, 0), b3, voffB);
            PG8_BAR; PG8_WAIT_L(0); PG8_MMA(0, 1, At, B1); PG8_BAR;
            PG8_LDA(At, 1, 1); PG8_STAGE(PG8_SA(1, 0), a3, voffA);
            PG8_BAR; PG8_WAIT_L(0); PG8_MMA(1, 0, At, B0); PG8_BAR; PG8_SCHED;
            PG8_STAGE(PG8_SB(1, 1), b3 + hstep, voffB);
            PG8_WAIT_V(6); PG8_BAR; PG8_MMA(1, 1, At, B1); PG8_BAR;
            }
        }
        if constexpr (ALIGN_EPI) { if (wr == 0) PG8_BAR; }
        if constexpr (!Epi::AFTER_DRAIN) { E(acc, cur, wr, wc, fr, fq); S.done(cur); }
        if (!has_next) break;
#pragma unroll
        for (int a = 0; a < 2; ++a)
#pragma unroll
            for (int b = 0; b < 2; ++b)
#pragma unroll
                for (int m = 0; m < 4; ++m)
#pragma unroll
                    for (int n = 0; n < 2; ++n) acc[a][b][m][n] = (f32x4){0.f, 0.f, 0.f, 0.f};
        cur = nxt; cA = nA; cB = nB; ++ui;
        if constexpr (ALIGN_EPI) { if (wr == 1) PG8_BAR; }
    }
    PG8_WAIT_V(0);
    if constexpr (!ALIGN_EPI) { if (wr == 0) PG8_BAR; }
    PG8_BAR;
    if constexpr (Epi::AFTER_DRAIN) { E.fused(acc, cur, wr, wc, fr, fq, lds, wid, lane); S.done(cur); }
#undef PG8_SA
#undef PG8_SB
#undef PG8_STAGE
#undef PG8_LDA
#undef PG8_LDB
#undef PG8_MMA
#undef PG8_WAIT_V
#undef PG8_WAIT_L
#undef PG8_BAR
#undef PG8_SCHED
}
}

namespace pg8 {
struct EpiQkvF { static constexpr bool PERM = true, AFTER_DRAIN = false; bf16_t* O; const float* bias;
    __device__ __forceinline__ void operator()(const f32x4 (&acc)[2][2][4][2], const Unit& u, int wr, int wc, int fr, int fq) const {
        const int row0 = u.pm * BM + wr * 64 + fr, col0 = u.pn * BM + wc * 32 + 8 * fq; const float sc = (u.pn < 4) ? 0.125f : 1.0f;
        f32x4 bv[2][2];
#pragma unroll
        for (int bj = 0; bj < 2; ++bj)
#pragma unroll
            for (int n = 0; n < 2; ++n) bv[bj][n] = *(const f32x4*)(bias + col0 + bj * HALF + 4 * n) * sc;
#pragma unroll
        for (int ai = 0; ai < 2; ++ai)
#pragma unroll
            for (int m = 0; m < 4; ++m) { bf16_t* rowp = O + (size_t)(row0 + ai * HALF + m * 16) * 1280 + col0;
#pragma unroll
                for (int bj = 0; bj < 2; ++bj) { const f32x4 v0 = acc[ai][bj][m][0] + bv[bj][0], v1 = acc[ai][bj][m][1] + bv[bj][1];
                    u32x4 w; w.x = cvt_pk_bf16(v0[0], v0[1]); w.y = cvt_pk_bf16(v0[2], v0[3]); w.z = cvt_pk_bf16(v1[0], v1[1]); w.w = cvt_pk_bf16(v1[2], v1[3]);
                    *(u32x4*)(rowp + bj * HALF) = w; } }
    }
};
struct EpiResidF { static constexpr bool PERM = false, AFTER_DRAIN = false; const float* base; float* out; const float* bias;
    __device__ __forceinline__ void operator()(const f32x4 (&acc)[2][2][4][2], const Unit& u, int wr, int wc, int fr, int fq) const {
        const int col0 = u.pn * BM + wc * 32 + 4 * fq;
        f32x4 bv[2][2];
#pragma unroll
        for (int bj = 0; bj < 2; ++bj)
#pragma unroll
            for (int n = 0; n < 2; ++n) bv[bj][n] = bias ? *(const f32x4*)(bias + col0 + bj * HALF + n * 16) : (f32x4){0.f, 0.f, 0.f, 0.f};
#pragma unroll
        for (int ai = 0; ai < 2; ++ai)
#pragma unroll
            for (int m = 0; m < 4; ++m) { const size_t off = (size_t)(u.pm * BM + ai * HALF + wr * 64 + m * 16 + fr) * 1024 + col0;
#pragma unroll
                for (int bj = 0; bj < 2; ++bj)
#pragma unroll
                    for (int n = 0; n < 2; ++n) { const f32x4 bs = *(const f32x4*)(base + off + bj * HALF + n * 16); *(f32x4*)(out + off + bj * HALF + n * 16) = bs + acc[ai][bj][m][n] + bv[bj][n]; }
                if (m & 1) asm volatile("" ::: "memory"); }
    }
};
struct EpiSwigluF { static constexpr bool PERM = true, AFTER_DRAIN = false; bf16_t* O;
    __device__ __forceinline__ float silu_mul(float g, float u) const { return g * __builtin_amdgcn_rcpf(1.0f + __expf(-g)) * u; }
    __device__ __forceinline__ void operator()(const f32x4 (&acc)[2][2][4][2], const Unit& u, int wr, int wc, int fr, int fq) const {
        const int row0 = u.pm * BM + wr * 64 + fr, f0 = u.pn * HALF + wc * 32 + 8 * fq;
#pragma unroll
        for (int ai = 0; ai < 2; ++ai)
#pragma unroll
            for (int m = 0; m < 4; ++m) { const f32x4 g0 = acc[ai][0][m][0], g1 = acc[ai][0][m][1], u0 = acc[ai][1][m][0], u1 = acc[ai][1][m][1];
                u32x4 w; w.x = cvt_pk_bf16(silu_mul(g0[0], u0[0]), silu_mul(g0[1], u0[1])); w.y = cvt_pk_bf16(silu_mul(g0[2], u0[2]), silu_mul(g0[3], u0[3]));
                w.z = cvt_pk_bf16(silu_mul(g1[0], u1[0]), silu_mul(g1[1], u1[1])); w.w = cvt_pk_bf16(silu_mul(g1[2], u1[2]), silu_mul(g1[3], u1[3]));
                *(u32x4*)(O + (size_t)(row0 + ai * HALF + m * 16) * 2816 + f0) = w; }
    }
};
struct EpiWinF { static constexpr bool PERM = true, AFTER_DRAIN = false; bf16_t* P; float* gates;
    __device__ __forceinline__ void operator()(const f32x4 (&acc)[2][2][4][2], const Unit& u, int wr, int wc, int fr, int fq) const {
        const int row0 = u.pm * BM + wr * 64 + fr, col0 = u.pn * BM + wc * 32 + 8 * fq;
        if (u.pn < 7) {
#pragma unroll
            for (int ai = 0; ai < 2; ++ai)
#pragma unroll
                for (int m = 0; m < 4; ++m) { bf16_t* rowp = P + (size_t)(row0 + ai * HALF + m * 16) * 1792 + col0;
#pragma unroll
                    for (int bj = 0; bj < 2; ++bj) { const f32x4 v0 = acc[ai][bj][m][0], v1 = acc[ai][bj][m][1];
                        u32x4 w; w.x = cvt_pk_bf16(v0[0], v0[1]); w.y = cvt_pk_bf16(v0[2], v0[3]); w.z = cvt_pk_bf16(v1[0], v1[1]); w.w = cvt_pk_bf16(v1[2], v1[3]);
                        *(u32x4*)(rowp + bj * HALF) = w; } }
        } else {
            const int gc = wc * 32 + 8 * fq;
            if (gc < 48) {
#pragma unroll
                for (int ai = 0; ai < 2; ++ai)
#pragma unroll
                    for (int m = 0; m < 4; ++m) { float* gp = gates + (size_t)(row0 + ai * HALF + m * 16) * 48 + gc;
#pragma unroll
                        for (int n = 0; n < 2; ++n) { const f32x4 v = acc[ai][0][m][n]; f32x4 s;
#pragma unroll
                            for (int j = 0; j < 4; ++j) s[j] = __builtin_amdgcn_rcpf(1.0f + __expf(-v[j]));
                            *(f32x4*)(gp + 4 * n) = s; } }
            }
        }
    }
};
struct EpiResidNormF { static constexpr bool PERM = false, AFTER_DRAIN = false; const float* base; float* out; const float* bias; const float* gain; bf16_t* xa; float* ss; PG8_LAS float* red;
    __device__ __forceinline__ void operator()(const f32x4 (&acc)[2][2][4][2], const Unit& u, int wr, int wc, int fr, int fq) const {
        const int col0 = u.pn * BM + wc * 32 + 4 * fq;
        f32x4 bv[2][2], gv[2][2];
#pragma unroll
        for (int bj = 0; bj < 2; ++bj)
#pragma unroll
            for (int n = 0; n < 2; ++n) { bv[bj][n] = bias ? *(const f32x4*)(bias + col0 + bj * HALF + n * 16) : (f32x4){0.f, 0.f, 0.f, 0.f}; gv[bj][n] = *(const f32x4*)(gain + col0 + bj * HALF + n * 16); }
#pragma unroll
        for (int ai = 0; ai < 2; ++ai)
#pragma unroll
            for (int m = 0; m < 4; ++m) { const int rl = ai * HALF + wr * 64 + m * 16 + fr; const size_t off = (size_t)(u.pm * BM + rl) * 1024 + col0; float q = 0.f;
#pragma unroll
                for (int bj = 0; bj < 2; ++bj)
#pragma unroll
                    for (int n = 0; n < 2; ++n) { const f32x4 bs = *(const f32x4*)(base + off + bj * HALF + n * 16); const f32x4 o = bs + acc[ai][bj][m][n] + bv[bj][n];
                        *(f32x4*)(out + off + bj * HALF + n * 16) = o; q += (o[0] * o[0] + o[1] * o[1]) + (o[2] * o[2] + o[3] * o[3]);
                        const f32x4 og = o * gv[bj][n]; u32x2 w; w.x = cvt_pk_bf16(og[0], og[1]); w.y = cvt_pk_bf16(og[2], og[3]); *(u32x2*)(xa + off + bj * HALF + n * 16) = w; }
                q += __shfl_xor(q, 16); q += __shfl_xor(q, 32);
                if (fq == 0) red[rl * 4 + wc] = q;
                if (m & 1) asm volatile("" ::: "memory"); }
        asm volatile("s_waitcnt lgkmcnt(0)" ::: "memory"); __builtin_amdgcn_s_barrier(); asm volatile("" ::: "memory");
        { const int tid = threadIdx.x; if (tid < 256) { const f32x4 r4 = *(const PG8_LAS f32x4*)(red + tid * 4); ss[(size_t)(u.pm * BM + tid) * 4 + u.pn] = (r4[0] + r4[1]) + (r4[2] + r4[3]); } }
        asm volatile("s_waitcnt lgkmcnt(0)" ::: "memory"); __builtin_amdgcn_s_barrier(); asm volatile("" ::: "memory");
    }
};
__device__ __forceinline__ float row_rstd(const float* ss, int row) { const f32x4 s4 = *(const f32x4*)(ss + (size_t)row * 4); return 1.0f / sqrtf(((s4[0] + s4[1]) + (s4[2] + s4[3])) * (1.0f / 1024.0f) + 1e-6f); }
struct EpiSwigluNF { static constexpr bool PERM = true, AFTER_DRAIN = false; bf16_t* O; const float* ss;
    __device__ __forceinline__ float silu_mul(float g, float u) const { return g * __builtin_amdgcn_rcpf(1.0f + __expf(-g)) * u; }
    __device__ __forceinline__ void operator()(const f32x4 (&acc)[2][2][4][2], const Unit& u, int wr, int wc, int fr, int fq) const {
        const int row0 = u.pm * BM + wr * 64 + fr, f0 = u.pn * HALF + wc * 32 + 8 * fq;
#pragma unroll
        for (int ai = 0; ai < 2; ++ai)
#pragma unroll
            for (int m = 0; m < 4; ++m) { const int row = row0 + ai * HALF + m * 16; const float rs = row_rstd(ss, row);
                const f32x4 g0 = acc[ai][0][m][0] * rs, g1 = acc[ai][0][m][1] * rs, u0 = acc[ai][1][m][0] * rs, u1 = acc[ai][1][m][1] * rs;
                u32x4 w; w.x = cvt_pk_bf16(silu_mul(g0[0], u0[0]), silu_mul(g0[1], u0[1])); w.y = cvt_pk_bf16(silu_mul(g0[2], u0[2]), silu_mul(g0[3], u0[3]));
                w.z = cvt_pk_bf16(silu_mul(g1[0], u1[0]), silu_mul(g1[1], u1[1])); w.w = cvt_pk_bf16(silu_mul(g1[2], u1[2]), silu_mul(g1[3], u1[3]));
                *(u32x4*)(O + (size_t)row * 2816 + f0) = w; }
    }
};
struct EpiWinNF { static constexpr bool PERM = true, AFTER_DRAIN = false; bf16_t* P; float* gates; const float* ss;
    __device__ __forceinline__ void operator()(const f32x4 (&acc)[2][2][4][2], const Unit& u, int wr, int wc, int fr, int fq) const {
        const int row0 = u.pm * BM + wr * 64 + fr, col0 = u.pn * BM + wc * 32 + 8 * fq;
        if (u.pn < 7) {
#pragma unroll
            for (int ai = 0; ai < 2; ++ai)
#pragma unroll
                for (int m = 0; m < 4; ++m) { const int row = row0 + ai * HALF + m * 16; const float rs = row_rstd(ss, row); bf16_t* rowp = P + (size_t)row * 1792 + col0;
#pragma unroll
                    for (int bj = 0; bj < 2; ++bj) { const f32x4 v0 = acc[ai][bj][m][0] * rs, v1 = acc[ai][bj][m][1] * rs;
                        u32x4 w; w.x = cvt_pk_bf16(v0[0], v0[1]); w.y = cvt_pk_bf16(v0[2], v0[3]); w.z = cvt_pk_bf16(v1[0], v1[1]); w.w = cvt_pk_bf16(v1[2], v1[3]);
                        *(u32x4*)(rowp + bj * HALF) = w; } }
        } else {
            const int gc = wc * 32 + 8 * fq;
            if (gc < 48) {
#pragma unroll
                for (int ai = 0; ai < 2; ++ai)
#pragma unroll
                    for (int m = 0; m < 4; ++m) { const int row = row0 + ai * HALF + m * 16; const float rs = row_rstd(ss, row); float* gp = gates + (size_t)row * 48 + gc;
#pragma unroll
                        for (int n = 0; n < 2; ++n) { const f32x4 v = acc[ai][0][m][n] * rs; f32x4 s;
#pragma unroll
                            for (int j = 0; j < 4; ++j) s[j] = __builtin_amdgcn_rcpf(1.0f + __expf(-v[j]));
                            *(f32x4*)(gp + 4 * n) = s; } }
            }
        }
    }
};
}


struct Args { const float* in[17]; float* out; unsigned char* ws; int ph_lo, ph_hi, li, pad; };
struct Frame {
    LAS unsigned char* lds;
    int tid, lane, wave, G, bid;
    int gw, ngw;
    const float* in[17]; float* out; unsigned char* ws;
};

__device__ __forceinline__ int t5_bucket(int n) {
    if (n < 16) return n;
    const float nf = (float)n;
    const int lb = 16 + (int)(logf(nf / 16.0f) / 4.1588830833596715f * 16.0f);
    return lb < 31 ? lb : 31;
}

struct RmPlain { int off; float s; __device__ int row(int n) const { return n + off; } __device__ float scale(int) const { return s; } };
struct RmQScale { int nq; __device__ int row(int n) const { return n; } __device__ float scale(int n) const { return n < nq ? 0.125f : 1.0f; } };
struct RmGU { __device__ int row(int n) const { const int up = n >= DFF; const int f = up ? n - DFF : n; return (f >> 7) * 256 + (up ? 128 : 0) + (f & 127); } __device__ float scale(int) const { return 1.0f; } };

template <class RM>
__device__ __forceinline__ void transpose_item(const float* W, int K, int N, bf16_t* WT, LAS float* scr, int item, int lane, const RM rm) {
    const int nblk = (N + 63) / 64, kb = item / nblk, nb = item % nblk, k0 = 64 * kb, n0 = 64 * nb;
    const int n4 = n0 + 4 * (lane & 15);
    f32x4 v[16];
#pragma unroll
    for (int i = 0; i < 16; ++i) { const int kk = 4 * i + (lane >> 4); v[i] = (n4 < N) ? *(const f32x4*)(W + (size_t)(k0 + kk) * N + n4) : (f32x4){0.f, 0.f, 0.f, 0.f}; }
#pragma unroll
    for (int i = 0; i < 16; ++i) { const int kk = 4 * i + (lane >> 4); LAS float* s = scr + kk * 65 + 4 * (lane & 15); s[0] = v[i].x; s[1] = v[i].y; s[2] = v[i].z; s[3] = v[i].w; }
    asm volatile("s_waitcnt lgkmcnt(0)" ::: "memory");
    const int c = lane & 7;
#pragma unroll
    for (int j = 0; j < 8; ++j) { const int nn = (lane >> 3) + 8 * j; const int n = n0 + nn; const LAS float* s = scr + (8 * c) * 65 + nn;
        if (n < N) { const float sc = rm.scale(n);
            u32x4 o; o.x = pk2(s[0 * 65] * sc, s[1 * 65] * sc); o.y = pk2(s[2 * 65] * sc, s[3 * 65] * sc); o.z = pk2(s[4 * 65] * sc, s[5 * 65] * sc); o.w = pk2(s[6 * 65] * sc, s[7 * 65] * sc);
            *(u32x4*)(WT + (size_t)rm.row(n) * K + k0 + 8 * c) = o; } }
    asm volatile("s_waitcnt lgkmcnt(0)" ::: "memory");
}
template <class RM>
__device__ __forceinline__ void transpose_all(Frame& F, const float* W, int K, int N, bf16_t* WT, const RM rm) {
    LAS float* scr = (LAS float*)(F.lds + F.wave * 16896);
    const int nitems = (K / 64) * ((N + 63) / 64);
    for (int it = F.gw; it < nitems; it += F.ngw) transpose_item(W, K, N, WT, scr, it, F.lane, rm);
}
__device__ __forceinline__ void rms_row_to_bf16(const float* xrow, const float* g, bf16_t* orow, int lane) {
    const f32x4* xr = (const f32x4*)xrow + lane; const f32x4* gr = (const f32x4*)g + lane;
    f32x4 v[4]; float s = 0.f;
#pragma unroll
    for (int j = 0; j < 4; ++j) { v[j] = xr[64 * j]; s += (v[j].x * v[j].x + v[j].y * v[j].y) + (v[j].z * v[j].z + v[j].w * v[j].w); }
    const float rstd = 1.0f / sqrtf(wave_sum(s) * (1.0f / DM) + RMS_EPS);
    unsigned long long* o8 = (unsigned long long*)orow + lane;
#pragma unroll
    for (int j = 0; j < 4; ++j) { const f32x4 gg = gr[64 * j];
        o8[64 * j] = (unsigned long long)pk2(v[j].x * rstd * gg.x, v[j].y * rstd * gg.y) | ((unsigned long long)pk2(v[j].z * rstd * gg.z, v[j].w * rstd * gg.w) << 32); }
}
__device__ __forceinline__ void norm_phase(Frame& F, const float* H, const float* g, bf16_t* XA) {
    for (int m = F.gw; m < M; m += F.ngw) rms_row_to_bf16(H + (size_t)m * DM, g, XA + (size_t)m * DM, F.lane);
}
__device__ __forceinline__ void final_norm_phase(Frame& F, float* H, const float* g) {
    for (int m = F.gw; m < M; m += F.ngw) {
        f32x4* xr = (f32x4*)(H + (size_t)m * DM) + F.lane; const f32x4* gr = (const f32x4*)g + F.lane;
        f32x4 v[4]; float s = 0.f;
#pragma unroll
        for (int j = 0; j < 4; ++j) { v[j] = xr[64 * j]; s += (v[j].x * v[j].x + v[j].y * v[j].y) + (v[j].z * v[j].z + v[j].w * v[j].w); }
        const float rstd = 1.0f / sqrtf(wave_sum(s) * (1.0f / DM) + RMS_EPS);
#pragma unroll
        for (int j = 0; j < 4; ++j) { const f32x4 gg = gr[64 * j]; f32x4 o; o.x = v[j].x * rstd * gg.x; o.y = v[j].y * rstd * gg.y; o.z = v[j].z * rstd * gg.z; o.w = v[j].w * rstd * gg.w; xr[64 * j] = o; }
    }
}
__device__ __forceinline__ void p0_prologue(Frame& F) {
    unsigned char* ws = F.ws;
    transpose_all(F, F.in[5], DM, AQKV, (bf16_t*)(ws + WS_WQKVA), RmQScale{1024});
    { float* bd = (float*)(ws + WS_BIASD); const float* rt = F.in[1];
      for (int i = F.bid * NTHR + F.tid; i < 2048 * 16; i += F.G * NTHR) { const int d = i >> 4, h = i & 15; bd[i] = rt[t5_bucket(d) * 16 + h]; } }
    norm_phase(F, F.in[0], F.in[2], (bf16_t*)(ws + WS_XA));
}
__device__ __forceinline__ void p0_rest(Frame& F, int hw, int nhw) {
    unsigned char* ws = F.ws;
    LAS float* scr = (LAS float*)(F.lds + F.wave * 16896);
    constexpr int I_O = 16 * 16, I_IN = 16 * 29, I_GU = 16 * 88, I_DN = 44 * 16, I_C1 = 32 * 4, I_C2 = 4 * 1;
    constexpr int NIT = 2 * I_O + I_IN + 2 * I_GU + 2 * I_DN + 2 * I_C1 + 2 * I_C2;
    for (int it = hw; it < NIT; it += nhw) {
        int r = it;
        if (r < I_GU) { transpose_item(F.in[15], DM, 2 * DFF, (bf16_t*)(ws + WS_WGU), scr, r, F.lane, RmGU{}); continue; } r -= I_GU;
        if (r < I_DN) { transpose_item(F.in[16], DFF, DM, (bf16_t*)(ws + WS_WDN), scr, r, F.lane, RmPlain{0, 1.f}); continue; } r -= I_DN;
        if (r < I_O) { transpose_item(F.in[8], DM, DM, (bf16_t*)(ws + WS_WOA), scr, r, F.lane, RmPlain{0, 1.f}); continue; } r -= I_O;
        if (r < I_IN) { transpose_item(F.in[10], DM, BIN, (bf16_t*)(ws + WS_WIN), scr, r, F.lane, RmQScale{1024}); continue; } r -= I_IN;
        if (r < I_O) { transpose_item(F.in[14], DM, DM, (bf16_t*)(ws + WS_WOB), scr, r, F.lane, RmPlain{0, 1.f}); continue; } r -= I_O;
        if (r < I_GU) { transpose_item(F.in[15] + (size_t)DM * 2 * DFF, DM, 2 * DFF, (bf16_t*)(ws + WS_WGU) + (size_t)2 * DFF * DM, scr, r, F.lane, RmGU{}); continue; } r -= I_GU;
        if (r < I_DN) { transpose_item(F.in[16] + (size_t)DFF * DM, DFF, DM, (bf16_t*)(ws + WS_WDN) + (size_t)DM * DFF, scr, r, F.lane, RmPlain{0, 1.f}); continue; } r -= I_DN;
        if (r < 2 * I_C1) { const int l = r / I_C1; transpose_item(F.in[12] + (size_t)l * 2048 * 256, 2048, 256, (bf16_t*)(ws + WS_CW1) + (size_t)l * 256 * 2048, scr, r % I_C1, F.lane, RmPlain{0, 1.f}); continue; } r -= 2 * I_C1;
        { const int l = r / I_C2; transpose_item(F.in[13] + (size_t)l * 256 * 64, 256, 64, (bf16_t*)(ws + WS_CW2) + (size_t)l * 64 * 256, scr, r % I_C2, F.lane, RmPlain{0, 1.f}); }
    }
    { u32x4* z = (u32x4*)((bf16_t*)(ws + WS_WIN) + (size_t)BIN * DM); const int n16 = (BINP - BIN) * DM * 2 / 16;
      for (int i = hw * 64 + F.lane; i < n16; i += nhw * 64) z[i] = (u32x4){0u, 0u, 0u, 0u}; }
    { float* c1 = (float*)(ws + WS_C1);
      for (int o = hw; o < 512; o += nhw) { const int kv = o >> 8, n = o & 255; const float* pos = F.in[11] + kv * 2048; const float* w1 = F.in[12] + (size_t)kv * 2048 * 256;
          float s = 0.f; for (int k = F.lane; k < 2048; k += 64) s += pos[k] * w1[(size_t)k * 256 + n];
          s = wave_sum(s); if (F.lane == 0) c1[o] = s; } }
}

template <bool DUAL, class Epi>
__device__ __forceinline__ void gemm_simple(Frame& F, const bf16_t* A, int lda, const bf16_t* Bt, int K, int nfeat_tiles, const Epi& E) {
    const int lane = F.lane, r32 = lane & 31, hi = lane >> 5;
    const int ntiles = (M / 64) * nfeat_tiles;
    for (int t = F.gw; t < ntiles; t += F.ngw) {
        const int mt = t / nfeat_tiles, ft = t % nfeat_tiles;
        const int m0 = mt * 64;
        int brow0, brow1, f0;
        if (DUAL) { f0 = ft * 32; brow0 = (f0 >> 7) * 256 + (f0 & 127); brow1 = brow0 + 128; }
        else { f0 = ft * 64; brow0 = f0; brow1 = f0 + 32; }
        const bf16_t* a0 = A + (size_t)(m0 + r32) * lda + 8 * hi; const bf16_t* a1 = a0 + (size_t)32 * lda;
        const bf16_t* b0 = Bt + (size_t)(brow0 + r32) * K + 8 * hi; const bf16_t* b1 = Bt + (size_t)(brow1 + r32) * K + 8 * hi;
        f32x16 acc00 = {}, acc01 = {}, acc10 = {}, acc11 = {};
#pragma unroll 4
        for (int k = 0; k < K; k += 16) {
            const bf16x8 fa0 = *(const bf16x8*)(a0 + k), fa1 = *(const bf16x8*)(a1 + k), fb0 = *(const bf16x8*)(b0 + k), fb1 = *(const bf16x8*)(b1 + k);
            acc00 = __builtin_amdgcn_mfma_f32_32x32x16_bf16(fa0, fb0, acc00, 0, 0, 0);
            acc01 = __builtin_amdgcn_mfma_f32_32x32x16_bf16(fa0, fb1, acc01, 0, 0, 0);
            acc10 = __builtin_amdgcn_mfma_f32_32x32x16_bf16(fa1, fb0, acc10, 0, 0, 0);
            acc11 = __builtin_amdgcn_mfma_f32_32x32x16_bf16(fa1, fb1, acc11, 0, 0, 0);
        }
#pragma unroll
        for (int r = 0; r < 16; ++r) {
            const int row = m0 + (r & 3) + 8 * (r >> 2) + 4 * hi;
            if (DUAL) { E(row, f0 + r32, acc00[r], acc01[r]); E(row + 32, f0 + r32, acc10[r], acc11[r]); }
            else { E(row, f0 + r32, acc00[r], 0.f); E(row, f0 + 32 + r32, acc01[r], 0.f); E(row + 32, f0 + r32, acc10[r], 0.f); E(row + 32, f0 + 32 + r32, acc11[r], 0.f); }
        }
    }
}
struct EpiQkvA { bf16_t* O; const float* bias; __device__ void operator()(int m, int n, float v, float) const { const float b = bias[n] * (n < 1024 ? 0.125f : 1.0f); O[(size_t)m * AQKV + n] = (bf16_t)f2bf(v + b); } };
struct EpiResid { const float* base; float* out; const float* bias; __device__ void operator()(int m, int n, float v, float) const { const size_t i = (size_t)m * DM + n; out[i] = base[i] + v + (bias ? bias[n] : 0.f); } };
struct EpiSwiglu { bf16_t* O; __device__ void operator()(int m, int f, float g, float u) const { const float s = g / (1.0f + __expf(-g)); O[(size_t)m * DFF + f] = (bf16_t)f2bf(s * u); } };
struct EpiWin { bf16_t* P; float* gates; __device__ void operator()(int m, int n, float v, float) const {
    if (n < PROJW) P[(size_t)m * PROJW + n] = (bf16_t)f2bf(v);
    else if (n < BIN) gates[(size_t)m * 48 + (n - PROJW)] = 1.0f / (1.0f + __expf(-v)); } };

struct KVsrc { const bf16_t* base; int pitch; int koff, voff; };
template <int MODE  >
__device__ __forceinline__ void attn_simple(Frame& F, const bf16_t* Q, int qpitch, KVsrc kv, const float* biasD, const float* sinks, const float* gates, const unsigned* selm, float* Ocomb, bf16_t* O) {
    const int nitems = M * NH / NTHR;
    for (int it = F.bid; it < nitems; it += F.G) {
        const int idx = it * NTHR + F.tid; const int m = idx >> 4, h = idx & 15, g = h >> 3;
        const int b = m / SEQ, t = m % SEQ;
        float q[64];
        { const u32x4* qp = (const u32x4*)(Q + (size_t)m * qpitch + h * 64);
#pragma unroll
          for (int c = 0; c < 8; ++c) { const u32x4 w = qp[c]; q[8 * c + 0] = bflo(w.x); q[8 * c + 1] = bfhi(w.x); q[8 * c + 2] = bflo(w.y); q[8 * c + 3] = bfhi(w.y); q[8 * c + 4] = bflo(w.z); q[8 * c + 5] = bfhi(w.z); q[8 * c + 6] = bflo(w.w); q[8 * c + 7] = bfhi(w.w); } }
        float o[64];
#pragma unroll
        for (int d = 0; d < 64; ++d) o[d] = 0.f;
        float mx = -1e20f, l = 0.f;
        unsigned sm = 0xffffffffu; int s_lo = 0;
        if (MODE == 0) s_lo = t - 127 > 0 ? t - 127 : 0;
        if (MODE == 2) s_lo = t - 511 > 0 ? t - 511 : 0;
        if (MODE == 1) sm = selm[(size_t)(b * 2 + g) * SEQ + t];
        const bf16_t* kb = kv.base + (size_t)b * SEQ * kv.pitch + kv.koff + g * 64;
        const bf16_t* vb = kv.base + (size_t)b * SEQ * kv.pitch + kv.voff + g * 64;
        for (int s = s_lo; s <= t; ++s) {
            if (MODE == 1) { if (!((sm >> (s >> 6)) & 1u)) { s |= 63; continue; } }
            const u32x4* kp = (const u32x4*)(kb + (size_t)s * kv.pitch);
            float dot = 0.f;
#pragma unroll
            for (int c = 0; c < 8; ++c) { const u32x4 w = kp[c];
                dot += q[8 * c + 0] * bflo(w.x) + q[8 * c + 1] * bfhi(w.x) + q[8 * c + 2] * bflo(w.y) + q[8 * c + 3] * bfhi(w.y) + q[8 * c + 4] * bflo(w.z) + q[8 * c + 5] * bfhi(w.z) + q[8 * c + 6] * bflo(w.w) + q[8 * c + 7] * bfhi(w.w); }
            const float sc = dot + biasD[(t - s) * 16 + h];
            const float mn = fmaxf(mx, sc); const float al = __expf(mx - mn), p = __expf(sc - mn);
            l = l * al + p; mx = mn;
            const u32x4* vp = (const u32x4*)(vb + (size_t)s * kv.pitch);
#pragma unroll
            for (int c = 0; c < 8; ++c) { const u32x4 w = vp[c];
                o[8 * c + 0] = o[8 * c + 0] * al + p * bflo(w.x); o[8 * c + 1] = o[8 * c + 1] * al + p * bfhi(w.x); o[8 * c + 2] = o[8 * c + 2] * al + p * bflo(w.y); o[8 * c + 3] = o[8 * c + 3] * al + p * bfhi(w.y);
                o[8 * c + 4] = o[8 * c + 4] * al + p * bflo(w.z); o[8 * c + 5] = o[8 * c + 5] * al + p * bfhi(w.z); o[8 * c + 6] = o[8 * c + 6] * al + p * bflo(w.w); o[8 * c + 7] = o[8 * c + 7] * al + p * bfhi(w.w); }
        }
        float inv;
        if (MODE == 0) { const float sk = sinks[h]; const float mf = fmaxf(mx, sk); const float al = __expf(mx - mf); inv = al / (l * al + __expf(sk - mf)); }
        else inv = (l > 0.f ? 1.0f / l : 0.f) * gates[(size_t)m * 48 + h * 3 + MODE];
        const size_t ob = (size_t)m * DM + h * 64;
        if (MODE == 1) {
#pragma unroll
            for (int c = 0; c < 16; ++c) { f32x4 a = *(f32x4*)(Ocomb + ob + 4 * c); a.x += o[4 * c] * inv; a.y += o[4 * c + 1] * inv; a.z += o[4 * c + 2] * inv; a.w += o[4 * c + 3] * inv; *(f32x4*)(Ocomb + ob + 4 * c) = a; }
        } else {
#pragma unroll
            for (int c = 0; c < 8; ++c) { float e[8];
#pragma unroll
                for (int j = 0; j < 8; ++j) e[j] = o[8 * c + j] * inv;
                if (MODE == 2) { const f32x4 a0 = *(const f32x4*)(Ocomb + ob + 8 * c), a1 = *(const f32x4*)(Ocomb + ob + 8 * c + 4); e[0] += a0.x; e[1] += a0.y; e[2] += a0.z; e[3] += a0.w; e[4] += a1.x; e[5] += a1.y; e[6] += a1.z; e[7] += a1.w; }
                u32x4 w; w.x = pk2(e[0], e[1]); w.y = pk2(e[2], e[3]); w.z = pk2(e[4], e[5]); w.w = pk2(e[6], e[7]); *(u32x4*)(O + ob + 8 * c) = w; }
        }
    }
}

__device__ __forceinline__ float gelu_tanh(float x) { const float u = 0.7978845608028654f * (x + 0.044715f * x * x * x); const float e = __expf(2.0f * u); const float th = 1.0f - 2.0f / (e + 1.0f); return 0.5f * x * (1.0f + th); }
__device__ __forceinline__ void compress_simple(Frame& F) {
    unsigned char* ws = F.ws;
    const bf16_t* P = (const bf16_t*)(ws + WS_QKV);
    LAS float* xs = (LAS float*)F.lds;
    LAS float* hs = xs + 2048;
    LAS float* part = hs + 256;
    const int nitems = 2 * BATCH * 2 * NC;
    for (int it = F.bid; it < nitems; it += F.G) {
        const int c = it % NC, g = (it / NC) & 1, b = (it / (NC * 2)) % BATCH, kvi = it / (NC * 2 * BATCH);
        __syncthreads();
        { const int l = F.tid >> 4, d4 = (F.tid & 15) * 4; const bf16_t* src = P + (size_t)(b * SEQ + 16 * c + l) * PROJW + 1024 + kvi * 128 + g * 64 + d4;
          const u32x2 w = *(const u32x2*)src; xs[l * 64 + d4] = bflo(w.x); xs[l * 64 + d4 + 1] = bfhi(w.x); xs[l * 64 + d4 + 2] = bflo(w.y); xs[l * 64 + d4 + 3] = bfhi(w.y); }
        __syncthreads();
        { const int n = F.tid & 255, half = F.tid >> 8; const bf16_t* w1 = (const bf16_t*)(ws + WS_CW1) + (size_t)kvi * 256 * 2048 + (size_t)n * 2048 + half * 1024;
          float s = 0.f;
          for (int k = 0; k < 1024; k += 8) { const u32x4 w = *(const u32x4*)(w1 + k); const LAS float* x = xs + half * 1024 + k;
              s += x[0] * bflo(w.x) + x[1] * bfhi(w.x) + x[2] * bflo(w.y) + x[3] * bfhi(w.y) + x[4] * bflo(w.z) + x[5] * bfhi(w.z) + x[6] * bflo(w.w) + x[7] * bfhi(w.w); }
          part[F.tid] = s; }
        __syncthreads();
        if (F.tid < 256) hs[F.tid] = gelu_tanh(part[F.tid] + part[F.tid + 256] + ((const float*)(ws + WS_C1))[kvi * 256 + F.tid]);
        __syncthreads();
        if (F.tid < 64) { const bf16_t* w2 = (const bf16_t*)(ws + WS_CW2) + (size_t)kvi * 64 * 256 + (size_t)F.tid * 256; float s = 0.f;
            for (int n = 0; n < 256; n += 2) { const unsigned w = *(const unsigned*)(w2 + n); s += hs[n] * bflo(w) + hs[n + 1] * bfhi(w); }
            ((bf16_t*)(ws + WS_KCVC))[((size_t)((kvi * BATCH + b) * 2 + g) * 128 + c) * 64 + F.tid] = (bf16_t)f2bf(s); }
    }
}

__device__ __forceinline__ void compress_fast(Frame& F) {
    unsigned char* ws = F.ws;
    const bf16_t* P = (const bf16_t*)(ws + WS_QKV);
    const bf16_t* w1t = (const bf16_t*)(ws + WS_CW1); const bf16_t* w2t = (const bf16_t*)(ws + WS_CW2);
    const float* c1 = (const float*)(ws + WS_C1);
    bf16_t* KV = (bf16_t*)(ws + WS_KCVC);
    LAS unsigned char* hl = F.lds;
    const int lane = F.lane, r32 = lane & 31, hi = lane >> 5, w = F.wave;
    for (int it = F.bid; it < 128; it += F.G) {
        const int ct = it & 3, g = (it >> 2) & 1, b = (it >> 3) & 7, kvi = it >> 6;
        const int c0 = 32 * ct;
        const int cl = (c0 + r32) < 126 ? (c0 + r32) : 126;
        const bf16_t* abase = P + (size_t)(b * SEQ + 16 * cl) * PROJW + 1024 + kvi * 128 + g * 64 + 8 * hi;
        const bf16_t* bbase = w1t + (size_t)kvi * 256 * 2048 + (size_t)(32 * w + r32) * 2048 + 8 * hi;
        f32x16 acc = {};
#pragma unroll 8
        for (int ks = 0; ks < 128; ++ks) {
            const bf16x8 a = *(const bf16x8*)(abase + (size_t)(ks >> 2) * PROJW + 16 * (ks & 3));
            const bf16x8 bb = *(const bf16x8*)(bbase + 16 * ks);
            acc = __builtin_amdgcn_mfma_f32_32x32x16_bf16(a, bb, acc, 0, 0, 0);
        }
        const float c1v = c1[kvi * 256 + 32 * w + r32];
        __syncthreads();
#pragma unroll
        for (int r = 0; r < 16; ++r) { const int cr = (r & 3) + 8 * (r >> 2) + 4 * hi; *(LAS bf16_t*)(hl + cr * 528 + (32 * w + r32) * 2) = (bf16_t)f2bf(gelu_tanh(acc[r] + c1v)); }
        __syncthreads();
        if (w < 2) {
            f32x16 o = {};
            const bf16_t* w2 = w2t + (size_t)kvi * 64 * 256 + (size_t)(32 * w + r32) * 256 + 8 * hi;
#pragma unroll
            for (int ks = 0; ks < 16; ++ks) {
                const bf16x8 a = *(const LAS bf16x8*)(hl + r32 * 528 + (16 * ks + 8 * hi) * 2);
                const bf16x8 bb = *(const bf16x8*)(w2 + 16 * ks);
                o = __builtin_amdgcn_mfma_f32_32x32x16_bf16(a, bb, o, 0, 0, 0);
            }
            bf16_t* outp = KV + (size_t)((kvi * BATCH + b) * 2 + g) * 128 * 64 + 32 * w + r32;
#pragma unroll
            for (int r = 0; r < 16; ++r) { const int c = c0 + (r & 3) + 8 * (r >> 2) + 4 * hi; outp[(size_t)c * 64] = (c < NC) ? (bf16_t)f2bf(o[r]) : (bf16_t)0; }
        }
    }
}

__device__ __forceinline__ void cmp_simple(Frame& F) {
    unsigned char* ws = F.ws;
    const bf16_t* P = (const bf16_t*)(ws + WS_QKV);
    const float* biasD = (const float*)(ws + WS_BIASD);
    const float* gates = (const float*)(ws + WS_GATES);
    float* Ocomb = (float*)(ws + WS_OCOMB);
    unsigned* selm = (unsigned*)(ws + WS_SELM);
    LAS float* Pl = (LAS float*)F.lds;
    LAS float* sc = Pl + 1024;
    const int nitems = BATCH * 2 * SEQ;
    for (int it = F.bid; it < nitems; it += F.G) {
        const int t = it % SEQ, g = (it / SEQ) & 1, b = it / (SEQ * 2);
        const int m = b * SEQ + t, hh = F.wave, h = g * 8 + hh, lane = F.lane;
        const bf16_t* kc = (const bf16_t*)(ws + WS_KCVC) + (size_t)((0 * BATCH + b) * 2 + g) * 128 * 64;
        const bf16_t* vc = (const bf16_t*)(ws + WS_KCVC) + (size_t)((1 * BATCH + b) * 2 + g) * 128 * 64;
        const bf16_t* qp = P + (size_t)m * PROJW + h * 64;
        __syncthreads();
        float s2[2];
#pragma unroll
        for (int u = 0; u < 2; ++u) { const int c = lane + 64 * u; float dot = 0.f; const bool valid = (c < NC) && (16 * c + 31 <= t);
            if (valid) { const u32x4* kp = (const u32x4*)(kc + (size_t)c * 64); const u32x4* qq = (const u32x4*)qp;
#pragma unroll
                for (int j = 0; j < 8; ++j) { const u32x4 a = qq[j], w = kp[j];
                    dot += bflo(a.x) * bflo(w.x) + bfhi(a.x) * bfhi(w.x) + bflo(a.y) * bflo(w.y) + bfhi(a.y) * bfhi(w.y) + bflo(a.z) * bflo(w.z) + bfhi(a.z) * bfhi(w.z) + bflo(a.w) * bflo(w.w) + bfhi(a.w) * bfhi(w.w); }
                dot += biasD[(t - 16 * c - 31) * 16 + h]; }
            s2[u] = valid ? dot : NEG_BIG; }
        const float mx = wave_max(fmaxf(s2[0], s2[1]));
        const float e0 = s2[0] > -1e29f ? __expf(s2[0] - mx) : 0.f, e1 = s2[1] > -1e29f ? __expf(s2[1] - mx) : 0.f;
        const float l = wave_sum(e0 + e1); const float inv = l > 0.f ? 1.0f / l : 0.f;
        Pl[hh * 128 + lane] = e0 * inv; Pl[hh * 128 + 64 + lane] = e1 * inv;
        __syncthreads();
        { float o = 0.f; const int cmax = (t - 31) >= 0 ? (t - 31) / 16 : -1;
          for (int c = 0; c <= cmax && c < NC; ++c) o += Pl[hh * 128 + c] * bf2f(vc[(size_t)c * 64 + lane]);
          Ocomb[(size_t)m * DM + h * 64 + lane] = o * gates[(size_t)m * 48 + h * 3 + 0]; }
        if (F.tid < 32) { const int j = F.tid, cur = t >> 6; float imp = 0.f;
            for (int c = 4 * j - 1; c <= 4 * j + 3; ++c) if (c >= 0 && c < NC) { float a = 0.f;
#pragma unroll
                for (int q = 0; q < 8; ++q) a += Pl[q * 128 + c];
                imp += a; }
            const bool forced = (j == 0) || (cur - j >= 0 && cur - j < 2);
            sc[j] = forced ? 1e6f : (j <= cur ? imp : -1.0f); }
        __syncthreads();
        if (F.tid < 32) { const int j = F.tid; const float mine = sc[j]; int rank = 0;
            for (int k = 0; k < 32; ++k) { const float o = sc[k]; rank += (o > mine || (o == mine && k < j)) ? 1 : 0; }
            const unsigned long long bal = __ballot(rank < 16);
            if (j == 0) selm[(size_t)(b * 2 + g) * SEQ + t] = (unsigned)bal; }
    }
}


namespace fa {
constexpr float LOG2E = 1.4426950408889634f;
constexpr float THR = 5.5f;
constexpr int KVB = 8192;
constexpr int BUFB = 2 * KVB;
constexpr int TC_N = 2112, TC_RC = 2047;
constexpr int TW_N = 640, TW_RC = 575;
constexpr int TS_N = 256, TS_RC = 191;
constexpr int L_KV = 0, L_TC = 2 * BUFB, L_TW = L_TC + 8 * TC_N * 4, L_SC = L_TW + 8 * TW_N * 4, L_SELM = L_SC + 4096, L_END = L_SELM + 128;
static_assert(L_END <= LDS_MAIN, "attention LDS map");
typedef float f32x2_t __attribute__((ext_vector_type(2))); typedef __bf16 bf16x2_t __attribute__((ext_vector_type(2)));
typedef short v4i16_t __attribute__((ext_vector_type(4)));
__device__ __forceinline__ unsigned cvtpk(float lo, float hi) { f32x2_t v = {lo, hi}; bf16x2_t b = __builtin_convertvector(v, bf16x2_t); return __builtin_bit_cast(unsigned, b); }
__device__ __forceinline__ v4i16_t vtr(const LAS unsigned char* p) { return __builtin_amdgcn_ds_read_tr16_b64_v4i16((LAS v4i16_t*)p); }
__device__ __forceinline__ int swz_f(int key) { return (((key >> 1) & 1) << 2) | ((key >> 2) & 3); }
__device__ __forceinline__ int swz_off(int key, int chunk) { return key * 128 + ((chunk ^ swz_f(key)) << 4); }
__device__ __forceinline__ float hswap_max(float v) { return fmaxf(v, __shfl_xor(v, 32)); }
__device__ __forceinline__ float hswap_sum(float v) { return v + __shfl_xor(v, 32); }

struct TileSrc { const bf16_t* k; const bf16_t* v; int pitch; };
__device__ __forceinline__ void tile_load(const TileSrc& s, int tid, u32x4& kr, u32x4& vr) {
    const int key = tid >> 3, ch = tid & 7;
    kr = *(const u32x4*)(s.k + (size_t)key * s.pitch + ch * 8); vr = *(const u32x4*)(s.v + (size_t)key * s.pitch + ch * 8);
}
__device__ __forceinline__ void tile_store(LAS unsigned char* buf, int tid, const u32x4& kr, const u32x4& vr) {
    const int key = tid >> 3, ch = tid & 7; const int o = swz_off(key, ch);
    *(LAS u32x4*)(buf + o) = kr; *(LAS u32x4*)(buf + KVB + o) = vr;
}
__device__ __forceinline__ void qk_tile(const LAS unsigned char* buf, const bf16x8 (&qf)[4], const int (&koff)[4], f32x16& p0, f32x16& p1) {
    p0 = (f32x16){}; p1 = (f32x16){};
#pragma unroll
    for (int ks = 0; ks < 4; ++ks) {
        const bf16x8 a0 = *(const LAS bf16x8*)(buf + koff[ks]); const bf16x8 a1 = *(const LAS bf16x8*)(buf + koff[ks] + 4096);
        p0 = __builtin_amdgcn_mfma_f32_32x32x16_bf16(a0, qf[ks], p0, 0, 0, 0);
        p1 = __builtin_amdgcn_mfma_f32_32x32x16_bf16(a1, qf[ks], p1, 0, 0, 0);
    }
}
__device__ __forceinline__ void pv_tile(const LAS unsigned char* buf, const int (&voff)[4], const f32x16& p0, const f32x16& p1, f32x16& o0, f32x16& o1) {
#pragma unroll
    for (int s = 0; s < 4; ++s) {
        u32x4 pw;
        if (s < 2) { const int b = 8 * (s & 1); pw.x = cvtpk(p0[b], p0[b + 1]); pw.y = cvtpk(p0[b + 2], p0[b + 3]); pw.z = cvtpk(p0[b + 4], p0[b + 5]); pw.w = cvtpk(p0[b + 6], p0[b + 7]); }
        else       { const int b = 8 * (s & 1); pw.x = cvtpk(p1[b], p1[b + 1]); pw.y = cvtpk(p1[b + 2], p1[b + 3]); pw.z = cvtpk(p1[b + 4], p1[b + 5]); pw.w = cvtpk(p1[b + 6], p1[b + 7]); }
        const bf16x8 pb = __builtin_bit_cast(bf16x8, pw);
        { const v4i16_t va = vtr(buf + voff[0] + 2048 * s), vb = vtr(buf + voff[1] + 2048 * s);
          const bf16x8 A = (bf16x8){va[0], va[1], va[2], va[3], vb[0], vb[1], vb[2], vb[3]};
          o0 = __builtin_amdgcn_mfma_f32_32x32x16_bf16(A, pb, o0, 0, 0, 0); }
        { const v4i16_t va = vtr(buf + voff[2] + 2048 * s), vb = vtr(buf + voff[3] + 2048 * s);
          const bf16x8 A = (bf16x8){va[0], va[1], va[2], va[3], vb[0], vb[1], vb[2], vb[3]};
          o1 = __builtin_amdgcn_mfma_f32_32x32x16_bf16(A, pb, o1, 0, 0, 0); }
    }
}
__device__ __forceinline__ void tile_step(const LAS unsigned char* buf, const bf16x8 (&qf)[4], const int (&koff)[4], const int (&voff)[4], const LAS float* tp,
                                          float& m, float& l, f32x16& o0, f32x16& o1) {
    f32x16 p0, p1;
    qk_tile(buf, qf, koff, p0, p1);
#pragma unroll
    for (int r = 0; r < 16; ++r) { p0[r] += tp[(r & 3) + 8 * (r >> 2)]; p1[r] += tp[32 + (r & 3) + 8 * (r >> 2)]; }
    float mx = fmaxf(p0[0], p1[0]);
#pragma unroll
    for (int r = 1; r < 16; ++r) mx = fmaxf(mx, fmaxf(p0[r], p1[r]));
    mx = hswap_max(mx);
    if (__any(mx > m + THR)) {
        const float mn = fmaxf(m, mx); const float al = __builtin_amdgcn_exp2f((m - mn) * LOG2E);
        l *= al; m = mn;
#pragma unroll
        for (int r = 0; r < 16; ++r) { o0[r] *= al; o1[r] *= al; }
    }
    const float c = -m * LOG2E; float ls = 0.f;
#pragma unroll
    for (int r = 0; r < 16; ++r) { p0[r] = __builtin_amdgcn_exp2f(__builtin_fmaf(p0[r], LOG2E, c)); p1[r] = __builtin_amdgcn_exp2f(__builtin_fmaf(p1[r], LOG2E, c)); ls += p0[r] + p1[r]; }
    l += ls;
    pv_tile(buf, voff, p0, p1, o0, o1);
}
__device__ __forceinline__ void lane_offsets(int lane, int (&koff)[4], int (&voff)[4]) {
    const int r32 = lane & 31, hi = lane >> 5;
#pragma unroll
    for (int ks = 0; ks < 4; ++ks) koff[ks] = swz_off(r32, 2 * ks + hi);
    const int kq = (lane & 15) >> 2, gidx = (lane >> 4) & 1, within = 8 * (lane & 1);
    const int fA = ((kq >> 1) << 2) | hi, fB = ((kq >> 1) << 2) | (hi + 2);
#pragma unroll
    for (int dh = 0; dh < 2; ++dh) { const int chunk = 4 * dh + 2 * gidx + ((lane & 3) >> 1);
        voff[2 * dh + 0] = KVB + (4 * hi + kq) * 128 + ((chunk ^ fA) << 4) + within;
        voff[2 * dh + 1] = KVB + (4 * hi + kq + 8) * 128 + ((chunk ^ fB) << 4) + within; }
}
__device__ __forceinline__ void unit_decode(int it, int& b, int& g, int& qt) {
    const int k = it >> 8, v = it & 255, pair = v >> 4, s = v & 15;
    b = pair >> 1; g = pair & 1; qt = (k == 0) ? s : (k == 1) ? 31 - s : (k == 2) ? 32 + s : 63 - s;
}
__device__ __forceinline__ void store_o(bf16_t* orow  , int hi, const f32x16& o0, const f32x16& o1) {
#pragma unroll
    for (int rg = 0; rg < 4; ++rg) {
        u32x2 w0; w0.x = cvtpk(o0[4 * rg], o0[4 * rg + 1]); w0.y = cvtpk(o0[4 * rg + 2], o0[4 * rg + 3]);
        u32x2 w1; w1.x = cvtpk(o1[4 * rg], o1[4 * rg + 1]); w1.y = cvtpk(o1[4 * rg + 2], o1[4 * rg + 3]);
        *(u32x2*)(orow + 8 * rg + 4 * hi) = w0; *(u32x2*)(orow + 32 + 8 * rg + 4 * hi) = w1; }
}

__device__ __forceinline__ void swa_phase(Frame& F, const bf16_t* QKV, const float* biasD, const float* sinks, bf16_t* O) {
    LAS unsigned char* kvb = F.lds + L_KV; LAS float* tabS = (LAS float*)(F.lds + L_TC);
    const int lane = F.lane, r32 = lane & 31, hi = lane >> 5, w = F.wave, tid = F.tid;
    int koff[4], voff[4]; lane_offsets(lane, koff, voff);
    const int vcu = (F.G % 8 == 0) ? (F.bid % 8) * (F.G / 8) + F.bid / 8 : F.bid;
    int built_g = -1;
    for (int it = vcu; it < 1024; it += F.G) {
        int b, g, qt; unit_decode(it, b, g, qt);
        const int t0 = 32 * qt, cur = qt >> 1, h = 8 * g + w, t = t0 + r32;
        if (g != built_g) { __syncthreads();
            for (int i = tid; i < 8 * TS_N; i += NTHR) { const int hh = i >> 8, j = i & 255; const int dist = TS_RC - j; tabS[i] = (dist >= 0 && dist < 128) ? biasD[dist * 16 + 8 * g + hh] : NEG_BIG; }
            built_g = g; __syncthreads(); }
        const LAS float* tab = tabS + w * TS_N;
        const bf16_t* rowb = QKV + (size_t)b * SEQ * AQKV;
        bf16x8 qf[4];
#pragma unroll
        for (int ks = 0; ks < 4; ++ks) qf[ks] = *(const bf16x8*)(rowb + (size_t)t * AQKV + h * 64 + 16 * ks + 8 * hi);
        f32x16 o0 = {}, o1 = {}; float m = -1e20f, l = 0.f;
        const int kt_lo = cur - 2 > 0 ? cur - 2 : 0;
        u32x4 kr, vr;
        { const TileSrc s{rowb + (size_t)(64 * kt_lo) * AQKV + 1024 + g * 64, rowb + (size_t)(64 * kt_lo) * AQKV + 1152 + g * 64, AQKV}; tile_load(s, tid, kr, vr); }
        tile_store(kvb, tid, kr, vr);
        __syncthreads();
        int bufi = 0;
        for (int kt = kt_lo; kt <= cur; ++kt) {
            const bool has_n = kt < cur;
            if (has_n) { const TileSrc s{rowb + (size_t)(64 * (kt + 1)) * AQKV + 1024 + g * 64, rowb + (size_t)(64 * (kt + 1)) * AQKV + 1152 + g * 64, AQKV}; tile_load(s, tid, kr, vr); }
            tile_step(kvb + bufi * BUFB, qf, koff, voff, tab + (64 * kt - t + TS_RC + 4 * hi), m, l, o0, o1);
            if (has_n) tile_store(kvb + (bufi ^ 1) * BUFB, tid, kr, vr);
            __syncthreads();
            bufi ^= 1;
        }
        { const float lt = hswap_sum(l); const float sk = sinks[h]; const float mf = fmaxf(m, sk); const float al = __expf(m - mf); const float inv = al / (lt * al + __expf(sk - mf));
#pragma unroll
          for (int r = 0; r < 16; ++r) { o0[r] *= inv; o1[r] *= inv; }
          store_o(O + (size_t)(b * SEQ + t) * DM + h * 64, hi, o0, o1); }
    }
}

__device__ __forceinline__ void nsa_phase(Frame& F, const bf16_t* P, const bf16_t* KC, const bf16_t* VC, const float* biasD, const float* gates, bf16_t* O) {
    LAS unsigned char* kvb = F.lds + L_KV; LAS float* tabC = (LAS float*)(F.lds + L_TC); LAS float* tabW = (LAS float*)(F.lds + L_TW);
    LAS float* stg = (LAS float*)(F.lds + L_KV);
    LAS float* scl = (LAS float*)(F.lds + L_SC);
    LAS unsigned* selm = (LAS unsigned*)(F.lds + L_SELM);
    const int lane = F.lane, r32 = lane & 31, hi = lane >> 5, w = F.wave, tid = F.tid;
    int koff[4], voff[4]; lane_offsets(lane, koff, voff);
    const int vcu = (F.G % 8 == 0) ? (F.bid % 8) * (F.G / 8) + F.bid / 8 : F.bid;
    int built_g = -1;
    for (int it = vcu; it < 1024; it += F.G) {
        int b, g, qt; unit_decode(it, b, g, qt);
        const int t0 = 32 * qt, cur = qt >> 1, h = 8 * g + w, t = t0 + r32;
        if (g != built_g) { __syncthreads();
            for (int i = tid; i < 8 * TC_N; i += NTHR) { const int hh = i / TC_N, j = i - hh * TC_N; tabC[i] = (j <= TC_RC) ? biasD[(TC_RC - j) * 16 + 8 * g + hh] : NEG_BIG; }
            for (int i = tid; i < 8 * TW_N; i += NTHR) { const int hh = i / TW_N, j = i - hh * TW_N; const int dist = TW_RC - j; tabW[i] = (dist >= 0 && dist < 512) ? biasD[dist * 16 + 8 * g + hh] : NEG_BIG; }
            built_g = g; __syncthreads(); }
        const LAS float* tc = tabC + w * TC_N; const LAS float* tw = tabW + w * TW_N;
        const bf16_t* rowb = P + (size_t)b * SEQ * PROJW;
        const size_t mrow = (size_t)(b * SEQ + t);
        bf16x8 qf[4];
#pragma unroll
        for (int ks = 0; ks < 4; ++ks) qf[ks] = *(const bf16x8*)(rowb + (size_t)t * PROJW + h * 64 + 16 * ks + 8 * hi);
        const float g0 = gates[mrow * 48 + h * 3 + 0], g1 = gates[mrow * 48 + h * 3 + 1], g2 = gates[mrow * 48 + h * 3 + 2];
        f32x16 f0, f1;
        {
            const bf16_t* kc = KC + (size_t)(b * 2 + g) * 128 * 64; const bf16_t* vc = VC + (size_t)(b * 2 + g) * 128 * 64;
            u32x4 kr, vr;
            { const TileSrc s{kc, vc, 64}; tile_load(s, tid, kr, vr); tile_store(kvb, tid, kr, vr); }
            { const TileSrc s{kc + 64 * 64, vc + 64 * 64, 64}; tile_load(s, tid, kr, vr); tile_store(kvb + BUFB, tid, kr, vr); }
            __syncthreads();
            f32x16 s00, s01, s10, s11;
            qk_tile(kvb, qf, koff, s00, s01); qk_tile(kvb + BUFB, qf, koff, s10, s11);
            const int e0 = TC_RC - (t - 31 - 64 * hi);
#define CMP_BIAS(S, KT, KB) _Pragma("unroll") for (int r = 0; r < 16; ++r) { int idx = e0 + 16 * (64 * (KT) + 32 * (KB) + (r & 3) + 8 * (r >> 2)); idx = idx < 2048 ? idx : 2048; S[r] += tc[idx]; }
            CMP_BIAS(s00, 0, 0) CMP_BIAS(s01, 0, 1) CMP_BIAS(s10, 1, 0) CMP_BIAS(s11, 1, 1)
#undef CMP_BIAS
            float mx = -1e20f;
#pragma unroll
            for (int r = 0; r < 16; ++r) mx = fmaxf(fmaxf(mx, fmaxf(s00[r], s01[r])), fmaxf(s10[r], s11[r]));
            mx = hswap_max(mx);
            const float c = -mx * LOG2E; float ls = 0.f;
#pragma unroll
            for (int r = 0; r < 16; ++r) { s00[r] = __builtin_amdgcn_exp2f(__builtin_fmaf(s00[r], LOG2E, c)); s01[r] = __builtin_amdgcn_exp2f(__builtin_fmaf(s01[r], LOG2E, c));
                s10[r] = __builtin_amdgcn_exp2f(__builtin_fmaf(s10[r], LOG2E, c)); s11[r] = __builtin_amdgcn_exp2f(__builtin_fmaf(s11[r], LOG2E, c)); ls += (s00[r] + s01[r]) + (s10[r] + s11[r]); }
            ls = hswap_sum(ls); const float inv = ls > 0.f ? 1.0f / ls : 0.f;
#pragma unroll
            for (int r = 0; r < 16; ++r) { s00[r] *= inv; s01[r] *= inv; s10[r] *= inv; s11[r] *= inv; }
            float gs[16], xl[16];
#pragma unroll
            for (int rg = 0; rg < 4; ++rg) {
                gs[0 + rg] = (s00[4 * rg] + s00[4 * rg + 1]) + (s00[4 * rg + 2] + s00[4 * rg + 3]); xl[0 + rg] = s00[4 * rg + 3];
                gs[4 + rg] = (s01[4 * rg] + s01[4 * rg + 1]) + (s01[4 * rg + 2] + s01[4 * rg + 3]); xl[4 + rg] = s01[4 * rg + 3];
                gs[8 + rg] = (s10[4 * rg] + s10[4 * rg + 1]) + (s10[4 * rg + 2] + s10[4 * rg + 3]); xl[8 + rg] = s10[4 * rg + 3];
                gs[12 + rg] = (s11[4 * rg] + s11[4 * rg + 1]) + (s11[4 * rg + 2] + s11[4 * rg + 3]); xl[12 + rg] = s11[4 * rg + 3]; }
            float rv[16];
#pragma unroll
            for (int n = 0; n < 16; ++n) rv[n] = __shfl_xor(xl[n], 32);
#pragma unroll
            for (int n = 0; n < 16; ++n) { const float prev_lo = (n > 0) ? rv[n > 0 ? n - 1 : 0] : 0.f; gs[n] += hi ? rv[n] : prev_lo; }
            f0 = (f32x16){}; f1 = (f32x16){};
            pv_tile(kvb, voff, s00, s01, f0, f1); pv_tile(kvb + BUFB, voff, s10, s11, f0, f1);
#pragma unroll
            for (int r = 0; r < 16; ++r) { f0[r] *= g0; f1[r] *= g0; }
            __syncthreads();
#pragma unroll
            for (int n = 0; n < 16; ++n) stg[(w * 32 + r32) * 32 + 2 * n + hi] = gs[n];
            __syncthreads();
#pragma unroll
            for (int ps = 0; ps < 2; ++ps) { const int q = (tid >> 5) + 16 * ps, j = tid & 31; float imp = 0.f;
#pragma unroll
                for (int ww = 0; ww < 8; ++ww) imp += stg[(ww * 32 + q) * 32 + j];
                const bool forced = (j == 0) || (cur - j >= 0 && cur - j < 2);
                scl[q * 32 + j] = forced ? 1e6f : (j <= cur ? imp : -1.0f); }
            __syncthreads();
#pragma unroll
            for (int ps = 0; ps < 2; ++ps) { const int q = (tid >> 5) + 16 * ps, j = tid & 31; const float mine = scl[q * 32 + j]; int rank = 0;
                for (int k = 0; k < 32; ++k) { const float ov = scl[q * 32 + k]; rank += (ov > mine || (ov == mine && k < j)) ? 1 : 0; }
                const unsigned long long bal = __ballot(rank < 16);
                if (lane == 0) { selm[2 * w + 16 * ps] = (unsigned)bal; selm[2 * w + 1 + 16 * ps] = (unsigned)(bal >> 32); } }
            __syncthreads();
        }
        const unsigned mymask = selm[r32];
        unsigned un = mymask;
#pragma unroll
        for (int o = 1; o < 32; o <<= 1) un |= (unsigned)__shfl_xor((int)un, o);
        un = (unsigned)__builtin_amdgcn_readfirstlane((int)un);
        unsigned rem = un & ((cur >= 31) ? 0xffffffffu : ((2u << cur) - 1u));
        int wk = cur - 8 > 0 ? cur - 8 : 0;
        const bf16_t* ksel = rowb + 1024 + 2 * 128 + g * 64; const bf16_t* vsel = rowb + 1024 + 3 * 128 + g * 64;
        const bf16_t* kwin = rowb + 1024 + 4 * 128 + g * 64; const bf16_t* vwin = rowb + 1024 + 5 * 128 + g * 64;
        int n_br, n_kt; bool has_n;
#define NEXT_TILE() do { if (rem) { n_kt = __builtin_ctz(rem); rem &= rem - 1u; n_br = 1; has_n = true; } else if (wk <= cur) { n_kt = wk++; n_br = 2; has_n = true; } else has_n = false; } while (0)
#define LOAD_NEXT() do { const TileSrc s_{(n_br == 1 ? ksel : kwin) + (size_t)(64 * n_kt) * PROJW, (n_br == 1 ? vsel : vwin) + (size_t)(64 * n_kt) * PROJW, PROJW}; tile_load(s_, tid, kr, vr); } while (0)
        u32x4 kr, vr;
        NEXT_TILE();
        LOAD_NEXT(); tile_store(kvb, tid, kr, vr);
        __syncthreads();
        int c_br = n_br, c_kt = n_kt, bufi = 0;
        f32x16 o0 = {}, o1 = {}; float m = -1e20f, l = 0.f; bool switched = false;
        for (;;) {
            NEXT_TILE();
            if (has_n) LOAD_NEXT();
            if (c_br == 2 && !switched) {
                const float lt = hswap_sum(l); const float inv = (lt > 0.f ? 1.0f / lt : 0.f) * g1;
#pragma unroll
                for (int r = 0; r < 16; ++r) { f0[r] += o0[r] * inv; f1[r] += o1[r] * inv; o0[r] = 0.f; o1[r] = 0.f; }
                m = -1e20f; l = 0.f; switched = true; }
            const LAS float* tp;
            if (c_br == 1) { const bool sel = (mymask >> c_kt) & 1u; tp = tc + (sel ? (64 * c_kt - t + TC_RC + 4 * hi) : 2048); }
            else tp = tw + (64 * c_kt - t + TW_RC + 4 * hi);
            tile_step(kvb + bufi * BUFB, qf, koff, voff, tp, m, l, o0, o1);
            if (!has_n) break;
            tile_store(kvb + (bufi ^ 1) * BUFB, tid, kr, vr);
            __syncthreads();
            c_br = n_br; c_kt = n_kt; bufi ^= 1;
        }
#undef NEXT_TILE
#undef LOAD_NEXT
        { const float lt = hswap_sum(l); const float inv = (lt > 0.f ? 1.0f / lt : 0.f) * (switched ? g2 : g1);
#pragma unroll
          for (int r = 0; r < 16; ++r) { f0[r] += o0[r] * inv; f1[r] += o1[r] * inv; }
          store_o(O + mrow * DM + h * 64, hi, f0, f1); }
        __syncthreads();
    }
}
}

template <class Epi> __device__ __forceinline__ void gemm_fast(Frame& F, const bf16_t* A, const bf16_t* Bt, int N, int K, const Epi& E) {
    pg8::Gemm g{A, Bt, M, N, K}; pg8::StaticOrder S; S.init(M, N, F.G, F.bid);
    pg8::gemm_phase<Epi, pg8::StaticOrder, true, true>(F.lds, g, S, E);
}
constexpr int NPHASES = FUSE_NORM ? 13 : 17;
__global__ void __launch_bounds__(NTHR, 2) trunk_fwd(Args args) {
    extern __shared__ __attribute__((aligned(16))) unsigned char lds[];
    Frame F;
    F.lds = (LAS unsigned char*)lds;
    F.tid = threadIdx.x; F.lane = F.tid & 63; F.wave = __builtin_amdgcn_readfirstlane(F.tid >> 6);
    F.G = gridDim.x; F.bid = blockIdx.x; F.gw = F.bid * NWAVES + F.wave; F.ngw = F.G * NWAVES;
#pragma unroll
    for (int i = 0; i < 17; ++i) F.in[i] = args.in[i];
    F.out = args.out; F.ws = args.ws;
    unsigned char* ws = args.ws;
    volatile LAS unsigned* MISC = (volatile LAS unsigned*)(F.lds + MISC_OFF);
    if (F.tid < 32) MISC[F.tid] = 0u;
    __syncthreads();
    unsigned* barw = (unsigned*)(ws + WS_CTL) + CW_BAR + args.li * XCD_BAR_WORDS;
    XcdBarrier bar; bar.bar = barw; bar.x = 0; bar.st = nullptr;
    const int lo = args.ph_lo, hi = args.ph_hi;
    if (hi - lo > 1) bar = xcd_barrier_post(barw, MISC + 8);
#define IN(k) (lo <= (k) && (k) < hi)
#define SEAM(k) do { if (IN(k) && IN((k) + 1)) xcd_barrier(bar); } while (0)

    bf16_t* XA = (bf16_t*)(ws + WS_XA); bf16_t* QKV = (bf16_t*)(ws + WS_QKV); bf16_t* Ob = (bf16_t*)(ws + WS_O); bf16_t* HID = (bf16_t*)(ws + WS_HID);
    float* Hres = F.out; float* Ocomb = (float*)(ws + WS_OCOMB); float* gates = (float*)(ws + WS_GATES);
    const float* biasD = (const float*)(ws + WS_BIASD);

#define PHASE(k, BODY) if (IN(k)) { BODY; if ((k) == REPEAT_PHASE) { xcd_barrier(bar); BODY; xcd_barrier(bar); BODY; } }
#if FUSE_NORM
    float* SS = (float*)(ws + WS_SS); PG8_LAS float* red = (PG8_LAS float*)(F.lds + 131072);
    const bf16_t* WGU0 = (const bf16_t*)(ws + WS_WGU); const bf16_t* WGU1 = WGU0 + (size_t)2 * DFF * DM; const bf16_t* WDN0 = (const bf16_t*)(ws + WS_WDN); const bf16_t* WDN1 = WDN0 + (size_t)DM * DFF;
    PHASE(0, { p0_prologue(F); }) SEAM(0);
    PHASE(1, { gemm_fast(F, XA, (const bf16_t*)(ws + WS_WQKVA), AQKV, DM, pg8::EpiQkvF{QKV, F.in[6]});
                { int fh = 320 - F.G; if (fh < 0 || fh >= F.G) fh = 0; if (F.bid >= fh) p0_rest(F, (F.bid - fh) * NWAVES + F.wave, (F.G - fh) * NWAVES); } }) SEAM(1);
    PHASE(2, { fa::swa_phase(F, QKV, biasD, F.in[7], Ob); }) SEAM(2);
    PHASE(3, { gemm_fast(F, Ob, (const bf16_t*)(ws + WS_WOA), DM, DM, pg8::EpiResidNormF{F.in[0], Hres, F.in[9], F.in[3], XA, SS, red}); }) SEAM(3);
    PHASE(4, { gemm_fast(F, XA, WGU0, 2 * DFF, DM, pg8::EpiSwigluNF{HID, SS}); }) SEAM(4);
    PHASE(5, { gemm_fast(F, HID, WDN0, DM, DFF, pg8::EpiResidNormF{Hres, Hres, nullptr, F.in[2] + DM, XA, SS, red}); }) SEAM(5);
    PHASE(6, { gemm_fast(F, XA, (const bf16_t*)(ws + WS_WIN), BINP, DM, pg8::EpiWinNF{QKV, gates, SS}); }) SEAM(6);
    PHASE(7, { compress_fast(F); }) SEAM(7);
    PHASE(8, { fa::nsa_phase(F, QKV, (const bf16_t*)(ws + WS_KCVC), (const bf16_t*)(ws + WS_KCVC) + (size_t)BATCH * 2 * 128 * 64, biasD, gates, Ob); }) SEAM(8);
    PHASE(9, { gemm_fast(F, Ob, (const bf16_t*)(ws + WS_WOB), DM, DM, pg8::EpiResidNormF{Hres, Hres, nullptr, F.in[3] + DM, XA, SS, red}); }) SEAM(9);
    PHASE(10, { gemm_fast(F, XA, WGU1, 2 * DFF, DM, pg8::EpiSwigluNF{HID, SS}); }) SEAM(10);
    PHASE(11, { gemm_fast(F, HID, WDN1, DM, DFF, pg8::EpiResidF{Hres, Hres, nullptr}); }) SEAM(11);
    PHASE(12, { final_norm_phase(F, Hres, F.in[4]); })
#else
    PHASE(0, { p0_prologue(F); p0_rest(F, F.gw, F.ngw); }) SEAM(0);
    PHASE(1, { if (FAST_GEMM) gemm_fast(F, XA, (const bf16_t*)(ws + WS_WQKVA), AQKV, DM, pg8::EpiQkvF{QKV, F.in[6]}); else gemm_simple<false>(F, XA, DM, (const bf16_t*)(ws + WS_WQKVA), DM, AQKV / 64, EpiQkvA{QKV, F.in[6]}); }) SEAM(1);
    PHASE(2, { if (FAST_ATTN & 1) fa::swa_phase(F, QKV, biasD, F.in[7], Ob); else attn_simple<0>(F, QKV, AQKV, KVsrc{QKV, AQKV, 1024, 1152}, biasD, F.in[7], nullptr, nullptr, nullptr, Ob); }) SEAM(2);
    PHASE(3, { if (FAST_GEMM) gemm_fast(F, Ob, (const bf16_t*)(ws + WS_WOA), DM, DM, pg8::EpiResidF{F.in[0], Hres, F.in[9]}); else gemm_simple<false>(F, Ob, DM, (const bf16_t*)(ws + WS_WOA), DM, DM / 64, EpiResid{F.in[0], Hres, F.in[9]}); }) SEAM(3);
    PHASE(4, { norm_phase(F, Hres, F.in[3], XA); }) SEAM(4);
    PHASE(5, { if (FAST_GEMM) gemm_fast(F, XA, (const bf16_t*)(ws + WS_WGU), 2 * DFF, DM, pg8::EpiSwigluF{HID}); else gemm_simple<true>(F, XA, DM, (const bf16_t*)(ws + WS_WGU), DM, DFF / 32, EpiSwiglu{HID}); }) SEAM(5);
    PHASE(6, { if (FAST_GEMM) gemm_fast(F, HID, (const bf16_t*)(ws + WS_WDN), DM, DFF, pg8::EpiResidF{Hres, Hres, nullptr}); else gemm_simple<false>(F, HID, DFF, (const bf16_t*)(ws + WS_WDN), DFF, DM / 64, EpiResid{Hres, Hres, nullptr}); }) SEAM(6);
    PHASE(7, { norm_phase(F, Hres, F.in[2] + DM, XA); }) SEAM(7);
    PHASE(8, { if (FAST_GEMM) gemm_fast(F, XA, (const bf16_t*)(ws + WS_WIN), BINP, DM, pg8::EpiWinF{QKV, gates}); else gemm_simple<false>(F, XA, DM, (const bf16_t*)(ws + WS_WIN), DM, (BIN + 63) / 64, EpiWin{QKV, gates}); }) SEAM(8);
    PHASE(9, { if (FAST_CMPR) compress_fast(F); else compress_simple(F); }) SEAM(9);
    PHASE(10, { if (!(FAST_ATTN & 2)) cmp_simple(F); }) SEAM(10);
    PHASE(11, { if (FAST_ATTN & 2) fa::nsa_phase(F, QKV, (const bf16_t*)(ws + WS_KCVC), (const bf16_t*)(ws + WS_KCVC) + (size_t)BATCH * 2 * 128 * 64, biasD, gates, Ob); else { attn_simple<1>(F, QKV, PROJW, KVsrc{QKV, PROJW, 1024 + 2 * 128, 1024 + 3 * 128}, biasD, nullptr, gates, (const unsigned*)(ws + WS_SELM), Ocomb, Ob);
                  attn_simple<2>(F, QKV, PROJW, KVsrc{QKV, PROJW, 1024 + 4 * 128, 1024 + 5 * 128}, biasD, nullptr, gates, nullptr, Ocomb, Ob); } }) SEAM(11);
    PHASE(12, { if (FAST_GEMM) gemm_fast(F, Ob, (const bf16_t*)(ws + WS_WOB), DM, DM, pg8::EpiResidF{Hres, Hres, nullptr}); else gemm_simple<false>(F, Ob, DM, (const bf16_t*)(ws + WS_WOB), DM, DM / 64, EpiResid{Hres, Hres, nullptr}); }) SEAM(12);
    PHASE(13, { norm_phase(F, Hres, F.in[3] + DM, XA); }) SEAM(13);
    PHASE(14, { if (FAST_GEMM) gemm_fast(F, XA, (const bf16_t*)(ws + WS_WGU) + (size_t)2 * DFF * DM, 2 * DFF, DM, pg8::EpiSwigluF{HID}); else gemm_simple<true>(F, XA, DM, (const bf16_t*)(ws + WS_WGU) + (size_t)2 * DFF * DM, DM, DFF / 32, EpiSwiglu{HID}); }) SEAM(14);
    PHASE(15, { if (FAST_GEMM) gemm_fast(F, HID, (const bf16_t*)(ws + WS_WDN) + (size_t)DM * DFF, DM, DFF, pg8::EpiResidF{Hres, Hres, nullptr}); else gemm_simple<false>(F, HID, DFF, (const bf16_t*)(ws + WS_WDN) + (size_t)DM * DFF, DFF, DM / 64, EpiResid{Hres, Hres, nullptr}); }) SEAM(15);
    PHASE(16, { final_norm_phase(F, Hres, F.in[4]); })
#endif
#undef IN
#undef SEAM
#undef PHASE
}

extern "C" void kernel_launch(void* const* d_in, const int* in_sizes, int n_in, void* d_out, int out_size, void* d_ws, size_t ws_size, hipStream_t stream) {
    static int grid = 0;
    if (grid == 0) {
        if (n_in != 17 || out_size != M * DM || ws_size < WS_END) { fprintf(stderr, "kernel_launch: unexpected shapes (n_in %d out %d ws %zu)\n", n_in, out_size, ws_size); grid = -1; return; }
        int dev = 0, cus = 0, per_cu = 0;
        (void)hipGetDevice(&dev); (void)hipDeviceGetAttribute(&cus, hipDeviceAttributeMultiprocessorCount, dev);
        (void)hipFuncSetAttribute((const void*)trunk_fwd, hipFuncAttributeMaxDynamicSharedMemorySize, LDS_BYTES);
        (void)hipOccupancyMaxActiveBlocksPerMultiprocessor(&per_cu, (const void*)trunk_fwd, NTHR, LDS_BYTES);
        (void)hipGetLastError();
        if (per_cu < 1) fprintf(stderr, "kernel_launch: occupancy query says %d blocks per CU\n", per_cu);
        grid = cus > 0 ? cus : 256;
    }
    if (grid < 0) return;
    (void)hipMemsetAsync((char*)d_ws + WS_CTL, 0, CTL_ZERO_BYTES, stream);
    Args a{};
    for (int i = 0; i < 17; ++i) a.in[i] = (const float*)d_in[i];
    a.out = (float*)d_out; a.ws = (unsigned char*)d_ws;
#if MK_ONE_LAUNCH
    a.ph_lo = 0; a.ph_hi = NPHASES; a.li = 0;
    void* kargs[] = {&a};
    hipError_t e = hipLaunchCooperativeKernel((const void*)trunk_fwd, dim3(grid), dim3(NTHR), kargs, LDS_BYTES, stream);
    if (e != hipSuccess) fprintf(stderr, "cooperative launch failed: %s\n", hipGetErrorString(e));
#else
    for (int p = 0; p < NPHASES; ++p) { a.ph_lo = p; a.ph_hi = p + 1; a.li = 0;
        hipLaunchKernelGGL(trunk_fwd, dim3(grid), dim3(NTHR), LDS_BYTES, stream, a); }
#endif
}
```
